# Optimizing an MI355X kernel written in HIP

```python
import math
import jax, jax.numpy as jnp
from jax import lax
import numpy as np

D_MODEL = 4096
BATCH = 1
SEQ = 8192
DEPTH = 4

MIXER_ORDER = ("ssd", "pool", "moba")
RMS_EPS = 1e-6

SSD_EXPAND = 2
SSD_D_INNER = SSD_EXPAND * D_MODEL
SSD_HEAD_DIM = 64
SSD_N_HEADS = SSD_D_INNER // SSD_HEAD_DIM
SSD_N_GROUPS = 8
SSD_HEADS_PER_GROUP = SSD_N_HEADS // SSD_N_GROUPS
SSD_D_STATE = 128
SSD_CONV_WIDTH = 4
SSD_CONV_DIM = SSD_D_INNER + 2 * SSD_N_GROUPS * SSD_D_STATE
SSD_IN_DIM = SSD_D_INNER + SSD_CONV_DIM + SSD_N_HEADS
SSD_CHUNK = 128

POOL_WIDTH = 2 * D_MODEL
POOL_WINDOWS = (2, 4, 8, 16)
POOL_GROUPS = len(POOL_WINDOWS)
POOL_GROUP_DIM = POOL_WIDTH // POOL_GROUPS

MOBA_HEAD_DIM = 128
MOBA_WIDTH = D_MODEL
MOBA_N_HEADS = MOBA_WIDTH // MOBA_HEAD_DIM
MOBA_BLOCK = 256
MOBA_TOPK = 3
MOBA_Q_CHUNK = 16

kernel_name = "hybrid_ssd_pool_moba_trunk"


def rms_norm(x, w):
    xf = x.astype(jnp.float32)
    y = xf * lax.rsqrt(jnp.mean(xf * xf, axis=-1, keepdims=True) + RMS_EPS)
    return (y * w.astype(jnp.float32)).astype(x.dtype)


def causal_dwconv(x, w, b):
    k_w = w.shape[0]
    s = x.shape[1]
    xp = jnp.pad(x, ((0, 0), (k_w - 1, 0), (0, 0)))
    y = b
    for k in range(k_w):
        y = y + xp[:, k:k + s] * w[k]
    return y


def ssd_scan(x, a, bm, cm):
    b, s, g, r, p = x.shape
    n = bm.shape[-1]
    l = SSD_CHUNK
    c = s // l
    x = x.reshape(b, c, l, g, r, p)
    bm = bm.reshape(b, c, l, g, n)
    cm = cm.reshape(b, c, l, g, n)
    a = a.reshape(b, c, l, g, r).transpose(0, 1, 3, 4, 2)
    a_cs = jnp.cumsum(a, axis=-1)
    seg = a_cs[..., :, None] - a_cs[..., None, :]
    tril = jnp.tril(jnp.ones((l, l), dtype=bool))
    decay_in = jnp.exp(jnp.where(tril, seg, -jnp.inf))
    cb = jnp.einsum("bclgn,bcsgn->bcgls", cm, bm)
    y_diag = jnp.einsum("bcgls,bcgrls,bcsgrp->bclgrp", cb, decay_in, x)
    decay_to_end = jnp.exp(a_cs[..., -1:] - a_cs)
    chunk_states = jnp.einsum("bclgn,bcgrl,bclgrp->bcgrpn", bm, decay_to_end, x)
    chunk_decay = jnp.exp(a_cs[..., -1])

    def step(h, inp):
        st, dec = inp
        return h * dec[..., None, None] + st, h

    h0 = jnp.zeros((b, g, r, p, n), dtype=chunk_states.dtype)
    _, prev = lax.scan(step, h0, (jnp.moveaxis(chunk_states, 1, 0),
                                  jnp.moveaxis(chunk_decay, 1, 0)))
    prev = jnp.moveaxis(prev, 0, 1)
    y_off = jnp.einsum("bclgn,bcgrpn,bcgrl->bclgrp", cm, prev, jnp.exp(a_cs))
    return (y_diag + y_off).reshape(b, s, g, r, p)


def ssd_mixer(u, w_in, conv_w, conv_b, dt_bias, a_log, d_skip, norm_w, w_out):
    b, s, _ = u.shape
    G, R, P, N = SSD_N_GROUPS, SSD_HEADS_PER_GROUP, SSD_HEAD_DIM, SSD_D_STATE
    zxbcdt = u @ w_in
    z = zxbcdt[..., :SSD_D_INNER]
    xbc = zxbcdt[..., SSD_D_INNER:SSD_D_INNER + SSD_CONV_DIM]
    dt = zxbcdt[..., SSD_D_INNER + SSD_CONV_DIM:]
    xbc = jax.nn.silu(causal_dwconv(xbc, conv_w, conv_b))
    xs = xbc[..., :SSD_D_INNER].reshape(b, s, G, R, P)
    bm = xbc[..., SSD_D_INNER:SSD_D_INNER + G * N].reshape(b, s, G, N)
    cm = xbc[..., SSD_D_INNER + G * N:].reshape(b, s, G, N)
    dt = jax.nn.softplus(dt.astype(jnp.float32) + dt_bias.astype(jnp.float32)).reshape(b, s, G, R)
    a = -jnp.exp(a_log.astype(jnp.float32)).reshape(G, R)
    y = ssd_scan(xs * dt[..., None], dt * a, bm, cm)
    y = y + xs * d_skip.reshape(G, R)[:, :, None]
    y = y.reshape(b, s, SSD_D_INNER)
    yz = (y * jax.nn.silu(z.astype(y.dtype))).reshape(b, s, G, SSD_D_INNER // G)
    yf = yz.astype(jnp.float32)
    yf = yf * lax.rsqrt(jnp.mean(yf * yf, axis=-1, keepdims=True) + RMS_EPS)
    y = (yf.reshape(b, s, SSD_D_INNER) * norm_w.astype(jnp.float32)).astype(u.dtype)
    return y @ w_out


def pool_mixer(u, w_in, w_grp, b_grp, scale, w_out):
    b, s, _ = u.shape
    proj = u @ w_in
    v, z = proj[..., :POOL_WIDTH], proj[..., POOL_WIDTH:]
    cs = jnp.cumsum(v.astype(jnp.float32), axis=1)
    pos = jnp.arange(s)
    groups = []
    for gi, w in enumerate(POOL_WINDOWS):
        sl = slice(gi * POOL_GROUP_DIM, (gi + 1) * POOL_GROUP_DIM)
        cs_g = cs[..., sl]
        prev = jnp.pad(cs_g, ((0, 0), (w, 0), (0, 0)))[:, :s]
        count = jnp.minimum(pos + 1, w).astype(jnp.float32)[None, :, None]
        groups.append((cs_g - prev) / count - v[..., sl].astype(jnp.float32))
    d = jnp.stack(groups, axis=2).astype(u.dtype)
    mixed = jnp.einsum("bsgc,gcd->bsgd", d, w_grp) + b_grp
    mixed = mixed.reshape(b, s, POOL_WIDTH) * scale
    return (mixed * jax.nn.silu(z)) @ w_out


def moba_mixer(u, w_in, q_norm_w, k_norm_w, w_out):
    b, s, _ = u.shape
    H, Dh, BLK, Q = MOBA_N_HEADS, MOBA_HEAD_DIM, MOBA_BLOCK, MOBA_Q_CHUNK
    proj = u @ w_in
    q = rms_norm(proj[..., 0 * MOBA_WIDTH:1 * MOBA_WIDTH].reshape(b, s, H, Dh), q_norm_w)
    k = rms_norm(proj[..., 1 * MOBA_WIDTH:2 * MOBA_WIDTH].reshape(b, s, H, Dh), k_norm_w)
    v = proj[..., 2 * MOBA_WIDTH:3 * MOBA_WIDTH].reshape(b, s, H, Dh)
    gate = proj[..., 3 * MOBA_WIDTH:]
    s_pad = -(-s // BLK) * BLK
    pad = ((0, 0), (0, s_pad - s), (0, 0), (0, 0))
    q = jnp.pad(q, pad).transpose(0, 2, 1, 3)
    k = jnp.pad(k, pad).transpose(0, 2, 1, 3)
    v = jnp.pad(v, pad).transpose(0, 2, 1, 3)
    nb = s_pad // BLK
    kb = k.reshape(b, H, nb, BLK, Dh)
    vb = v.reshape(b, H, nb, BLK, Dh)
    k_mean = jnp.mean(kb.astype(jnp.float32), axis=3).astype(k.dtype)
    gscore = jnp.einsum("bhsd,bhnd->bhsn", q, k_mean).astype(jnp.float32)
    q_blk = jnp.arange(s_pad) // BLK
    past = jnp.arange(nb)[None, :] < q_blk[:, None]
    gscore = jnp.where(past, gscore, -jnp.inf)
    k_sel = min(MOBA_TOPK, nb)
    _, sel = lax.top_k(gscore, k_sel)
    sel_valid = sel < q_blk[None, None, :, None]
    scale = 1.0 / math.sqrt(Dh)
    bi = jnp.arange(b)[:, None, None, None]
    hi = jnp.arange(H)[None, :, None, None]

    def chunk_fn(c):
        start = c * Q
        qc = lax.dynamic_slice_in_dim(q, start, Q, axis=2)
        sel_c = lax.dynamic_slice_in_dim(sel, start, Q, axis=2)
        valid_c = lax.dynamic_slice_in_dim(sel_valid, start, Q, axis=2)
        own = start // BLK
        k_own = lax.dynamic_index_in_dim(kb, own, axis=2, keepdims=False)
        v_own = lax.dynamic_index_in_dim(vb, own, axis=2, keepdims=False)
        k_g = kb[bi, hi, sel_c]
        v_g = vb[bi, hi, sel_c]
        s_sel = jnp.einsum("bhqd,bhqkjd->bhqkj", qc, k_g).astype(jnp.float32) * scale
        s_sel = jnp.where(valid_c[..., None], s_sel, -jnp.inf).reshape(b, H, Q, k_sel * BLK)
        s_own = jnp.einsum("bhqd,bhjd->bhqj", qc, k_own).astype(jnp.float32) * scale
        qpos = start + jnp.arange(Q)
        kpos = own * BLK + jnp.arange(BLK)
        s_own = jnp.where(kpos[None, :] <= qpos[:, None], s_own, -jnp.inf)
        p = jax.nn.softmax(jnp.concatenate([s_sel, s_own], axis=-1), axis=-1).astype(v.dtype)
        p_sel = p[..., :k_sel * BLK].reshape(b, H, Q, k_sel, BLK)
        p_own = p[..., k_sel * BLK:]
        return (jnp.einsum("bhqkj,bhqkjd->bhqd", p_sel, v_g)
                + jnp.einsum("bhqj,bhjd->bhqd", p_own, v_own))

    outs = lax.map(chunk_fn, jnp.arange(s_pad // Q))
    o = outs.transpose(1, 0, 3, 2, 4).reshape(b, s_pad, H * Dh)[:, :s]
    return (o * jax.nn.silu(gate)) @ w_out


MIXERS = {"ssd": ssd_mixer, "pool": pool_mixer, "moba": moba_mixer}


def setup_inputs(seed: int = 0) -> dict:
    key = jax.random.key(seed)
    keys = jax.random.split(key, 64)
    counter = iter(range(64))

    def nk():
        return keys[next(counter)]

    def nrm(shape, sc):
        return jax.random.normal(nk(), shape, jnp.float32) * sc

    p = {}
    p["x"] = nrm((BATCH, SEQ, D_MODEL), 1.0)

    def add_ssd(name):
        H = SSD_N_HEADS
        p[name + "_w_in"] = nrm((D_MODEL, SSD_IN_DIM), D_MODEL ** -0.5)
        p[name + "_conv_w"] = nrm((SSD_CONV_WIDTH, SSD_CONV_DIM), SSD_CONV_WIDTH ** -0.5)
        p[name + "_conv_b"] = nrm((SSD_CONV_DIM,), 0.02)
        dt = jnp.exp(jax.random.uniform(nk(), (H,), jnp.float32)
                     * (math.log(0.1) - math.log(0.001)) + math.log(0.001))
        p[name + "_dt_bias"] = dt + jnp.log(-jnp.expm1(-dt))
        p[name + "_a_log"] = jnp.log(jax.random.uniform(nk(), (H,), jnp.float32, minval=1.0, maxval=16.0))
        p[name + "_d"] = 1.0 + nrm((H,), 0.02)
        p[name + "_norm_w"] = 1.0 + nrm((SSD_D_INNER,), 0.02)
        p[name + "_w_out"] = nrm((SSD_D_INNER, D_MODEL), SSD_D_INNER ** -0.5)

    p["norm0"] = 1.0 + nrm((D_MODEL,), 0.02)
    add_ssd("ssd0")
    p["norm1"] = 1.0 + nrm((D_MODEL,), 0.02)
    p["pool1_w_in"] = nrm((D_MODEL, 2 * POOL_WIDTH), D_MODEL ** -0.5)
    p["pool1_w_grp"] = nrm((POOL_GROUPS, POOL_GROUP_DIM, POOL_GROUP_DIM), POOL_GROUP_DIM ** -0.5)
    p["pool1_b_grp"] = nrm((POOL_GROUPS, POOL_GROUP_DIM), 0.02)
    p["pool1_scale"] = 1.0 + nrm((POOL_WIDTH,), 0.02)
    p["pool1_w_out"] = nrm((POOL_WIDTH, D_MODEL), POOL_WIDTH ** -0.5)
    p["norm2"] = 1.0 + nrm((D_MODEL,), 0.02)
    p["moba2_w_in"] = nrm((D_MODEL, 4 * MOBA_WIDTH), D_MODEL ** -0.5)
    p["moba2_q_norm"] = 1.0 + nrm((MOBA_HEAD_DIM,), 0.02)
    p["moba2_k_norm"] = 1.0 + nrm((MOBA_HEAD_DIM,), 0.02)
    p["moba2_w_out"] = nrm((MOBA_WIDTH, D_MODEL), MOBA_WIDTH ** -0.5)
    p["norm3"] = 1.0 + nrm((D_MODEL,), 0.02)
    add_ssd("ssd3")
    return p


def reference(x,
              norm0, ssd0_w_in, ssd0_conv_w, ssd0_conv_b, ssd0_dt_bias, ssd0_a_log, ssd0_d, ssd0_norm_w, ssd0_w_out,
              norm1, pool1_w_in, pool1_w_grp, pool1_b_grp, pool1_scale, pool1_w_out,
              norm2, moba2_w_in, moba2_q_norm, moba2_k_norm, moba2_w_out,
              norm3, ssd3_w_in, ssd3_conv_w, ssd3_conv_b, ssd3_dt_bias, ssd3_a_log, ssd3_d, ssd3_norm_w, ssd3_w_out):
    layer_params = [
        (norm0, (ssd0_w_in, ssd0_conv_w, ssd0_conv_b, ssd0_dt_bias, ssd0_a_log, ssd0_d, ssd0_norm_w, ssd0_w_out)),
        (norm1, (pool1_w_in, pool1_w_grp, pool1_b_grp, pool1_scale, pool1_w_out)),
        (norm2, (moba2_w_in, moba2_q_norm, moba2_k_norm, moba2_w_out)),
        (norm3, (ssd3_w_in, ssd3_conv_w, ssd3_conv_b, ssd3_dt_bias, ssd3_a_log, ssd3_d, ssd3_norm_w, ssd3_w_out)),
    ]
    h = x
    for i in range(DEPTH):
        g, params = layer_params[i]
        mixer = MIXERS[MIXER_ORDER[i % len(MIXER_ORDER)]]
        h = h + mixer(rms_norm(h, g), *params)
    return h
```

```cpp
#include <hip/hip_runtime.h>
#include <cstdio>
#include <cstdint>
#define MK_N_LAUNCHES 1
namespace pg8 {
#define PG8_LAS __attribute__((address_space(3)))
typedef unsigned short bf16_t;
typedef short bf16x8 __attribute__((ext_vector_type(8)));
typedef float f32x4 __attribute__((ext_vector_type(4)));
typedef unsigned u32x4 __attribute__((ext_vector_type(4)));
constexpr int BM = 256, BK = 64, HALF = 128, HTB = HALF * BK * 2  , STAGE_BYTES = 8 * HTB, NXCD = 8, WGM = 4;

__host__ __device__ __forceinline__ int lds_byte(int r, int c) { const int st = (r >> 4) * 2 + (c >> 5), rr = r & 15, cc = c & 31, ob = rr * 64 + cc * 2; return st * 1024 + (ob ^ (((ob >> 9) & 1) << 5)); }
__host__ __device__ __forceinline__ void stage_rc(int b, int& R, int& C) { const int st = b / 1024, sb = b % 1024, swz = sb ^ (((sb >> 9) & 1) << 5); R = (st >> 1) * 16 + swz / 64; C = (st & 1) * 32 + (swz % 64) / 2; }
__host__ __device__ __forceinline__ int perm32(int rho) { const int n = rho >> 4, i = rho & 15; return 8 * (i >> 2) + 4 * n + (i & 3); }

struct Unit { int pm, pn; };
struct Gemm { const bf16_t* A; const bf16_t* Bt; int M, N, K, lda, ldb, gdiv; };

struct StaticOrder {
    int nM, nN, nwg, G, c;
    __host__ __device__ void init(int M, int N, int G_, int c_) { nM = M / BM; nN = N / BM; nwg = nM * nN; G = G_; c = c_; }
    __host__ __device__ bool next(int i, Unit& u) const {
        const long L = (long)i * G + c; if (L >= nwg) return false;
        int wgid = (int)L; { const int q = nwg / NXCD, r = nwg % NXCD, xcd = wgid % NXCD, off = wgid / NXCD; wgid = (xcd < r ? xcd * (q + 1) : r * (q + 1) + (xcd - r) * q) + off; }
        const int nig = WGM * nN, gid = wgid / nig, fm = gid * WGM, gsz = (nM - fm) < WGM ? (nM - fm) : WGM;
        u.pm = fm + ((wgid % nig) % gsz); u.pn = (wgid % nig) / gsz; return true;
    }
    __device__ __forceinline__ void a_ready(const Unit&) const {}
    __device__ __forceinline__ void done(const Unit&) const {}
};

__device__ __forceinline__ unsigned cvt_pk_bf16(float lo, float hi) { unsigned r; asm volatile("v_cvt_pk_bf16_f32 %0, %1, %2" : "=v"(r) : "v"(lo), "v"(hi)); return r; }

template <class Epi, class Sched, bool ALIGN_EPI = false, bool SP2 = false>
__device__ __forceinline__ void gemm_phase(PG8_LAS unsigned char* lds, const Gemm g, const Sched& S, const Epi& E) {
    const int tid = threadIdx.x, wid = __builtin_amdgcn_readfirstlane(tid >> 6), lane = tid & 63, wr = wid >> 2, wc = wid & 3, fr = lane & 15, fq = lane >> 4;
    const int K = g.K, nt = K / BK;
    unsigned voffA[2], voffB[2];
#pragma unroll
    for (int i = 0; i < 2; ++i) { int R, C; stage_rc(tid * 16 + i * 8192, R, C); const int Rb = Epi::PERM ? ((R & ~31) + perm32(R & 31)) : R;
        voffA[i] = (unsigned)(R * g.lda + C) * 2u; voffB[i] = (unsigned)(Rb * g.ldb + C) * 2u; }
    const size_t kstep = (size_t)(BK * 2);
    const size_t hstepA = (size_t)HALF * g.lda * 2, hstepB = (size_t)HALF * g.ldb * 2;
    const size_t tstepA = 2 * hstepA, tstepB = 2 * hstepB;
    const unsigned ldsw = (unsigned)wid * 1024u;
    const int aoff = lds_byte(wr * 64 + fr, fq * 8), boff = lds_byte(wc * 32 + fr, fq * 8);
#define PG8_SA(b, h) (((b) * 2 + (h)) * HTB)
#define PG8_SB(b, h) ((4 + (b) * 2 + (h)) * HTB)
#define PG8_STAGE(bufoff, gbase, voff) do { _Pragma("unroll") for (int _i = 0; _i < 2; ++_i) \
        __builtin_amdgcn_global_load_lds((const unsigned*)((const char*)(gbase) + (voff)[_i]), (PG8_LAS unsigned*)(lds + (bufoff) + ldsw + _i * 8192), 16, 0, 0); } while (0)
#define PG8_LDA(dst, b, h) do { _Pragma("unroll") for (int m = 0; m < 4; ++m) _Pragma("unroll") for (int k = 0; k < 2; ++k) dst[m][k] = *(const PG8_LAS bf16x8*)(lds + PG8_SA(b, h) + aoff + m * 2048 + k * 1024); } while (0)
#define PG8_LDB(dst, b, h) do { _Pragma("unroll") for (int n = 0; n < 2; ++n) _Pragma("unroll") for (int k = 0; k < 2; ++k) dst[n][k] = *(const PG8_LAS bf16x8*)(lds + PG8_SB(b, h) + boff + n * 2048 + k * 1024); } while (0)
#define PG8_MMA(ai, bj, At, Bt) do { __builtin_amdgcn_s_setprio(1); _Pragma("unroll") for (int m = 0; m < 4; ++m) _Pragma("unroll") for (int n = 0; n < 2; ++n) _Pragma("unroll") for (int k = 0; k < 2; ++k) \
        acc[ai][bj][m][n] = __builtin_amdgcn_mfma_f32_16x16x32_bf16(Bt[n][k], At[m][k], acc[ai][bj][m][n], 0, 0, 0); __builtin_amdgcn_s_setprio(0); } while (0)
#define PG8_WAIT_V(n) asm volatile("s_waitcnt vmcnt(" #n ")" ::: "memory")
#define PG8_WAIT_L(n) asm volatile("s_waitcnt lgkmcnt(" #n ")" ::: "memory")
#define PG8_BAR __builtin_amdgcn_s_barrier()
#define PG8_SCHED __builtin_amdgcn_sched_barrier(0)
#define PG8_ABASE(u) ((const char*)g.A + (size_t)(u).pm * tstepA + (g.gdiv ? (size_t)((u).pn / g.gdiv) * (size_t)K * 2 : (size_t)0))
    Unit cur, nxt; int ui = 0;
    if (!S.next(0, cur)) return;
    f32x4 acc[2][2][4][2];
#pragma unroll
    for (int a = 0; a < 2; ++a)
#pragma unroll
        for (int b = 0; b < 2; ++b)
#pragma unroll
            for (int m = 0; m < 4; ++m)
#pragma unroll
                for (int n = 0; n < 2; ++n) acc[a][b][m][n] = (f32x4){0.f, 0.f, 0.f, 0.f};
    bf16x8 At[4][2], B0[2][2], B1[2][2];
    const char* cA = PG8_ABASE(cur); const char* cB = (const char*)g.Bt + (size_t)cur.pn * tstepB;
    S.a_ready(cur);
    if constexpr (SP2) {
        PG8_STAGE(PG8_SB(0, 0), cB, voffB); PG8_STAGE(PG8_SB(0, 1), cB + hstepB, voffB); PG8_STAGE(PG8_SA(0, 0), cA, voffA); PG8_STAGE(PG8_SA(0, 1), cA + hstepA, voffA);
        if (wr == 1) PG8_BAR;
        PG8_WAIT_V(2); PG8_BAR;
        PG8_STAGE(PG8_SB(1, 0), cB + kstep, voffB); PG8_STAGE(PG8_SA(1, 0), cA + kstep, voffA); PG8_STAGE(PG8_SB(1, 1), cB + hstepB + kstep, voffB);
        PG8_WAIT_V(6); PG8_BAR;
    } else {
        PG8_STAGE(PG8_SB(0, 0), cB, voffB); PG8_STAGE(PG8_SA(0, 0), cA, voffA); PG8_STAGE(PG8_SB(0, 1), cB + hstepB, voffB); PG8_STAGE(PG8_SA(0, 1), cA + hstepA, voffA);
        if (wr == 1) PG8_BAR;
        PG8_WAIT_V(4); PG8_BAR;
        PG8_STAGE(PG8_SB(1, 0), cB + kstep, voffB); PG8_STAGE(PG8_SA(1, 0), cA + kstep, voffA); PG8_STAGE(PG8_SB(1, 1), cB + hstepB + kstep, voffB);
        PG8_WAIT_V(6); PG8_BAR;
    }
    for (;;) {
        const bool has_next = S.next(ui + 1, nxt);
        const char* nA = has_next ? PG8_ABASE(nxt) : cA; const char* nB = has_next ? (const char*)g.Bt + (size_t)nxt.pn * tstepB : cB;
        for (int t = 0; t < nt; t += 2) {
            const bool last = (t == nt - 2);
            const char* a1 = cA + (size_t)(t + 1) * kstep;
            const char* a2 = last ? nA : cA + (size_t)(t + 2) * kstep; const char* b2 = last ? nB : cB + (size_t)(t + 2) * kstep;
            const char* a3 = a2 + kstep; const char* b3 = b2 + kstep;
            if (last && has_next) S.a_ready(nxt);
            if constexpr (SP2) {
            PG8_LDB(B0, 0, 0); PG8_LDB(B1, 0, 1); PG8_SCHED; PG8_LDA(At, 0, 0); PG8_STAGE(PG8_SA(1, 1), a1 + hstepA, voffA);
            PG8_WAIT_V(8); PG8_WAIT_L(0); PG8_BAR; PG8_MMA(0, 0, At, B0); PG8_MMA(0, 1, At, B1); PG8_BAR; PG8_SCHED;
            PG8_LDA(At, 0, 1); PG8_STAGE(PG8_SB(0, 0), b2, voffB); PG8_STAGE(PG8_SB(0, 1), b2 + hstepB, voffB); PG8_STAGE(PG8_SA(0, 0), a2, voffA);
            PG8_WAIT_V(8); PG8_WAIT_L(0); PG8_BAR; PG8_MMA(1, 0, At, B0); PG8_MMA(1, 1, At, B1); PG8_BAR; PG8_SCHED;
            PG8_LDB(B0, 1, 0); PG8_LDB(B1, 1, 1); PG8_SCHED; PG8_LDA(At, 1, 0); PG8_STAGE(PG8_SA(0, 1), a2 + hstepA, voffA);
            PG8_WAIT_V(8); PG8_WAIT_L(0); PG8_BAR; PG8_MMA(0, 0, At, B0); PG8_MMA(0, 1, At, B1); PG8_BAR; PG8_SCHED;
            PG8_LDA(At, 1, 1); PG8_STAGE(PG8_SB(1, 0), b3, voffB); PG8_STAGE(PG8_SB(1, 1), b3 + hstepB, voffB); PG8_STAGE(PG8_SA(1, 0), a3, voffA);
            PG8_WAIT_V(8); PG8_WAIT_L(0); PG8_BAR; PG8_MMA(1, 0, At, B0); PG8_MMA(1, 1, At, B1); PG8_BAR; PG8_SCHED;
            } else {
            PG8_LDB(B0, 0, 0); PG8_SCHED; PG8_LDA(At, 0, 0); PG8_STAGE(PG8_SA(1, 1), a1 + hstepA, voffA);
            PG8_WAIT_L(8); PG8_BAR; PG8_WAIT_L(0); PG8_MMA(0, 0, At, B0); PG8_BAR; PG8_SCHED;
            PG8_LDB(B1, 0, 1); PG8_STAGE(PG8_SB(0, 0), b2, voffB);
            PG8_BAR; PG8_WAIT_L(0); PG8_MMA(0, 1, At, B1); PG8_BAR;
            PG8_LDA(At, 0, 1); PG8_STAGE(PG8_SA(0, 0), a2, voffA);
            PG8_BAR; PG8_WAIT_L(0); PG8_MMA(1, 0, At, B0); PG8_BAR; PG8_SCHED;
            PG8_STAGE(PG8_SB(0, 1), b2 + hstepB, voffB);
            PG8_WAIT_V(6); PG8_BAR; PG8_MMA(1, 1, At, B1); PG8_BAR;
            PG8_LDB(B0, 1, 0); PG8_SCHED; PG8_LDA(At, 1, 0); PG8_STAGE(PG8_SA(0, 1), a2 + hstepA, voffA);
            PG8_WAIT_L(8); PG8_BAR; PG8_WAIT_L(0); PG8_MMA(0, 0, At, B0); PG8_BAR; PG8_SCHED;
            PG8_LDB(B1, 1, 1); PG8_STAGE(PG8_SB(1, 0), b3, voffB);
            PG8_BAR; PG8_WAIT_L(0); PG8_MMA(0, 1, At, B1); PG8_BAR;
            PG8_LDA(At, 1, 1); PG8_STAGE(PG8_SA(1, 0), a3, voffA);
            PG8_BAR; PG8_WAIT_L(0); PG8_MMA(1, 0, At, B0); PG8_BAR; PG8_SCHED;
            PG8_STAGE(PG8_SB(1, 1), b3 + hstepB, voffB);
            PG8_WAIT_V(6); PG8_BAR; PG8_MMA(1, 1, At, B1); PG8_BAR;
            }
        }
        if constexpr (ALIGN_EPI) { if (wr == 0) PG8_BAR; }
        E(acc, cur, wr, wc, fr, fq); S.done(cur);
        if (!has_next) break;
#pragma unroll
        for (int a = 0; a < 2; ++a)
#pragma unroll
            for (int b = 0; b < 2; ++b)
#pragma unroll
                for (int m = 0; m < 4; ++m)
#pragma unroll
                    for (int n = 0; n < 2; ++n) acc[a][b][m][n] = (f32x4){0.f, 0.f, 0.f, 0.f};
        cur = nxt; cA = nA; cB = nB; ++ui;
        if constexpr (ALIGN_EPI) { if (wr == 1) PG8_BAR; }
    }
    PG8_WAIT_V(0);
    if constexpr (!ALIGN_EPI) { if (wr == 0) PG8_BAR; }
    PG8_BAR;
#undef PG8_ABASE
#undef PG8_SA
#undef PG8_SB
#undef PG8_STAGE
#undef PG8_LDA
#undef PG8_LDB
#undef PG8_MMA
#undef PG8_WAIT_V
#undef PG8_WAIT_L
#undef PG8_BAR
#undef PG8_SCHED
}
}
constexpr int NWAVES = 8;
constexpr int M = 8192, D = 4096;
constexpr float RMS_EPS = 1e-6f;
constexpr int SSD_DI = 8192, SSD_NH = 128, SSD_HD = 64, SSD_NG = 8, SSD_DS = 128, SSD_CONV = 10240, SSD_IN = 18560, SSD_MAIN = 18432;
constexpr int POOL_W = 8192, POOL_GD = 2048;
constexpr int MOBA_H = 32, MOBA_DH = 128, MOBA_BLK = 256, MOBA_NB = 32, MOBA_W = 4096;

constexpr size_t MiB = 1u << 20;
constexpr size_t WS_CTL = 0, CTL_ZERO_BYTES = 1 * MiB;
constexpr size_t WS_W_SSD0_IN = 1 * MiB;
constexpr size_t WS_W_SSD0_OUT = WS_W_SSD0_IN + 145 * MiB;
constexpr size_t WS_W_POOL_IN = WS_W_SSD0_OUT + 64 * MiB;
constexpr size_t WS_W_POOL_GRP = WS_W_POOL_IN + 128 * MiB;
constexpr size_t WS_W_POOL_OUT = WS_W_POOL_GRP + 32 * MiB;
constexpr size_t WS_W_MOBA_IN = WS_W_POOL_OUT + 64 * MiB;
constexpr size_t WS_W_MOBA_OUT = WS_W_MOBA_IN + 128 * MiB;
constexpr size_t WS_W_SSD3_IN = WS_W_MOBA_OUT + 32 * MiB;
constexpr size_t WS_W_SSD3_OUT = WS_W_SSD3_IN + 145 * MiB;
constexpr size_t WS_ACT_A = WS_W_SSD3_OUT + 64 * MiB;
constexpr size_t WS_ACT_B = WS_ACT_A + 288 * MiB;
constexpr size_t WS_ACT_C = WS_ACT_B + 128 * MiB;
constexpr size_t WS_STATES = WS_ACT_C, WS_XT = WS_ACT_C + 128 * MiB;
constexpr size_t WS_XC = WS_ACT_C + 256 * MiB;
constexpr size_t WS_HB = WS_XC + 160 * MiB;
constexpr size_t WS_DT = WS_HB + 64 * MiB;
constexpr size_t WS_KMEAN = WS_DT + 4 * MiB;
constexpr size_t WS_DECAY = WS_KMEAN + 512 * 1024;
constexpr size_t WS_SSG = WS_DECAY + 64 * 1024;
constexpr size_t WS_END = WS_KMEAN + 1 * MiB;
constexpr size_t WS_BT = WS_HB;
constexpr int CW_TMO = 0, CW_CODE = 1;
constexpr int CW_BAR = 4096;
constexpr int CW_ROWSS = 16384;
static_assert((CW_ROWSS + 8 * M) * 4 <= (int)CTL_ZERO_BYTES, "CTL words inside the memset region");

constexpr int RING_OFF = 0, RING_BYTES = 131072;
constexpr int LDSCTL_OFF = RING_BYTES, MISC_OFF = LDSCTL_OFF + 320;
constexpr int LDS_BYTES = 147456;
static_assert(MISC_OFF + 128 <= LDS_BYTES, "LDS map");

#define GAS __attribute__((address_space(1)))
#define LAS __attribute__((address_space(3)))
typedef unsigned short bf16;
typedef unsigned v4u __attribute__((ext_vector_type(4)));
typedef unsigned v2u __attribute__((ext_vector_type(2)));
typedef float f32x4 __attribute__((ext_vector_type(4)));
typedef float f32x16 __attribute__((ext_vector_type(16)));
typedef short bf16x8 __attribute__((ext_vector_type(8)));
typedef GAS unsigned gu32;
#define RLX_AGENT __ATOMIC_RELAXED, __HIP_MEMORY_SCOPE_AGENT
#define LDS_WAIT() asm volatile("s_waitcnt lgkmcnt(0)" ::: "memory")
#define VM_WAIT() asm volatile("s_waitcnt vmcnt(0)" ::: "memory")
__device__ __forceinline__ unsigned f2bf(float f) { unsigned u = __builtin_bit_cast(unsigned, f); return (u + 0x7fffu + ((u >> 16) & 1u)) >> 16; }
typedef float f32x2_t_ __attribute__((ext_vector_type(2)));
typedef __bf16 bf16x2_t_ __attribute__((ext_vector_type(2)));
__device__ __forceinline__ unsigned pk2(float lo, float hi) { const f32x2_t_ v = {lo, hi}; return __builtin_bit_cast(unsigned, __builtin_convertvector(v, bf16x2_t_)); }
__device__ __forceinline__ float bflo(unsigned w) { return __builtin_bit_cast(float, w << 16); }
__device__ __forceinline__ float bfhi(unsigned w) { return __builtin_bit_cast(float, w & 0xffff0000u); }
__device__ __forceinline__ float bf1(bf16 b) { return __builtin_bit_cast(float, ((unsigned)b) << 16); }
__device__ __forceinline__ float silu_f(float x) { return x * __builtin_amdgcn_rcpf(1.f + __expf(-x)); }
__device__ __forceinline__ float wave_sum(float v) {
#pragma unroll
    for (int o = 1; o < 64; o <<= 1) v += __shfl_xor(v, o);
    return v;
}
__device__ __forceinline__ float wave_max(float v) {
#pragma unroll
    for (int o = 1; o < 64; o <<= 1) v = fmaxf(v, __shfl_xor(v, o));
    return v;
}
__device__ __forceinline__ f32x16 zero16() { f32x16 z;
#pragma unroll
    for (int j = 0; j < 16; ++j) z[j] = 0.f;
    asm volatile("" : "+v"(z)); return z; }
#define XB_TMO      128
#define XB_XCNT(j)  (256  + 64 * (j))
#define XB_XSUB(j)  (1280 + 64 * (j))
#define XB_XGEN(j)  (2304 + 64 * (j))
#define XB_TOP      3328
#define XB_TOPGEN   3392
#define XCD_BAR_WORDS 3456
#define XB_SPIN_CAP (1u << 18)

__device__ __forceinline__ unsigned xb_ld(unsigned* p)              { return __hip_atomic_load(p, __ATOMIC_RELAXED, __HIP_MEMORY_SCOPE_AGENT); }
__device__ __forceinline__ unsigned xb_add(unsigned* p, unsigned v) { return __hip_atomic_fetch_add(p, v, __ATOMIC_RELAXED, __HIP_MEMORY_SCOPE_AGENT); }
__device__ __forceinline__ unsigned xb_xcc_id() { return (unsigned)__builtin_amdgcn_s_getreg((3 << 11) | 20) & 0xFu; }
#define XB_SPIN(cond, bar) do { unsigned _sp = 0; while (cond) { __builtin_amdgcn_s_sleep(1); \
    if ((++_sp & 255u) == 0u) { if (xb_ld(&(bar)[XB_TMO])) break; if (_sp > XB_SPIN_CAP) { atomicAdd(&(bar)[XB_TMO], 1u); break; } } } } while (0)

struct XcdBarrier {
    unsigned* bar; unsigned x;
    volatile LAS unsigned* st;
};

__device__ __forceinline__ XcdBarrier xcd_barrier_post(unsigned* bar, volatile LAS unsigned* st) {
    XcdBarrier b; b.bar = bar; b.x = xb_xcc_id(); b.st = st;
    if (threadIdx.x == 0) (void)xb_add(&bar[XB_XCNT(b.x)], 1u);
    return b;
}
__device__ __forceinline__ void xcd_barrier_complete(unsigned* bar, unsigned x, unsigned& nloc, unsigned& nx) {
    const unsigned G = gridDim.x * gridDim.y * gridDim.z;
    unsigned sum, cnt, mine, sp = 0u;
    for (;;) {
        sum = 0u; cnt = 0u; mine = 0u;
#pragma unroll
        for (unsigned j = 0; j < 16; ++j) { const unsigned c = xb_ld(&bar[XB_XCNT(j)]); sum += c; cnt += (c > 0u) ? 1u : 0u; mine = (j == x) ? c : mine; }
        if (sum == G) break;
        __builtin_amdgcn_s_sleep(1);
        if ((++sp & 255u) == 0u) { if (xb_ld(&bar[XB_TMO])) break; if (sp > XB_SPIN_CAP) { atomicAdd(&bar[XB_TMO], 1u); break; } }
    }
    nloc = mine > 0u ? mine : 1u; nx = cnt > 0u ? cnt : 1u;
}

__device__ __forceinline__ void xcd_barrier(const XcdBarrier& b) {
    asm volatile("s_waitcnt vmcnt(0)" ::: "memory");
    __syncthreads();
    if (threadIdx.x == 0) {
        unsigned* bar = b.bar;
        __builtin_amdgcn_s_waitcnt(0);
        unsigned nloc = b.st[0], nx = b.st[1];
        if (nloc == 0u) { xcd_barrier_complete(bar, b.x, nloc, nx); b.st[0] = nloc; b.st[1] = nx; }
        const unsigned old = xb_add(&bar[XB_XSUB(b.x)], 1u);
        const unsigned gen = old / nloc;
        if (old + 1u == (gen + 1u) * nloc) {
            __builtin_amdgcn_fence(__ATOMIC_RELEASE, "agent");
            asm volatile("s_waitcnt vmcnt(0)" ::: "memory");
            const unsigned og = xb_add(&bar[XB_TOP], 1u);
            const unsigned tg = og / nx;
            if (og + 1u == (tg + 1u) * nx) xb_add(&bar[XB_TOPGEN], 1u);
            else XB_SPIN(xb_ld(&bar[XB_TOPGEN]) == tg, bar);
            __builtin_amdgcn_fence(__ATOMIC_ACQUIRE, "agent");
            xb_add(&bar[XB_XGEN(b.x)], 1u);
            asm volatile("s_waitcnt vmcnt(0)" ::: "memory");
        } else {
            XB_SPIN(xb_ld(&bar[XB_XGEN(b.x)]) == gen, bar);
            __builtin_amdgcn_fence(__ATOMIC_ACQUIRE, "agent");
            asm volatile("s_waitcnt vmcnt(0)" ::: "memory");
        }
    }
    __syncthreads();
}
struct Frame {
    LAS unsigned char* lds;
    volatile LAS unsigned* MISC;
    gu32* ctl;
    int tid, lane, wave;
    int G;
    unsigned char* ws;
};

namespace pg8 {
struct EpiRowScale {
    static constexpr bool PERM = true;
    bf16_t* O; int ldc; const unsigned long long* rowss;
    __device__ __forceinline__ void operator()(const f32x4 (&acc)[2][2][4][2], const Unit& u, int wr, int wc, int fr, int fq) const {
        const int row0 = u.pm * BM + wr * 64 + fr, col0 = u.pn * BM + wc * 32 + 8 * fq;
#pragma unroll
        for (int ai = 0; ai < 2; ++ai)
#pragma unroll
            for (int m = 0; m < 4; ++m) { const int row = row0 + ai * HALF + m * 16; const float rs = rsqrtf((float)rowss[row] * (1.0f / (4096.0f * 16777216.0f)) + 1e-6f);
                bf16_t* rowp = O + (size_t)row * ldc + col0;
#pragma unroll
                for (int bj = 0; bj < 2; ++bj) { const f32x4 v0 = acc[ai][bj][m][0] * rs, v1 = acc[ai][bj][m][1] * rs;
                    u32x4 w; w.x = cvt_pk_bf16(v0[0], v0[1]); w.y = cvt_pk_bf16(v0[2], v0[3]); w.z = cvt_pk_bf16(v1[0], v1[1]); w.w = cvt_pk_bf16(v1[2], v1[3]);
                    *(u32x4*)(rowp + bj * HALF) = w; } }
    }
};
struct EpiResid {
    static constexpr bool PERM = true;
    const float* res; float* out; bf16_t* hb; unsigned long long* rowss_next;
    __device__ __forceinline__ void operator()(const f32x4 (&acc)[2][2][4][2], const Unit& u, int wr, int wc, int fr, int fq) const {
        const int row0 = u.pm * BM + wr * 64 + fr, col0 = u.pn * BM + wc * 32 + 8 * fq;
#pragma unroll
        for (int ai = 0; ai < 2; ++ai)
#pragma unroll
            for (int m = 0; m < 4; ++m) { const int row = row0 + ai * HALF + m * 16; const size_t off = (size_t)row * 4096 + col0; float ss = 0.f;
#pragma unroll
                for (int bj = 0; bj < 2; ++bj) {
                    const f32x4 r0 = *(const f32x4*)(res + off + bj * HALF), r1 = *(const f32x4*)(res + off + bj * HALF + 4);
                    const f32x4 o0 = r0 + acc[ai][bj][m][0], o1 = r1 + acc[ai][bj][m][1];
                    *(f32x4*)(out + off + bj * HALF) = o0; *(f32x4*)(out + off + bj * HALF + 4) = o1;
                    ss += (o0[0] * o0[0] + o0[1] * o0[1]) + (o0[2] * o0[2] + o0[3] * o0[3]) + (o1[0] * o1[0] + o1[1] * o1[1]) + (o1[2] * o1[2] + o1[3] * o1[3]);
                    if (hb) { u32x4 w; w.x = cvt_pk_bf16(o0[0], o0[1]); w.y = cvt_pk_bf16(o0[2], o0[3]); w.z = cvt_pk_bf16(o1[0], o1[1]); w.w = cvt_pk_bf16(o1[2], o1[3]);
                        *(u32x4*)(hb + off + bj * HALF) = w; } }
                if (rowss_next) { ss += __shfl_xor(ss, 16); ss += __shfl_xor(ss, 32); if (fq == 0) atomicAdd(rowss_next + row, (unsigned long long)__float2ll_rn(ss * 16777216.0f)); }
                asm volatile("" ::: "memory"); }
    }
};
struct EpiPoolGrp {
    static constexpr bool PERM = true;
    bf16_t* O; const bf16_t* vz; const float* bg; const float* sc;
    __device__ __forceinline__ void operator()(const f32x4 (&acc)[2][2][4][2], const Unit& u, int wr, int wc, int fr, int fq) const {
        const int row0 = u.pm * BM + wr * 64 + fr, col0 = u.pn * BM + wc * 32 + 8 * fq;
        f32x4 bv[2][2], sv[2][2];
#pragma unroll
        for (int bj = 0; bj < 2; ++bj)
#pragma unroll
            for (int n = 0; n < 2; ++n) { bv[bj][n] = *(const f32x4*)(bg + col0 + bj * HALF + 4 * n); sv[bj][n] = *(const f32x4*)(sc + col0 + bj * HALF + 4 * n); }
#pragma unroll
        for (int ai = 0; ai < 2; ++ai)
#pragma unroll
            for (int m = 0; m < 4; ++m) { const int row = row0 + ai * HALF + m * 16;
#pragma unroll
                for (int bj = 0; bj < 2; ++bj) {
                    const u32x4 zz = *(const u32x4*)(vz + (size_t)row * 16384 + 8192 + col0 + bj * HALF);
                    const f32x4 v0 = (acc[ai][bj][m][0] + bv[bj][0]) * sv[bj][0], v1 = (acc[ai][bj][m][1] + bv[bj][1]) * sv[bj][1];
                    float z[8]; z[0] = __builtin_bit_cast(float, zz.x << 16); z[1] = __builtin_bit_cast(float, zz.x & 0xffff0000u); z[2] = __builtin_bit_cast(float, zz.y << 16); z[3] = __builtin_bit_cast(float, zz.y & 0xffff0000u);
                    z[4] = __builtin_bit_cast(float, zz.z << 16); z[5] = __builtin_bit_cast(float, zz.z & 0xffff0000u); z[6] = __builtin_bit_cast(float, zz.w << 16); z[7] = __builtin_bit_cast(float, zz.w & 0xffff0000u);
                    float o[8];
#pragma unroll
                    for (int j = 0; j < 4; ++j) { o[j] = v0[j] * (z[j] * __builtin_amdgcn_rcpf(1.f + __expf(-z[j]))); o[4 + j] = v1[j] * (z[4 + j] * __builtin_amdgcn_rcpf(1.f + __expf(-z[4 + j]))); }
                    u32x4 w; w.x = cvt_pk_bf16(o[0], o[1]); w.y = cvt_pk_bf16(o[2], o[3]); w.z = cvt_pk_bf16(o[4], o[5]); w.w = cvt_pk_bf16(o[6], o[7]);
                    *(u32x4*)(O + (size_t)row * 8192 + col0 + bj * HALF) = w; } }
    }
};
}

__device__ __forceinline__ void p0_transpose_item(const float* W, int K, int N, bf16* WT, const float* gain, LAS float* scr, int item, int lane) {
    const int nblk = N / 32, kb = item / nblk, nb = item % nblk, k0 = 64 * kb, n0 = 32 * nb;
    const int kr = lane >> 3, nc = (lane & 7) * 4;
    f32x4 v[8];
#pragma unroll
    for (int i = 0; i < 8; ++i) v[i] = __builtin_nontemporal_load((const f32x4*)(W + (size_t)(k0 + 8 * i + kr) * N + n0 + nc));
#pragma unroll
    for (int i = 0; i < 8; ++i) { const float g = gain ? gain[k0 + 8 * i + kr] : 1.0f; *(LAS f32x4*)(scr + (8 * i + kr) * 36 + nc) = v[i] * g; }
    LDS_WAIT(); asm volatile("" ::: "memory");
    const int c = lane & 7;
#pragma unroll
    for (int j = 0; j < 4; ++j) { const int n = (lane >> 3) + 8 * j; const LAS float* s = scr + (8 * c) * 36 + n;
        v4u o; o.x = pk2(s[0 * 36], s[1 * 36]); o.y = pk2(s[2 * 36], s[3 * 36]); o.z = pk2(s[4 * 36], s[5 * 36]); o.w = pk2(s[6 * 36], s[7 * 36]);
        *(GAS v4u*)(WT + (size_t)(n0 + n) * K + k0 + 8 * c) = o; }
    LDS_WAIT(); asm volatile("" ::: "memory");
}
struct AllIn { const float* in[30]; };
__device__ __forceinline__ const float* ldin(int i) { int off = i * 8; asm volatile("" : "+s"(off));
    const char __attribute__((address_space(4)))* kp = (const char __attribute__((address_space(4)))*)__builtin_amdgcn_kernarg_segment_ptr();
    return *(const float* const __attribute__((address_space(4)))*)(kp + off); }
__device__ __forceinline__ void p0_prologue(Frame& F, const float* x, bf16* hb, unsigned long long* rowss0) {
    LAS float* scr = (LAS float*)(F.lds + RING_OFF + F.wave * 16384);
    const int gw = blockIdx.x * NWAVES + F.wave, NGW = F.G * NWAVES;
    unsigned char* ws = F.ws;
    constexpr int I_SIN = (D / 64) * (SSD_IN / 32), I_SOUT = (SSD_DI / 64) * (D / 32), I_PIN = (D / 64) * (16384 / 32), I_PG = (2048 / 64) * (2048 / 32), I_POUT = I_SOUT, I_MIN = I_PIN, I_MOUT = (D / 64) * (D / 32);
    constexpr int NITEMS = 2 * I_SIN + 2 * I_SOUT + I_PIN + 4 * I_PG + I_POUT + I_MIN + I_MOUT;
    for (int it = gw; it < NITEMS; it += NGW) {
        int r = it;
        if (r < I_SIN) { p0_transpose_item(ldin(2), D, SSD_IN, (bf16*)(ws + WS_W_SSD0_IN), ldin(1), scr, r, F.lane); continue; } r -= I_SIN;
        if (r < I_SOUT) { p0_transpose_item(ldin(9), SSD_DI, D, (bf16*)(ws + WS_W_SSD0_OUT), nullptr, scr, r, F.lane); continue; } r -= I_SOUT;
        if (r < I_PIN) { p0_transpose_item(ldin(11), D, 16384, (bf16*)(ws + WS_W_POOL_IN), ldin(10), scr, r, F.lane); continue; } r -= I_PIN;
        if (r < 4 * I_PG) { const int g = r / I_PG; p0_transpose_item(ldin(12) + (size_t)g * 2048 * 2048, 2048, 2048, (bf16*)(ws + WS_W_POOL_GRP) + (size_t)g * 2048 * 2048, nullptr, scr, r % I_PG, F.lane); continue; } r -= 4 * I_PG;
        if (r < I_POUT) { p0_transpose_item(ldin(15), POOL_W, D, (bf16*)(ws + WS_W_POOL_OUT), nullptr, scr, r, F.lane); continue; } r -= I_POUT;
        if (r < I_MIN) { p0_transpose_item(ldin(17), D, 16384, (bf16*)(ws + WS_W_MOBA_IN), ldin(16), scr, r, F.lane); continue; } r -= I_MIN;
        if (r < I_MOUT) { p0_transpose_item(ldin(20), D, D, (bf16*)(ws + WS_W_MOBA_OUT), nullptr, scr, r, F.lane); continue; } r -= I_MOUT;
        if (r < I_SIN) { p0_transpose_item(ldin(22), D, SSD_IN, (bf16*)(ws + WS_W_SSD3_IN), ldin(21), scr, r, F.lane); continue; } r -= I_SIN;
        p0_transpose_item(ldin(29), SSD_DI, D, (bf16*)(ws + WS_W_SSD3_OUT), nullptr, scr, r, F.lane);
    }
    for (int m = gw; m < M; m += NGW) {
        const GAS f32x4* xr = (const GAS f32x4*)(x + (size_t)m * D) + F.lane; GAS v2u* o8 = (GAS v2u*)(hb + (size_t)m * D) + F.lane; float s = 0.f;
#pragma unroll 4
        for (int j = 0; j < 16; ++j) { const f32x4 v = xr[64 * j]; s += (v.x * v.x + v.y * v.y) + (v.z * v.z + v.w * v.w); v2u w; w.x = pk2(v.x, v.y); w.y = pk2(v.z, v.w); o8[64 * j] = w; }
        s = wave_sum(s); if (F.lane == 0) rowss0[m] = (unsigned long long)__float2ll_rn(s * 16777216.0f);
    }
}

__device__ __forceinline__ void dt_phase(Frame& F, const bf16* A, const bf16* Wdt, const unsigned long long* rowss, const float* dt_bias, float* dt_out) {
    const int lane = F.lane, r = lane & 31, hh = lane >> 5;
    LAS float* P = (LAS float*)(F.lds + RING_OFF);
    for (int u = blockIdx.x; u < M / 32; u += F.G) {
        const bf16* ap = A + (size_t)(u * 32 + r) * D + F.wave * 512 + hh * 8;
        const bf16* bp = Wdt + (size_t)r * D + F.wave * 512 + hh * 8;
        f32x16 acc[4];
#pragma unroll
        for (int nb = 0; nb < 4; ++nb) acc[nb] = zero16();
#pragma unroll 4
        for (int ks = 0; ks < 32; ++ks) {
            const bf16x8 a = *(const bf16x8*)(ap + ks * 16);
#pragma unroll
            for (int nb = 0; nb < 4; ++nb) { const bf16x8 b = *(const bf16x8*)(bp + (size_t)nb * 32 * D + ks * 16); acc[nb] = __builtin_amdgcn_mfma_f32_32x32x16_bf16(a, b, acc[nb], 0, 0, 0); }
        }
#pragma unroll
        for (int nb = 0; nb < 4; ++nb)
#pragma unroll
            for (int j = 0; j < 16; ++j) { const int row = (j & 3) + 8 * (j >> 2) + 4 * hh; P[F.wave * 4096 + row * 128 + nb * 32 + r] = acc[nb][j]; }
        __syncthreads();
#pragma unroll
        for (int j = 0; j < 8; ++j) { const int idx = F.tid + 512 * j; float s = 0.f;
#pragma unroll
            for (int w = 0; w < 8; ++w) s += P[w * 4096 + idx];
            const int row = u * 32 + (idx >> 7), col = idx & 127;
            const float v = s * rsqrtf((float)rowss[row] * (1.0f / (4096.0f * 16777216.0f)) + RMS_EPS) + dt_bias[col];
            dt_out[(size_t)row * 128 + col] = fmaxf(v, 0.f) + log1pf(__expf(-fabsf(v))); }
        __syncthreads();
    }
}
__device__ __forceinline__ int pi32(int r) { return (r & ~0xC) | ((r & 4) << 1) | ((r & 8) >> 1); }
__device__ __forceinline__ void conv_phase(Frame& F, const bf16* zx, const float* cw, const float* cb, bf16* xc, bf16* xtile, bf16* btT, bf16* btok, bf16* ctok) {
    constexpr int NCG = SSD_CONV / 8, RUN = 16, NIT = (M / RUN) * NCG;
    LAS unsigned char* STG = F.lds + RING_OFF + F.wave * 8192;
    for (int it = blockIdx.x * 512 + F.tid; it < NIT; it += F.G * 512) {
        const int cg = it % NCG, tr = it / NCG, c0 = cg * 8, t0 = tr * RUN;
        v4u rows[RUN + 3];
#pragma unroll
        for (int i = 0; i < RUN + 3; ++i) { const int t = t0 - 3 + i; if (t >= 0) rows[i] = *(const v4u*)(zx + (size_t)t * SSD_MAIN + SSD_DI + c0); else { rows[i].x = 0u; rows[i].y = 0u; rows[i].z = 0u; rows[i].w = 0u; } }
        float w[4][8], b[8];
#pragma unroll
        for (int k = 0; k < 4; ++k) { const f32x4 a = *(const f32x4*)(cw + k * SSD_CONV + c0), bq = *(const f32x4*)(cw + k * SSD_CONV + c0 + 4);
#pragma unroll
            for (int j = 0; j < 4; ++j) { w[k][j] = a[j]; w[k][4 + j] = bq[j]; } }
        { const f32x4 a = *(const f32x4*)(cb + c0), bq = *(const f32x4*)(cb + c0 + 4);
#pragma unroll
          for (int j = 0; j < 4; ++j) { b[j] = a[j]; b[4 + j] = bq[j]; } }
        const int kind = c0 < SSD_DI ? 0 : (c0 < SSD_DI + 1024 ? 1 : 2);
        const int chunk = t0 >> 7, tl0 = t0 & 127;
        unsigned char* ptok; unsigned char* pch;
        if (kind == 0) { const int h = c0 >> 6, pt = (c0 >> 5) & 1, r0 = c0 & 31;
            ptok = (unsigned char*)(xc + (size_t)t0 * SSD_DI + c0);
            pch = (unsigned char*)(xtile + ((((size_t)chunk * 128 + h) * 2 + pt) * 8 + (tl0 >> 4)) * 512 + (size_t)r0 * 8); }
        else { const int n0 = (c0 - SSD_DI) & 127, g = ((c0 - SSD_DI) >> 7) & 7, ksN = n0 >> 4, h2N = (n0 >> 3) & 1, nt = n0 >> 5;
            ptok = (unsigned char*)((kind == 1 ? btok : ctok) + ((((size_t)chunk * 8 + g) * 4 + (tl0 >> 5)) * 8 + ksN) * 512 + (size_t)((tl0 & 16) + 32 * h2N) * 8);
            pch = (unsigned char*)(btT + ((((size_t)chunk * 8 + g) * 4 + nt) * 8 + (tl0 >> 4)) * 512 + (size_t)((n0 & 16) | ((n0 & 8) >> 1)) * 8); }
#pragma unroll
        for (int tb = 0; tb < RUN; tb += 8) {
            unsigned yp[8][4];
#pragma unroll
            for (int i = 0; i < 8; ++i) {
                float y[8];
#pragma unroll
                for (int j = 0; j < 8; ++j) { float a = b[j];
#pragma unroll
                    for (int k = 0; k < 4; ++k) { const v4u q = rows[tb + i + k]; const unsigned wd = (j >> 1) == 0 ? q.x : (j >> 1) == 1 ? q.y : (j >> 1) == 2 ? q.z : q.w; a += w[k][j] * ((j & 1) ? bfhi(wd) : bflo(wd)); }
                    y[j] = silu_f(a); }
                v4u o; o.x = pk2(y[0], y[1]); o.y = pk2(y[2], y[3]); o.z = pk2(y[4], y[5]); o.w = pk2(y[6], y[7]);
                const int ti = tb + i, pti = (ti & 3) | ((ti & 4) << 1) | ((ti & 8) >> 1);
                if (kind == 1) *(v4u*)(ptok + pti * 16) = o;
                else if (kind == 2) *(v4u*)(ptok + ti * 16) = o;
#pragma unroll
                for (int j = 0; j < 8; ++j) { const unsigned hb_ = f2bf(y[j]); if (i & 1) yp[j][i >> 1] |= hb_ << 16; else yp[j][i >> 1] = hb_; }
            }
            if (kind == 0) {
#pragma unroll
                for (int j = 0; j < 8; ++j) { v4u o; o.x = yp[j][0]; o.y = yp[j][1]; o.z = yp[j][2]; o.w = yp[j][3]; *(LAS v4u*)(STG + (F.lane * 8 + j) * 16) = o; }
                LDS_WAIT(); asm volatile("" ::: "memory");
                bf16* xbase = xtile + (((size_t)chunk * 256 + (c0 >> 5) - ((F.lane * 8) >> 5)) * 8 + (tl0 >> 4)) * 512 + (size_t)((tb >> 3) * 32) * 8;
#pragma unroll
                for (int s_ = 0; s_ < 8; ++s_) { const int hpl = 2 * s_ + (F.lane >> 5), slot = F.lane & 31;
                    const v4u o = *(const LAS v4u*)(STG + (hpl * 32 + slot) * 16);
                    *(v4u*)(xbase + (size_t)hpl * 8 * 512 + slot * 8) = o; }
                LDS_WAIT(); asm volatile("" ::: "memory");
            } else if (kind == 1) {
#pragma unroll
                for (int j = 0; j < 8; ++j) { v4u o; o.x = yp[j][0]; o.y = yp[j][1]; o.z = yp[j][2]; o.w = yp[j][3];
                    *(v4u*)(pch + (((j & 4) << 1) | (j & 3)) * 16 + (tb >> 3) * 512) = o; } }
        }
    }
}
__device__ __forceinline__ void ssd_s1_phase(Frame& F, const bf16* xtile, const bf16* btT, const float* dt, const float* a_log, bf16* states, float* decay) {
    const int lane = F.lane, h2 = lane >> 5;
    LAS float* w1 = (LAS float*)(F.lds + RING_OFF) + F.wave * 256;
    for (int u = blockIdx.x; u < 64 * SSD_NG; u += F.G) {
        const int c = u >> 3, g = u & 7, t0 = c * 128;
        float dec_out[2];
#pragma unroll
        for (int hh = 0; hh < 2; ++hh) { const int h = g * 16 + F.wave * 2 + hh; const float A = -__expf(a_log[h]);
            const float d0 = dt[(size_t)(t0 + 2 * lane) * 128 + h], d1 = dt[(size_t)(t0 + 2 * lane + 1) * 128 + h];
            const float a0 = d0 * A, a1 = d1 * A; float s = a0 + a1;
#pragma unroll
            for (int o = 1; o < 64; o <<= 1) { const float v = __shfl_up(s, o); if (lane >= o) s += v; }
            const float cs1 = s, cs0 = s - a1; const float cend = __shfl(s, 63);
            w1[hh * 128 + 2 * lane] = d0 * __expf(cend - cs0); w1[hh * 128 + 2 * lane + 1] = d1 * __expf(cend - cs1);
            dec_out[hh] = __expf(cend); }
        if (lane == 0) { decay[(c * 8 + g) * 32 + F.wave * 2] = dec_out[0]; decay[(c * 8 + g) * 32 + F.wave * 2 + 1] = dec_out[1]; }
        LDS_WAIT(); asm volatile("" ::: "memory");
#pragma nounroll
        for (int item = 0; item < 4; ++item) { const int hh = item >> 1, pt = item & 1, h = g * 16 + F.wave * 2 + hh;
            const bf16* xp = xtile + ((((size_t)c * 128 + h) * 2 + pt) * 8) * 512 + (size_t)lane * 8;
            const bf16* bp = btT + ((((size_t)c * 8 + g) * 4) * 8) * 512 + (size_t)lane * 8;
            bf16x8 Xf[8];
#pragma unroll
            for (int ks = 0; ks < 8; ++ks) Xf[ks] = *(const bf16x8*)(xp + ks * 512);
#pragma unroll
            for (int ks = 0; ks < 8; ++ks) { const v4u aq = __builtin_bit_cast(v4u, Xf[ks]);
                const f32x4 wa = *(const LAS f32x4*)(w1 + hh * 128 + ks * 16 + h2 * 8), wb = *(const LAS f32x4*)(w1 + hh * 128 + ks * 16 + h2 * 8 + 4);
                v4u as; as.x = pk2(bflo(aq.x) * wa.x, bfhi(aq.x) * wa.y); as.y = pk2(bflo(aq.y) * wa.z, bfhi(aq.y) * wa.w); as.z = pk2(bflo(aq.z) * wb.x, bfhi(aq.z) * wb.y); as.w = pk2(bflo(aq.w) * wb.z, bfhi(aq.w) * wb.w);
                Xf[ks] = __builtin_bit_cast(bf16x8, as); }
            bf16* sp = states + ((((size_t)c * 128 + h) * 2 + pt) * 8) * 512 + (size_t)lane * 8;
#pragma unroll
            for (int nt = 0; nt < 4; ++nt) { bf16x8 Bf[8];
#pragma unroll
                for (int ks = 0; ks < 8; ++ks) Bf[ks] = *(const bf16x8*)(bp + (size_t)(nt * 8 + ks) * 512);
                f32x16 acc = zero16();
#pragma unroll
                for (int ks = 0; ks < 8; ++ks) acc = __builtin_amdgcn_mfma_f32_32x32x16_bf16(Bf[ks], Xf[ks], acc, 0, 0, 0);
#pragma unroll
                for (int kk = 0; kk < 2; ++kk) { v4u o; o.x = pk2(acc[8 * kk], acc[8 * kk + 1]); o.y = pk2(acc[8 * kk + 2], acc[8 * kk + 3]); o.z = pk2(acc[8 * kk + 4], acc[8 * kk + 5]); o.w = pk2(acc[8 * kk + 6], acc[8 * kk + 7]);
                    *(v4u*)(sp + (size_t)(2 * nt + kk) * 512) = o; } }
        }
        LDS_WAIT(); asm volatile("" ::: "memory");
    }
}
__device__ __forceinline__ void ssd_s2_phase(Frame& F, bf16* states, const float* decay) {
    for (int it = blockIdx.x * 512 + F.tid; it < SSD_NH * 64 * 16; it += F.G * 512) {
        const int h = it >> 10; float H[8];
#pragma unroll
        for (int j = 0; j < 8; ++j) H[j] = 0.f;
        v4u* sp = (v4u*)(states + (size_t)it * 8);
#pragma unroll 8
        for (int c = 0; c < 64; ++c) { const v4u q = sp[(size_t)c * (128 * 64 * 16)]; const float dec = decay[(c * 8 + (h >> 4)) * 32 + (h & 15)];
            v4u o; o.x = pk2(H[0], H[1]); o.y = pk2(H[2], H[3]); o.z = pk2(H[4], H[5]); o.w = pk2(H[6], H[7]);
            sp[(size_t)c * (128 * 64 * 16)] = o;
            H[0] = H[0] * dec + bflo(q.x); H[1] = H[1] * dec + bfhi(q.x); H[2] = H[2] * dec + bflo(q.y); H[3] = H[3] * dec + bfhi(q.y);
            H[4] = H[4] * dec + bflo(q.z); H[5] = H[5] * dec + bfhi(q.z); H[6] = H[6] * dec + bflo(q.w); H[7] = H[7] * dec + bfhi(q.w); }
    }
}
__device__ __forceinline__ void ssd_s3_phase(Frame& F, const bf16* xc, const bf16* xtile, const bf16* btok, const bf16* ctok, const bf16* zx, const float* dt, const float* a_log, const float* dsk, float* ssg, const bf16* states, bf16* ybuf) {
    const int lane = F.lane, r = lane & 31, h2 = lane >> 5, li = F.wave >> 1, hhalf = F.wave & 1;
    LAS float* cst = (LAS float*)(F.lds + RING_OFF);
    LAS float* dtt = cst + 2048;
    LAS float* ssw = dtt + 2048;
    LAS float* TT = (LAS float*)(F.lds + RING_OFF + 20480) + F.wave * (32 * 36);
    const int el = lane >> 1, eh = lane & 1;
    for (int u = blockIdx.x; u < 64 * SSD_NG; u += F.G) {
        const int c = u >> 3, g = u & 7, t0 = c * 128;
#pragma unroll
        for (int hh = 0; hh < 2; ++hh) { const int hl = F.wave * 2 + hh, h = g * 16 + hl; const float A = -__expf(a_log[h]);
            const float d0 = dt[(size_t)(t0 + 2 * lane) * 128 + h], d1 = dt[(size_t)(t0 + 2 * lane + 1) * 128 + h];
            const float a1 = d1 * A; float s = d0 * A + a1;
#pragma unroll
            for (int o = 1; o < 64; o <<= 1) { const float v = __shfl_up(s, o); if (lane >= o) s += v; }
            cst[hl * 128 + 2 * lane] = s - a1; cst[hl * 128 + 2 * lane + 1] = s; dtt[hl * 128 + 2 * lane] = d0; dtt[hl * 128 + 2 * lane + 1] = d1; }
        __syncthreads();
        const bf16* cp = ctok + ((((size_t)c * 8 + g) * 4 + li) * 8) * 512 + (size_t)lane * 8;
        f32x16 CBt[4];
        { bf16x8 Cf[8];
#pragma unroll
          for (int ks = 0; ks < 8; ++ks) Cf[ks] = *(const bf16x8*)(cp + ks * 512);
#pragma unroll
          for (int si = 0; si < 4; ++si) {
            if (si <= li) { CBt[si] = zero16(); const bf16* bp = btok + ((((size_t)c * 8 + g) * 4 + si) * 8) * 512 + (size_t)lane * 8; bf16x8 Bf[8];
#pragma unroll
                for (int ks = 0; ks < 8; ++ks) Bf[ks] = *(const bf16x8*)(bp + ks * 512);
#pragma unroll
                for (int ks = 0; ks < 8; ++ks) CBt[si] = __builtin_amdgcn_mfma_f32_32x32x16_bf16(Bf[ks], Cf[ks], CBt[si], 0, 0, 0); }
          } }
        float ssq = 0.f;
        LAS unsigned char* HX = F.lds + RING_OFF + 57344 + hhalf * 32768;
        bf16x8 st[4];
        { const int h = g * 16 + hhalf * 8; const bf16* hp = states + ((((size_t)c * 128 + h) * 2) * 8 + li * 4) * 512 + (size_t)lane * 8;
#pragma unroll
          for (int f = 0; f < 4; ++f) st[f] = *(const bf16x8*)(hp + f * 512); }
#pragma nounroll
        for (int hq = 0; hq < 8; ++hq) {
            const int hl = hhalf * 8 + hq, h = g * 16 + hl;
            const float csl = cst[hl * 128 + 32 * li + r], Dh = dsk[h];
            __syncthreads();
            bf16x8 Cf[8];
            { const bf16* xp = xtile + ((((size_t)c * 128 + h) * 2) * 8 + li * 4) * 512 + (size_t)lane * 8; bf16x8 sx[4];
#pragma unroll
              for (int f = 0; f < 4; ++f) sx[f] = *(const bf16x8*)(xp + f * 512);
#pragma unroll
              for (int ks = 0; ks < 8; ++ks) Cf[ks] = *(const bf16x8*)(cp + ks * 512);
#pragma unroll
              for (int f = 0; f < 4; ++f) { *(LAS bf16x8*)(HX + (li * 4 + f) * 1024 + lane * 16) = st[f]; *(LAS bf16x8*)(HX + 16384 + (li * 4 + f) * 1024 + lane * 16) = sx[f]; } }
            { const int hn = g * 16 + hhalf * 8 + (hq < 7 ? hq + 1 : hq);
              const bf16* hp = states + ((((size_t)c * 128 + hn) * 2) * 8 + li * 4) * 512 + (size_t)lane * 8;
#pragma unroll
              for (int f = 0; f < 4; ++f) st[f] = *(const bf16x8*)(hp + f * 512); }
            __syncthreads();
            f32x16 acc[2];
#pragma unroll
            for (int pt = 0; pt < 2; ++pt) {
                acc[pt] = zero16();
#pragma unroll
                for (int ks = 0; ks < 8; ++ks) { const bf16x8 hf = *(const LAS bf16x8*)(HX + (pt * 8 + ks) * 1024 + lane * 16); acc[pt] = __builtin_amdgcn_mfma_f32_32x32x16_bf16(Cf[ks], hf, acc[pt], 0, 0, 0); }
            }
#pragma unroll
            for (int j = 0; j < 16; ++j) { const float e = __expf(cst[hl * 128 + 32 * li + (j & 3) + 8 * (j >> 2) + 4 * h2]); acc[0][j] *= e; acc[1][j] *= e; }
#pragma unroll
            for (int si = 0; si < 4; ++si) {
                if (si <= li) {
#pragma unroll
                    for (int kk = 0; kk < 2; ++kk) {
                        const int sl = 16 * kk + 8 * h2, s0 = 32 * si + sl;
                        const f32x4 ca = *(const LAS f32x4*)(cst + hl * 128 + s0), cb = *(const LAS f32x4*)(cst + hl * 128 + s0 + 4);
                        const f32x4 da = *(const LAS f32x4*)(dtt + hl * 128 + s0), db = *(const LAS f32x4*)(dtt + hl * 128 + s0 + 4);
                        float gv[8];
#pragma unroll
                        for (int jj = 0; jj < 8; ++jj) { const float cs_s = jj < 4 ? ca[jj & 3] : cb[jj & 3], dt_s = jj < 4 ? da[jj & 3] : db[jj & 3];
                            float v = CBt[si][8 * kk + jj] * __expf(fminf(csl - cs_s, 0.f)) * dt_s;
                            if (si == li && sl + jj > r) v = 0.f;
                            if (si == li && sl + jj == r) v += Dh;
                            gv[jj] = v; }
                        v4u gq; gq.x = pk2(gv[0], gv[1]); gq.y = pk2(gv[2], gv[3]); gq.z = pk2(gv[4], gv[5]); gq.w = pk2(gv[6], gv[7]);
                        const bf16x8 Gf = __builtin_bit_cast(bf16x8, gq);
#pragma unroll
                        for (int pt = 0; pt < 2; ++pt) { const bf16x8 xf = *(const LAS bf16x8*)(HX + 16384 + (pt * 8 + 2 * si + kk) * 1024 + lane * 16);
                            acc[pt] = __builtin_amdgcn_mfma_f32_32x32x16_bf16(Gf, xf, acc[pt], 0, 0, 0); }
                    }
                }
            }
#pragma unroll
            for (int pt = 0; pt < 2; ++pt) {
#pragma unroll
                for (int j = 0; j < 16; ++j) TT[((j & 3) + 8 * (j >> 2) + 4 * h2) * 36 + r] = acc[pt][j];
                LDS_WAIT(); asm volatile("" ::: "memory");
                const size_t t = (size_t)(t0 + 32 * li + el); const int ch = h * 64 + pt * 32 + eh * 16;
                const v4u z0 = *(const v4u*)(zx + t * SSD_MAIN + ch), z1 = *(const v4u*)(zx + t * SSD_MAIN + ch + 8);
                const f32x4 a0 = *(const LAS f32x4*)(TT + el * 36 + eh * 16), a1 = *(const LAS f32x4*)(TT + el * 36 + eh * 16 + 4), a2 = *(const LAS f32x4*)(TT + el * 36 + eh * 16 + 8), a3 = *(const LAS f32x4*)(TT + el * 36 + eh * 16 + 12);
                float yv[16];
#define S3_Y(i, av, xw, zw, hi) { const float zs_ = (hi) ? bfhi(zw) : bflo(zw); const float y_ = (av) * silu_f(zs_); yv[i] = y_; ssq += y_ * y_; }
                S3_Y(0, a0.x, 0, z0.x, 0) S3_Y(1, a0.y, 0, z0.x, 1) S3_Y(2, a0.z, 0, z0.y, 0) S3_Y(3, a0.w, 0, z0.y, 1)
                S3_Y(4, a1.x, 0, z0.z, 0) S3_Y(5, a1.y, 0, z0.z, 1) S3_Y(6, a1.z, 0, z0.w, 0) S3_Y(7, a1.w, 0, z0.w, 1)
                S3_Y(8, a2.x, 0, z1.x, 0) S3_Y(9, a2.y, 0, z1.x, 1) S3_Y(10, a2.z, 0, z1.y, 0) S3_Y(11, a2.w, 0, z1.y, 1)
                S3_Y(12, a3.x, 0, z1.z, 0) S3_Y(13, a3.y, 0, z1.z, 1) S3_Y(14, a3.z, 0, z1.w, 0) S3_Y(15, a3.w, 0, z1.w, 1)
#undef S3_Y
                v4u o0, o1; o0.x = pk2(yv[0], yv[1]); o0.y = pk2(yv[2], yv[3]); o0.z = pk2(yv[4], yv[5]); o0.w = pk2(yv[6], yv[7]); o1.x = pk2(yv[8], yv[9]); o1.y = pk2(yv[10], yv[11]); o1.z = pk2(yv[12], yv[13]); o1.w = pk2(yv[14], yv[15]);
                *(v4u*)(ybuf + t * SSD_DI + ch) = o0; *(v4u*)(ybuf + t * SSD_DI + ch + 8) = o1;
                LDS_WAIT(); asm volatile("" ::: "memory");
            }
        }
        ssq += __shfl_xor(ssq, 1);
        if (eh == 0) ssw[hhalf * 128 + 32 * li + el] = ssq;
        __syncthreads();
        if (F.tid < 128) ssg[(size_t)g * M + t0 + F.tid] = ssw[F.tid] + ssw[128 + F.tid];
        __syncthreads();
    }
}
__device__ __forceinline__ void ssd_norm_phase(Frame& F, bf16* ybuf, const float* ssg, const float* norm_w) {
    const int gt = blockIdx.x * 512 + F.tid, chunk = gt & 1023, ch0 = chunk * 8, g = ch0 >> 10;
    const f32x4 wa = *(const f32x4*)(norm_w + ch0), wb = *(const f32x4*)(norm_w + ch0 + 4);
    const int tstep = (F.G * 512) >> 10;
    for (int t = gt >> 10; t < M; t += 4 * tstep) {
        v4u q[4]; float rs[4];
#pragma unroll
        for (int i = 0; i < 4; ++i) { const int ti = t + i * tstep; if (ti < M) { q[i] = *(const v4u*)(ybuf + (size_t)ti * SSD_DI + ch0); rs[i] = ssg[(size_t)g * M + ti]; } }
#pragma unroll
        for (int i = 0; i < 4; ++i) { const int ti = t + i * tstep; if (ti < M) { const float r_ = rsqrtf(rs[i] * (1.0f / 1024.0f) + RMS_EPS); v4u o;
            o.x = pk2(bflo(q[i].x) * r_ * wa.x, bfhi(q[i].x) * r_ * wa.y); o.y = pk2(bflo(q[i].y) * r_ * wa.z, bfhi(q[i].y) * r_ * wa.w);
            o.z = pk2(bflo(q[i].z) * r_ * wb.x, bfhi(q[i].z) * r_ * wb.y); o.w = pk2(bflo(q[i].w) * r_ * wb.z, bfhi(q[i].w) * r_ * wb.w);
            *(v4u*)(ybuf + (size_t)ti * SSD_DI + ch0) = o; } }
    }
}
template <int W> __device__ __forceinline__ void pool_item(const bf16* vz, bf16* dbuf, int c0, int t0) {
    constexpr int RUN = W == 16 ? 8 : 16, NR = RUN + W - 1;
    v4u rows[NR];
#pragma unroll
    for (int i = 0; i < NR; ++i) { const int t = t0 - (W - 1) + i; if (t >= 0) rows[i] = *(const v4u*)(vz + (size_t)t * 16384 + c0); else { rows[i].x = 0u; rows[i].y = 0u; rows[i].z = 0u; rows[i].w = 0u; } }
    float S[8];
#pragma unroll
    for (int j = 0; j < 8; ++j) S[j] = 0.f;
#define POOL_ACC(q, sgn) do { S[0] += sgn bflo((q).x); S[1] += sgn bfhi((q).x); S[2] += sgn bflo((q).y); S[3] += sgn bfhi((q).y); S[4] += sgn bflo((q).z); S[5] += sgn bfhi((q).z); S[6] += sgn bflo((q).w); S[7] += sgn bfhi((q).w); } while (0)
#pragma unroll
    for (int i = 0; i < W - 1; ++i) POOL_ACC(rows[i], +);
#pragma unroll
    for (int i = 0; i < RUN; ++i) { const int t = t0 + i; const v4u q = rows[W - 1 + i]; POOL_ACC(q, +);
        const float inv = __builtin_amdgcn_rcpf((float)(t + 1 < W ? t + 1 : W));
        v4u o; o.x = pk2(S[0] * inv - bflo(q.x), S[1] * inv - bfhi(q.x)); o.y = pk2(S[2] * inv - bflo(q.y), S[3] * inv - bfhi(q.y)); o.z = pk2(S[4] * inv - bflo(q.z), S[5] * inv - bfhi(q.z)); o.w = pk2(S[6] * inv - bflo(q.w), S[7] * inv - bfhi(q.w));
        *(v4u*)(dbuf + (size_t)t * POOL_W + c0) = o;
        POOL_ACC(rows[i], -); }
#undef POOL_ACC
}
template <int W> __device__ __forceinline__ void pool_group(Frame& F, const bf16* vz, bf16* dbuf, int gsel) {
    constexpr int NCG = POOL_GD / 8, RUN = W == 16 ? 8 : 16, NIT = (M / RUN) * NCG;
    for (int it = blockIdx.x * 512 + F.tid; it < NIT; it += F.G * 512) pool_item<W>(vz, dbuf, gsel * POOL_GD + (it % NCG) * 8, (it / NCG) * RUN);
}
__device__ __forceinline__ void pool_phase(Frame& F, const bf16* vz, bf16* dbuf) {
    pool_group<2>(F, vz, dbuf, 0); asm volatile("" ::: "memory");
    pool_group<4>(F, vz, dbuf, 1); asm volatile("" ::: "memory");
    pool_group<8>(F, vz, dbuf, 2); asm volatile("" ::: "memory");
    pool_group<16>(F, vz, dbuf, 3);
}

typedef short s16x4 __attribute__((ext_vector_type(4)));
__device__ __forceinline__ void qknorm_phase(Frame& F, bf16* qkvg, const float* qw, const float* kw, bf16* kmb, bf16* ktile, bf16* vtile) {
    LAS float* red = (LAS float*)(F.lds + 132096);
    LAS unsigned char* KL = F.lds + RING_OFF + F.wave * 16384;
    LAS unsigned char* VL = KL + 8192;
    const int lane = F.lane, r = lane & 31, h2 = lane >> 5;
    const int pr = (r & ~0xC) | ((r & 4) << 1) | ((r & 8) >> 1);
    const float qw0 = qw[2 * lane], qw1 = qw[2 * lane + 1], kw0 = kw[2 * lane], kw1 = kw[2 * lane + 1];
    for (int it = blockIdx.x; it < MOBA_NB * MOBA_H; it += F.G) {
        const int n = it / MOBA_H, h = it % MOBA_H; float ks0 = 0.f, ks1 = 0.f; const int tb = n * 256 + F.wave * 32;
#pragma unroll 8
        for (int i = 0; i < 32; ++i) { const int t = tb + i;
            unsigned* qp = (unsigned*)(qkvg + (size_t)t * 16384 + h * 128) + lane;
            const unsigned qv = *qp, kv = *((const unsigned*)(qkvg + (size_t)t * 16384 + 4096 + h * 128) + lane), vv = *((const unsigned*)(qkvg + (size_t)t * 16384 + 8192 + h * 128) + lane);
            const float q0 = bflo(qv), q1 = bfhi(qv), k0 = bflo(kv), k1 = bfhi(kv);
            const float qs = wave_sum(q0 * q0 + q1 * q1), ks = wave_sum(k0 * k0 + k1 * k1);
            const float qr = rsqrtf(qs * (1.0f / 128.0f) + RMS_EPS), kr = rsqrtf(ks * (1.0f / 128.0f) + RMS_EPS);
            const unsigned qo = pk2(q0 * qr * qw0, q1 * qr * qw1), ko = pk2(k0 * kr * kw0, k1 * kr * kw1);
            *qp = qo; ks0 += bflo(ko); ks1 += bfhi(ko);
            *(LAS unsigned*)(KL + i * 256 + lane * 4) = ko; *(LAS unsigned*)(VL + i * 256 + lane * 4) = vv; }
        red[F.wave * 128 + 2 * lane] = ks0; red[F.wave * 128 + 2 * lane + 1] = ks1;
        LDS_WAIT(); asm volatile("" ::: "memory");
        { const size_t tbase = ((((size_t)h * MOBA_NB + n) * 8 + F.wave) * 8) * 512 + (size_t)lane * 8;
#pragma unroll
          for (int ks = 0; ks < 8; ++ks) *(v4u*)(ktile + tbase + (size_t)ks * 512) = *(const LAS v4u*)(KL + pr * 256 + (16 * ks + 8 * h2) * 2);
          const int qq = (lane & 15) >> 2, pp = lane & 3, b16 = (lane >> 4) & 1;
#pragma unroll
          for (int kk = 0; kk < 2; ++kk)
#pragma unroll
              for (int dt = 0; dt < 4; ++dt) {
                  const LAS unsigned char* a0 = VL + (16 * kk + 8 * h2 + qq) * 256 + (dt * 32 + 16 * b16 + 4 * pp) * 2;
                  const s16x4 lo = __builtin_amdgcn_ds_read_tr16_b64_v4i16((LAS s16x4*)a0), hi = __builtin_amdgcn_ds_read_tr16_b64_v4i16((LAS s16x4*)(a0 + 4 * 256));
                  bf16x8 f; f[0] = lo[0]; f[1] = lo[1]; f[2] = lo[2]; f[3] = lo[3]; f[4] = hi[0]; f[5] = hi[1]; f[6] = hi[2]; f[7] = hi[3];
                  *(bf16x8*)(vtile + tbase + (size_t)(kk * 4 + dt) * 512) = f; } }
        __syncthreads();
        if (F.tid < 128) { float s = 0.f;
#pragma unroll
            for (int w = 0; w < 8; ++w) s += red[w * 128 + F.tid];
            kmb[((size_t)h * MOBA_NB + n) * 128 + F.tid] = (bf16)f2bf(s * (1.0f / 256.0f)); }
        __syncthreads();
    }
}

__device__ __forceinline__ void moba_gate_phase(Frame& F, const bf16* qkvg, const bf16* kmb, int* cntg, unsigned short* listg, unsigned char* selvg) {
    const int lane = F.lane, r = lane & 31, h2 = lane >> 5;
    LAS unsigned short* LIST = (LAS unsigned short*)(F.lds + RING_OFF);
    LAS int* CNTW = (LAS int*)(F.lds + RING_OFF + 16384);
    LAS int* TOT = (LAS int*)(F.lds + RING_OFF + 17408);
    for (int u = blockIdx.x; u < MOBA_H * MOBA_NB; u += F.G) {
        const int h = u >> 5, j = u & 31;
        int s0 = -1, s1 = -1, s2 = -1;
        { const bf16* qp = qkvg + (size_t)(j * 256 + F.wave * 32 + r) * 16384 + h * 128 + h2 * 8; const bf16* kp = kmb + ((size_t)h * MOBA_NB + r) * 128 + h2 * 8;
          f32x16 gs = zero16();
#pragma unroll
          for (int ks = 0; ks < 8; ++ks) { const bf16x8 a = *(const bf16x8*)(kp + ks * 16), b = *(const bf16x8*)(qp + ks * 16); gs = __builtin_amdgcn_mfma_f32_32x32x16_bf16(a, b, gs, 0, 0, 0); }
          float v0 = -INFINITY, v1 = -INFINITY, v2 = -INFINITY;
#pragma unroll
          for (int n = 0; n < 32; ++n) { const int ri = (n & 3) + 4 * (n >> 3); const float own = gs[ri], oth = __shfl_xor(own, 32);
              float s = (((n >> 2) & 1) == h2) ? own : oth; if (n >= j) s = -INFINITY;
              if (s > v0) { v2 = v1; s2 = s1; v1 = v0; s1 = s0; v0 = s; s0 = n; } else if (s > v1) { v2 = v1; s2 = s1; v1 = s; s1 = n; } else if (s > v2) { v2 = s; s2 = n; } }
        }
        if (h2 == 0) selvg[(size_t)(j * 256 + F.wave * 32 + r) * MOBA_H + h] = (unsigned char)((s0 >= 0 ? 1 : 0) | (s1 >= 0 ? 2 : 0) | (s2 >= 0 ? 4 : 0));
#pragma unroll 4
        for (int n = 0; n < 32; ++n) { const unsigned long long b = __ballot(h2 == 0 && (s0 == n || s1 == n || s2 == n)); if (lane == 0) CNTW[F.wave * 32 + n] = __popcll(b); }
        __syncthreads();
        int basev = 0, totv = 0;
        if (lane < 32) {
#pragma unroll
            for (int w = 0; w < 8; ++w) { const int cval = CNTW[w * 32 + lane]; if (w < F.wave) basev += cval; totv += cval; } }
#pragma unroll 4
        for (int n = 0; n < 32; ++n) { const bool mine = h2 == 0 && (s0 == n || s1 == n || s2 == n); const unsigned long long b = __ballot(mine);
            const int base = __builtin_amdgcn_readlane(basev, n);
            if (mine) { const int pos = base + __popcll(b & ((1ull << lane) - 1ull)); const int slot = (s0 == n) ? 0 : (s1 == n) ? 1 : 2; LIST[n * 256 + pos] = (unsigned short)((F.wave * 32 + r) | (slot << 8)); } }
        if (F.wave == 0 && lane < 32) { TOT[lane] = totv; cntg[((size_t)h * 32 + lane) * 32 + j] = totv; }
        __syncthreads();
        for (int i = F.tid; i < 32 * 256; i += 512) { const int n = i >> 8, pos = i & 255; if (pos < TOT[n]) listg[(((size_t)h * 32 + n) * 32 + j) * 256 + pos] = LIST[i]; }
        __syncthreads();
    }
}
__device__ __forceinline__ void moba_kv_phase(Frame& F, const bf16* qkvg, const bf16* ktile, const bf16* vtile, const int* cntg, const unsigned short* listg, const float* qw, const float* kw, bf16* part, float* lpart) {
    const int lane = F.lane, r = lane & 31, h2 = lane >> 5;
    LAS unsigned char* KV = F.lds + RING_OFF;
    LAS int* CHO = (LAS int*)(F.lds + 132096);
    LAS int* PJ = (LAS int*)(F.lds + 136320);
    float c2;
    { float mq = fmaxf(fabsf(qw[2 * lane]), fabsf(qw[2 * lane + 1])), mk = fmaxf(fabsf(kw[2 * lane]), fabsf(kw[2 * lane + 1])); mq = wave_max(mq); mk = wave_max(mk);
      c2 = (11.3137085f * mq * mk * 1.03f + 0.1f) * 1.44269504f; }
    const float c1 = 0.08838834764831845f * 1.44269504f;
    for (int i = F.tid; i < 1024; i += 512) { const int n = i & 31; int E = 0; const int* cp = cntg + (size_t)i * 32;
        for (int j = n + 1; j < 32; ++j) E += cp[j];
        CHO[i] = (8 + ((E + 31) >> 5) + 7) >> 3; }
    __syncthreads();
    if (F.wave == 0) { int loc[16]; int s = 0;
#pragma unroll
        for (int k = 0; k < 16; ++k) { loc[k] = CHO[lane * 16 + k]; s += loc[k]; }
        int inc = s;
#pragma unroll
        for (int o = 1; o < 64; o <<= 1) { const int v = __shfl_up(inc, o); if (lane >= o) inc += v; }
        int run = inc - s;
#pragma unroll
        for (int k = 0; k < 16; ++k) { CHO[lane * 16 + k] = run; run += loc[k]; }
        if (lane == 63) CHO[1024] = inc; }
    __syncthreads();
    const int NC = CHO[1024];
    const int cbeg = (int)(((long)blockIdx.x * NC) / F.G), cend = (int)(((long)(blockIdx.x + 1) * NC) / F.G);
    int cur_hn = -1;
    for (int cid = cbeg; cid < cend; ++cid) {
        int lo = 0, hi = 1023;
        while (lo < hi) { const int mid = (lo + hi + 1) >> 1; if (CHO[mid] <= cid) lo = mid; else hi = mid - 1; }
        const int h = lo >> 5, n = lo & 31, c = cid - CHO[lo];
        const bool reload = lo != cur_hn; cur_hn = lo;
        if (reload) {
            __syncthreads();
            if (F.wave == 0) { int v = (lane < 32 && lane > n) ? cntg[((size_t)h * 32 + n) * 32 + lane] : 0; int inc = v;
#pragma unroll
                for (int o = 1; o < 32; o <<= 1) { const int w = __shfl_up(inc, o); if (lane >= o) inc += w; }
                if (lane < 32) PJ[lane] = inc - v; if (lane == 31) PJ[32] = inc; }
            const v4u* ks = (const v4u*)(ktile + (((size_t)h * MOBA_NB + n) * 64) * 512); const v4u* vs = (const v4u*)(vtile + (((size_t)h * MOBA_NB + n) * 64) * 512);
            v4u kb[8], vb[8];
#pragma unroll
            for (int k = 0; k < 8; ++k) { kb[k] = ks[F.tid + 512 * k]; vb[k] = vs[F.tid + 512 * k]; }
#pragma unroll
            for (int k = 0; k < 8; ++k) { *(LAS v4u*)(KV + (F.tid + 512 * k) * 16) = kb[k]; *(LAS v4u*)(KV + 65536 + (F.tid + 512 * k) * 16) = vb[k]; }
            __syncthreads();
        }
        const int E = PJ[32], T = 8 + ((E + 31) >> 5), ti = c * 8 + F.wave;
        int q = 0, slot = 3, tq = 0, nkt = 0; bool valid = false, own = false;
        if (ti < 8) { own = true; q = ti * 32 + r; tq = n * 256 + q; nkt = ti + 1; valid = true; }
        else if (ti < T) { int e = (ti - 8) * 32 + r; valid = e < E; if (!valid) e = (ti - 8) * 32; int jj = n + 1;
            for (int j2 = n + 2; j2 < 32; ++j2) if (PJ[j2] <= e) jj = j2;
            const int ent = listg[(((size_t)h * 32 + n) * 32 + jj) * 256 + (e - PJ[jj])]; q = ent & 255; slot = ent >> 8; tq = jj * 256 + q; nkt = 8; }
        if (nkt > 0) {
            f32x16 O[4]; float lsum = 0.f;
#pragma unroll
            for (int dt = 0; dt < 4; ++dt) O[dt] = zero16();
            bf16x8 Qf[8];
            { const bf16* qp = qkvg + (size_t)tq * 16384 + h * 128 + h2 * 8;
#pragma unroll
              for (int ks = 0; ks < 8; ++ks) Qf[ks] = *(const bf16x8*)(qp + ks * 16); }
#pragma nounroll
            for (int kt = 0; kt < nkt; ++kt) {
                f32x16 S = zero16();
#pragma unroll
                for (int ks = 0; ks < 8; ++ks) { const bf16x8 kf = *(const LAS bf16x8*)(KV + ((kt * 8 + ks) * 64 + lane) * 16); S = __builtin_amdgcn_mfma_f32_32x32x16_bf16(kf, Qf[ks], S, 0, 0, 0); }
                const bool diag = own && (kt == nkt - 1);
                float p[16];
#pragma unroll
                for (int i = 0; i < 16; ++i) { float pv = __builtin_amdgcn_exp2f(S[i] * c1 - c2); if (diag && (kt * 32 + 16 * (i >> 3) + 8 * h2 + (i & 7)) > q) pv = 0.f; p[i] = pv; lsum += pv; }
#pragma unroll
                for (int kk = 0; kk < 2; ++kk) { v4u pq; pq.x = pk2(p[8 * kk], p[8 * kk + 1]); pq.y = pk2(p[8 * kk + 2], p[8 * kk + 3]); pq.z = pk2(p[8 * kk + 4], p[8 * kk + 5]); pq.w = pk2(p[8 * kk + 6], p[8 * kk + 7]);
                    const bf16x8 Pf = __builtin_bit_cast(bf16x8, pq);
#pragma unroll
                    for (int dt = 0; dt < 4; ++dt) { const bf16x8 vf = *(const LAS bf16x8*)(KV + 65536 + ((kt * 8 + kk * 4 + dt) * 64 + lane) * 16); O[dt] = __builtin_amdgcn_mfma_f32_32x32x16_bf16(vf, Pf, O[dt], 0, 0, 0); } }
            }
            lsum += __shfl_xor(lsum, 32);
            {
                const size_t dst = ((size_t)tq * MOBA_H + h) * 4 + slot; if (valid && h2 == 0) lpart[dst] = lsum;
                bf16* pr_ = part + dst * 128 + 8 * h2;
#pragma unroll
                for (int dt = 0; dt < 4; ++dt)
#pragma unroll
                    for (int rp = 0; rp < 2; ++rp) {
                        const unsigned x0 = pk2(O[dt][8 * rp], O[dt][8 * rp + 1]), x1 = pk2(O[dt][8 * rp + 2], O[dt][8 * rp + 3]), y0 = pk2(O[dt][8 * rp + 4], O[dt][8 * rp + 5]), y1 = pk2(O[dt][8 * rp + 6], O[dt][8 * rp + 7]);
                        const auto s0 = __builtin_amdgcn_permlane32_swap(x0, y0, false, false), s1 = __builtin_amdgcn_permlane32_swap(x1, y1, false, false);
                        v4u w; w.x = s0[0]; w.y = s1[0]; w.z = s0[1]; w.w = s1[1];
                        if (valid) *(v4u*)(pr_ + dt * 32 + 16 * rp) = w; } }
        }
    }
}
__device__ __forceinline__ void moba_combine_phase(Frame& F, const bf16* qkvg, const unsigned char* selvg, const bf16* part, const float* lpart, bf16* obuf) {
    for (int it = blockIdx.x * 512 + F.tid; it < M * MOBA_H * 2; it += F.G * 512) {
        const int half = it & 1, th = it >> 1, h = th & 31, t = th >> 5; const unsigned vm = selvg[th] | 8u; float o[64]; float l = 0.f;
#pragma unroll
        for (int i = 0; i < 64; ++i) o[i] = 0.f;
#pragma unroll
        for (int sl = 0; sl < 4; ++sl) if (vm & (1u << sl)) { const size_t rd = (size_t)th * 4 + sl; l += lpart[rd]; const v4u* pp = (const v4u*)(part + rd * 128 + half * 64);
#pragma unroll
            for (int c = 0; c < 8; ++c) { const v4u w = pp[c]; o[8 * c] += bflo(w.x); o[8 * c + 1] += bfhi(w.x); o[8 * c + 2] += bflo(w.y); o[8 * c + 3] += bfhi(w.y); o[8 * c + 4] += bflo(w.z); o[8 * c + 5] += bfhi(w.z); o[8 * c + 6] += bflo(w.w); o[8 * c + 7] += bfhi(w.w); } }
        const float inv = 1.0f / l; const v4u* gp = (const v4u*)(qkvg + (size_t)t * 16384 + 12288 + h * 128 + half * 64); v4u* op = (v4u*)(obuf + (size_t)t * MOBA_W + h * 128 + half * 64);
#pragma unroll
        for (int c = 0; c < 8; ++c) { const v4u gq = gp[c]; v4u w;
            w.x = pk2(o[8 * c] * inv * silu_f(bflo(gq.x)), o[8 * c + 1] * inv * silu_f(bfhi(gq.x))); w.y = pk2(o[8 * c + 2] * inv * silu_f(bflo(gq.y)), o[8 * c + 3] * inv * silu_f(bfhi(gq.y)));
            w.z = pk2(o[8 * c + 4] * inv * silu_f(bflo(gq.z)), o[8 * c + 5] * inv * silu_f(bfhi(gq.z))); w.w = pk2(o[8 * c + 6] * inv * silu_f(bflo(gq.w)), o[8 * c + 7] * inv * silu_f(bfhi(gq.w))); op[c] = w; }
    }
}
#ifndef MK_N_LAUNCHES
#define MK_N_LAUNCHES 1
#endif
constexpr int N_PHASES = 25;
struct Args { AllIn I; float* out; unsigned char* ws; int ph_lo, ph_hi; };
#define INP(i) ldin(i)
__global__ void __launch_bounds__(NWAVES * 64, 2) mk_fwd(Args args) {
    extern __shared__ __attribute__((aligned(16))) unsigned char lds[];
    Frame F;
    F.lds = (LAS unsigned char*)lds;
    F.MISC = (volatile LAS unsigned*)(F.lds + MISC_OFF);
    F.tid = threadIdx.x; F.lane = F.tid & 63; F.wave = __builtin_amdgcn_readfirstlane(F.tid >> 6);
    F.G = gridDim.x; F.ws = args.ws;
    F.ctl = (gu32*)(args.ws + WS_CTL);
    for (int u = F.tid; u < (LDS_BYTES - LDSCTL_OFF) / 4; u += NWAVES * 64) ((LAS unsigned*)(F.lds + LDSCTL_OFF))[u] = 0u;
    __syncthreads();
    const int lo = args.ph_lo, hi = args.ph_hi;
    XcdBarrier bar; bar.bar = (unsigned*)(F.ctl + CW_BAR); bar.x = 0; bar.st = nullptr;
    if (hi - lo > 1) bar = xcd_barrier_post((unsigned*)(F.ctl + CW_BAR), F.MISC + 8);
#define IN(k) (lo <= (k) && (k) < hi)
#define SEAM(k) do { if (IN(k) && IN((k) + 1)) xcd_barrier(bar); } while (0)
#define WSP(T, off) ((T*)(args.ws + (off)))
#define ROWSS(l) ((unsigned long long*)(F.ctl + CW_ROWSS) + (l) * M)

    if (IN(0)) { p0_prologue(F, INP(0), WSP(bf16, WS_HB), ROWSS(0)); } SEAM(0);

#define SSD_LAYER(REPV) { constexpr int rep = (REPV); \
        constexpr int pb = rep ? 18 : 1, ib = rep ? 22 : 2, layer = rep ? 3 : 0; \
        if (IN(pb + 0)) { \
            const bf16* Win_t = WSP(const bf16, rep ? WS_W_SSD3_IN : WS_W_SSD0_IN); \
            pg8::Gemm g{WSP(const bf16, WS_HB), Win_t, M, SSD_MAIN, D, D, D, 0}; pg8::StaticOrder S; S.init(M, SSD_MAIN, F.G, (int)blockIdx.x); \
            pg8::EpiRowScale E{WSP(bf16, WS_ACT_A), SSD_MAIN, ROWSS(layer)}; \
            pg8::gemm_phase<pg8::EpiRowScale, pg8::StaticOrder, true, true>(F.lds + RING_OFF, g, S, E); \
            __syncthreads(); \
            dt_phase(F, WSP(const bf16, WS_HB), Win_t + (size_t)SSD_MAIN * D, ROWSS(layer), INP(ib + 3), WSP(float, WS_DT)); \
        } \
        SEAM(pb + 0); \
        if (IN(pb + 1)) conv_phase(F, WSP(const bf16, WS_ACT_A), INP(ib + 1), INP(ib + 2), WSP(bf16, WS_XC), WSP(bf16, WS_XT), WSP(bf16, WS_BT), WSP(bf16, WS_BT + 16 * MiB), WSP(bf16, WS_BT + 32 * MiB)); \
        SEAM(pb + 1); \
        if (IN(pb + 2)) ssd_s1_phase(F, WSP(const bf16, WS_XT), WSP(const bf16, WS_BT), WSP(const float, WS_DT), INP(ib + 4), WSP(bf16, WS_STATES), WSP(float, WS_DECAY)); \
        SEAM(pb + 2); \
        if (IN(pb + 3)) ssd_s2_phase(F, WSP(bf16, WS_STATES), WSP(const float, WS_DECAY)); \
        SEAM(pb + 3); \
        if (IN(pb + 4)) ssd_s3_phase(F, WSP(const bf16, WS_XC), WSP(const bf16, WS_XT), WSP(const bf16, WS_BT + 16 * MiB), WSP(const bf16, WS_BT + 32 * MiB), WSP(const bf16, WS_ACT_A), WSP(const float, WS_DT), INP(ib + 4), INP(ib + 5), WSP(float, WS_SSG), WSP(const bf16, WS_STATES), WSP(bf16, WS_ACT_B)); \
        SEAM(pb + 4); \
        if (IN(pb + 5)) ssd_norm_phase(F, WSP(bf16, WS_ACT_B), WSP(const float, WS_SSG), INP(ib + 6)); \
        SEAM(pb + 5); \
        if (IN(pb + 6)) { \
            pg8::Gemm g{WSP(const bf16, WS_ACT_B), WSP(const bf16, rep ? WS_W_SSD3_OUT : WS_W_SSD0_OUT), M, D, SSD_DI, SSD_DI, SSD_DI, 0}; pg8::StaticOrder S; S.init(M, D, F.G, (int)blockIdx.x); \
            pg8::EpiResid E{rep ? (const float*)args.out : INP(0), args.out, rep ? (bf16*)nullptr : WSP(bf16, WS_HB), rep ? (unsigned long long*)nullptr : ROWSS(1)}; \
            pg8::gemm_phase<pg8::EpiResid, pg8::StaticOrder, true, true>(F.lds + RING_OFF, g, S, E); \
        } \
        SEAM(pb + 6); \
    }
    SSD_LAYER(0)
    {
            if (IN(8)) {
                pg8::Gemm g{WSP(const bf16, WS_HB), WSP(const bf16, WS_W_POOL_IN), M, 16384, D, D, D, 0}; pg8::StaticOrder S; S.init(M, 16384, F.G, (int)blockIdx.x);
                pg8::EpiRowScale E{WSP(bf16, WS_ACT_A), 16384, ROWSS(1)};
                pg8::gemm_phase<pg8::EpiRowScale, pg8::StaticOrder, true, true>(F.lds + RING_OFF, g, S, E);
            }
            SEAM(8);
            if (IN(9)) pool_phase(F, WSP(const bf16, WS_ACT_A), WSP(bf16, WS_ACT_B));
            SEAM(9);
            if (IN(10)) {
                pg8::Gemm g{WSP(const bf16, WS_ACT_B), WSP(const bf16, WS_W_POOL_GRP), M, POOL_W, POOL_GD, POOL_W, POOL_GD, POOL_GD / 256}; pg8::StaticOrder S; S.init(M, POOL_W, F.G, (int)blockIdx.x);
                pg8::EpiPoolGrp E{WSP(bf16, WS_ACT_C), WSP(const bf16, WS_ACT_A), INP(13), INP(14)};
                pg8::gemm_phase<pg8::EpiPoolGrp, pg8::StaticOrder, true, true>(F.lds + RING_OFF, g, S, E);
            }
            SEAM(10);
            if (IN(11)) {
                pg8::Gemm g{WSP(const bf16, WS_ACT_C), WSP(const bf16, WS_W_POOL_OUT), M, D, POOL_W, POOL_W, POOL_W, 0}; pg8::StaticOrder S; S.init(M, D, F.G, (int)blockIdx.x);
                pg8::EpiResid E{args.out, args.out, WSP(bf16, WS_HB), ROWSS(2)};
                pg8::gemm_phase<pg8::EpiResid, pg8::StaticOrder, true, true>(F.lds + RING_OFF, g, S, E);
            }
            SEAM(11);
            if (IN(12)) {
                pg8::Gemm g{WSP(const bf16, WS_HB), WSP(const bf16, WS_W_MOBA_IN), M, 16384, D, D, D, 0}; pg8::StaticOrder S; S.init(M, 16384, F.G, (int)blockIdx.x);
                pg8::EpiRowScale E{WSP(bf16, WS_ACT_A), 16384, ROWSS(2)};
                pg8::gemm_phase<pg8::EpiRowScale, pg8::StaticOrder, true, true>(F.lds + RING_OFF, g, S, E);
            }
            SEAM(12);
            if (IN(13)) qknorm_phase(F, WSP(bf16, WS_ACT_A), INP(18), INP(19), WSP(bf16, WS_KMEAN), WSP(bf16, WS_XC + 72 * MiB), WSP(bf16, WS_XC));
            SEAM(13);
            if (IN(14)) moba_gate_phase(F, WSP(const bf16, WS_ACT_A), WSP(const bf16, WS_KMEAN), WSP(int, WS_XC + 136 * MiB), WSP(unsigned short, WS_XC + 138 * MiB), WSP(unsigned char, WS_XC + 137 * MiB));
            SEAM(14);
            if (IN(15)) moba_kv_phase(F, WSP(const bf16, WS_ACT_A), WSP(const bf16, WS_XC + 72 * MiB), WSP(const bf16, WS_XC), WSP(const int, WS_XC + 136 * MiB), WSP(const unsigned short, WS_XC + 138 * MiB), INP(18), INP(19), WSP(bf16, WS_ACT_C), WSP(float, WS_XC + 64 * MiB));
            SEAM(15);
            if (IN(16)) moba_combine_phase(F, WSP(const bf16, WS_ACT_A), WSP(const unsigned char, WS_XC + 137 * MiB), WSP(const bf16, WS_ACT_C), WSP(const float, WS_XC + 64 * MiB), WSP(bf16, WS_ACT_B));
            SEAM(16);
            if (IN(17)) {
                pg8::Gemm g{WSP(const bf16, WS_ACT_B), WSP(const bf16, WS_W_MOBA_OUT), M, D, MOBA_W, MOBA_W, MOBA_W, 0}; pg8::StaticOrder S; S.init(M, D, F.G, (int)blockIdx.x);
                pg8::EpiResid E{args.out, args.out, WSP(bf16, WS_HB), ROWSS(3)};
                pg8::gemm_phase<pg8::EpiResid, pg8::StaticOrder, true, true>(F.lds + RING_OFF, g, S, E);
            }
            SEAM(17);
        }
    SSD_LAYER(1)
#undef SSD_LAYER
#undef IN
#undef SEAM
#undef WSP
#undef ROWSS
}

extern "C" void kernel_launch(void* const* d_in, const int* in_sizes, int n_in, void* d_out, int out_size, void* d_ws, size_t ws_size, hipStream_t stream) {
    static int grid = 0;
    if (grid == 0) {
        if (n_in != 30 || in_sizes[0] != M * D || out_size != M * D || ws_size < WS_END) { fprintf(stderr, "kernel_launch: unexpected shapes: n_in %d in0 %d out %d ws %zu (need %zu)\n", n_in, n_in > 0 ? in_sizes[0] : -1, out_size, ws_size, (size_t)WS_END); grid = -1; return; }
        int dev = 0, cus = 0, per_cu = 0;
        if (hipGetDevice(&dev) != hipSuccess || hipDeviceGetAttribute(&cus, hipDeviceAttributeMultiprocessorCount, dev) != hipSuccess) { grid = -1; return; }
        if (hipFuncSetAttribute((const void*)mk_fwd, hipFuncAttributeMaxDynamicSharedMemorySize, LDS_BYTES) != hipSuccess) { fprintf(stderr, "kernel_launch: hipFuncSetAttribute failed\n"); grid = -1; return; }
        if (hipOccupancyMaxActiveBlocksPerMultiprocessor(&per_cu, (const void*)mk_fwd, NWAVES * 64, LDS_BYTES) != hipSuccess || per_cu < 1)
            fprintf(stderr, "kernel_launch: occupancy query reports %d workgroups per CU\n", per_cu);
        (void)hipGetLastError();
        grid = cus;
    }
    if (grid < 0) return;
    if (hipMemsetAsync((char*)d_ws + WS_CTL, 0, CTL_ZERO_BYTES, stream) != hipSuccess) { fprintf(stderr, "kernel_launch: memset failed\n"); return; }
    Args a{};
    for (int i = 0; i < 30; ++i) a.I.in[i] = (const float*)d_in[i];
    a.out = (float*)d_out; a.ws = (unsigned char*)d_ws;
#if MK_N_LAUNCHES == 1
    a.ph_lo = 0; a.ph_hi = N_PHASES;
    hipLaunchKernelGGL(mk_fwd, dim3(grid), dim3(NWAVES * 64), LDS_BYTES, stream, a);
#else
    for (int li = 0; li < N_PHASES; ++li) { a.ph_lo = li; a.ph_hi = li + 1; hipLaunchKernelGGL(mk_fwd, dim3(grid), dim3(NWAVES * 64), LDS_BYTES, stream, a); }
#endif
}
```

```cpp
#include <hip/hip_runtime.h>
#include <cstdio>
#include <cstdint>
#define MK_N_LAUNCHES 1
namespace pg8 {
#define PG8_LAS __attribute__((address_space(3)))
typedef unsigned short bf16_t;
typedef short bf16x8 __attribute__((ext_vector_type(8)));
typedef float f32x4 __attribute__((ext_vector_type(4)));
typedef unsigned u32x4 __attribute__((ext_vector_type(4)));
constexpr int BM = 256, BK = 64, HALF = 128, HTB = HALF * BK * 2  , STAGE_BYTES = 8 * HTB, NXCD = 8, WGM = 4;

__host__ __device__ __forceinline__ int lds_byte(int r, int c) { const int st = (r >> 4) * 2 + (c >> 5), rr = r & 15, cc = c & 31, ob = rr * 64 + cc * 2; return st * 1024 + (ob ^ (((ob >> 9) & 1) << 5)); }
__host__ __device__ __forceinline__ void stage_rc(int b, int& R, int& C) { const int st = b / 1024, sb = b % 1024, swz = sb ^ (((sb >> 9) & 1) << 5); R = (st >> 1) * 16 + swz / 64; C = (st & 1) * 32 + (swz % 64) / 2; }
__host__ __device__ __forceinline__ int perm32(int rho) { const int n = rho >> 4, i = rho & 15; return 8 * (i >> 2) + 4 * n + (i & 3); }

struct Unit { int pm, pn; };
struct Gemm { const bf16_t* A; const bf16_t* Bt; int M, N, K, lda, ldb, gdiv; };

struct StaticOrder {
    int nM, nN, nwg, G, c;
    __host__ __device__ void init(int M, int N, int G_, int c_) { nM = M / BM; nN = N / BM; nwg = nM * nN; G = G_; c = c_; }
    __host__ __device__ bool next(int i, Unit& u) const {
        const long L = (long)i * G + c; if (L >= nwg) return false;
        int wgid = (int)L; { const int q = nwg / NXCD, r = nwg % NXCD, xcd = wgid % NXCD, off = wgid / NXCD; wgid = (xcd < r ? xcd * (q + 1) : r * (q + 1) + (xcd - r) * q) + off; }
        const int nig = WGM * nN, gid = wgid / nig, fm = gid * WGM, gsz = (nM - fm) < WGM ? (nM - fm) : WGM;
        u.pm = fm + ((wgid % nig) % gsz); u.pn = (wgid % nig) / gsz; return true;
    }
    __device__ __forceinline__ void a_ready(const Unit&) const {}
    __device__ __forceinline__ void done(const Unit&) const {}
};

__device__ __forceinline__ unsigned cvt_pk_bf16(float lo, float hi) { unsigned r; asm volatile("v_cvt_pk_bf16_f32 %0, %1, %2" : "=v"(r) : "v"(lo), "v"(hi)); return r; }

template <class Epi, class Sched, bool ALIGN_EPI = false, bool SP2 = false>
__device__ __forceinline__ void gemm_phase(PG8_LAS unsigned char* lds, const Gemm g, const Sched& S, const Epi& E) {
    const int tid = threadIdx.x, wid = __builtin_amdgcn_readfirstlane(tid >> 6), lane = tid & 63, wr = wid >> 2, wc = wid & 3, fr = lane & 15, fq = lane >> 4;
    const int K = g.K, nt = K / BK;
    unsigned voffA[2], voffB[2];
#pragma unroll
    for (int i = 0; i < 2; ++i) { int R, C; stage_rc(tid * 16 + i * 8192, R, C); const int Rb = Epi::PERM ? ((R & ~31) + perm32(R & 31)) : R;
        voffA[i] = (unsigned)(R * g.lda + C) * 2u; voffB[i] = (unsigned)(Rb * g.ldb + C) * 2u; }
    const size_t kstep = (size_t)(BK * 2);
    const size_t hstepA = (size_t)HALF * g.lda * 2, hstepB = (size_t)HALF * g.ldb * 2;
    const size_t tstepA = 2 * hstepA, tstepB = 2 * hstepB;
    const unsigned ldsw = (unsigned)wid * 1024u;
    const int aoff = lds_byte(wr * 64 + fr, fq * 8), boff = lds_byte(wc * 32 + fr, fq * 8);
#define PG8_SA(b, h) (((b) * 2 + (h)) * HTB)
#define PG8_SB(b, h) ((4 + (b) * 2 + (h)) * HTB)
#define PG8_STAGE(bufoff, gbase, voff) do { _Pragma("unroll") for (int _i = 0; _i < 2; ++_i) \
        __builtin_amdgcn_global_load_lds((const unsigned*)((const char*)(gbase) + (voff)[_i]), (PG8_LAS unsigned*)(lds + (bufoff) + ldsw + _i * 8192), 16, 0, 0); } while (0)
#define PG8_LDA(dst, b, h) do { _Pragma("unroll") for (int m = 0; m < 4; ++m) _Pragma("unroll") for (int k = 0; k < 2; ++k) dst[m][k] = *(const PG8_LAS bf16x8*)(lds + PG8_SA(b, h) + aoff + m * 2048 + k * 1024); } while (0)
#define PG8_LDB(dst, b, h) do { _Pragma("unroll") for (int n = 0; n < 2; ++n) _Pragma("unroll") for (int k = 0; k < 2; ++k) dst[n][k] = *(const PG8_LAS bf16x8*)(lds + PG8_SB(b, h) + boff + n * 2048 + k * 1024); } while (0)
#define PG8_MMA(ai, bj, At, Bt) do { __builtin_amdgcn_s_setprio(1); _Pragma("unroll") for (int m = 0; m < 4; ++m) _Pragma("unroll") for (int n = 0; n < 2; ++n) _Pragma("unroll") for (int k = 0; k < 2; ++k) \
        acc[ai][bj][m][n] = __builtin_amdgcn_mfma_f32_16x16x32_bf16(Bt[n][k], At[m][k], acc[ai][bj][m][n], 0, 0, 0); __builtin_amdgcn_s_setprio(0); } while (0)
#define PG8_WAIT_V(n) asm volatile("s_waitcnt vmcnt(" #n ")" ::: "memory")
#define PG8_WAIT_L(n) asm volatile("s_waitcnt lgkmcnt(" #n ")" ::: "memory")
#define PG8_BAR __builtin_amdgcn_s_barrier()
#define PG8_SCHED __builtin_amdgcn_sched_barrier(0)
#define PG8_ABASE(u) ((const char*)g.A + (size_t)(u).pm * tstepA + (g.gdiv ? (size_t)((u).pn / g.gdiv) * (size_t)K * 2 : (size_t)0))
    Unit cur, nxt; int ui = 0;
    if (!S.next(0, cur)) return;
    f32x4 acc[2][2][4][2];
#pragma unroll
    for (int a = 0; a < 2; ++a)
#pragma unroll
        for (int b = 0; b < 2; ++b)
#pragma unroll
            for (int m = 0; m < 4; ++m)
#pragma unroll
                for (int n = 0; n < 2; ++n) acc[a][b][m][n] = (f32x4){0.f, 0.f, 0.f, 0.f};
    bf16x8 At[4][2], B0[2][2], B1[2][2];
    const char* cA = PG8_ABASE(cur); const char* cB = (const char*)g.Bt + (size_t)cur.pn * tstepB;
    S.a_ready(cur);
    E.pre(cur);
    if constexpr (SP2) {
        PG8_STAGE(PG8_SB(0, 0), cB, voffB); PG8_STAGE(PG8_SB(0, 1), cB + hstepB, voffB); PG8_STAGE(PG8_SA(0, 0), cA, voffA); PG8_STAGE(PG8_SA(0, 1), cA + hstepA, voffA);
        if (wr == 1) PG8_BAR;
        PG8_WAIT_V(2); PG8_BAR;
        PG8_STAGE(PG8_SB(1, 0), cB + kstep, voffB); PG8_STAGE(PG8_SA(1, 0), cA + kstep, voffA); PG8_STAGE(PG8_SB(1, 1), cB + hstepB + kstep, voffB);
        PG8_WAIT_V(6); PG8_BAR;
    } else {
        PG8_STAGE(PG8_SB(0, 0), cB, voffB); PG8_STAGE(PG8_SA(0, 0), cA, voffA); PG8_STAGE(PG8_SB(0, 1), cB + hstepB, voffB); PG8_STAGE(PG8_SA(0, 1), cA + hstepA, voffA);
        if (wr == 1) PG8_BAR;
        PG8_WAIT_V(4); PG8_BAR;
        PG8_STAGE(PG8_SB(1, 0), cB + kstep, voffB); PG8_STAGE(PG8_SA(1, 0), cA + kstep, voffA); PG8_STAGE(PG8_SB(1, 1), cB + hstepB + kstep, voffB);
        PG8_WAIT_V(6); PG8_BAR;
    }
    for (;;) {
        const bool has_next = S.next(ui + 1, nxt);
        const char* nA = has_next ? PG8_ABASE(nxt) : cA; const char* nB = has_next ? (const char*)g.Bt + (size_t)nxt.pn * tstepB : cB;
        for (int t = 0; t < nt; t += 2) {
            const bool last = (t == nt - 2);
            if constexpr (Epi::KHOOK) {
                if (t == 2) E.fill(cur);
                if (t > 0 && (t & 15) == 0) E.khook(acc, (t >> 4) - 1, wr, fr);
            }
            const char* a1 = cA + (size_t)(t + 1) * kstep;
            const char* a2 = last ? nA : cA + (size_t)(t + 2) * kstep; const char* b2 = last ? nB : cB + (size_t)(t + 2) * kstep;
            const char* a3 = a2 + kstep; const char* b3 = b2 + kstep;
            if (last && has_next) S.a_ready(nxt);
            if constexpr (SP2) {
            PG8_LDB(B0, 0, 0); PG8_LDB(B1, 0, 1); PG8_SCHED; PG8_LDA(At, 0, 0); PG8_STAGE(PG8_SA(1, 1), a1 + hstepA, voffA);
            PG8_WAIT_V(8); PG8_WAIT_L(0); PG8_BAR; PG8_MMA(0, 0, At, B0); PG8_MMA(0, 1, At, B1); PG8_BAR; PG8_SCHED;
            PG8_LDA(At, 0, 1); PG8_STAGE(PG8_SB(0, 0), b2, voffB); PG8_STAGE(PG8_SB(0, 1), b2 + hstepB, voffB); PG8_STAGE(PG8_SA(0, 0), a2, voffA);
            PG8_WAIT_V(8); PG8_WAIT_L(0); PG8_BAR; PG8_MMA(1, 0, At, B0); PG8_MMA(1, 1, At, B1); PG8_BAR; PG8_SCHED;
            PG8_LDB(B0, 1, 0); PG8_LDB(B1, 1, 1); PG8_SCHED; PG8_LDA(At, 1, 0); PG8_STAGE(PG8_SA(0, 1), a2 + hstepA, voffA);
            PG8_WAIT_V(8); PG8_WAIT_L(0); PG8_BAR; PG8_MMA(0, 0, At, B0); PG8_MMA(0, 1, At, B1); PG8_BAR; PG8_SCHED;
            PG8_LDA(At, 1, 1); PG8_STAGE(PG8_SB(1, 0), b3, voffB); PG8_STAGE(PG8_SB(1, 1), b3 + hstepB, voffB); PG8_STAGE(PG8_SA(1, 0), a3, voffA);
            PG8_WAIT_V(8); PG8_WAIT_L(0); PG8_BAR; PG8_MMA(1, 0, At, B0); PG8_MMA(1, 1, At, B1); PG8_BAR; PG8_SCHED;
            } else {
            PG8_LDB(B0, 0, 0); PG8_SCHED; PG8_LDA(At, 0, 0); PG8_STAGE(PG8_SA(1, 1), a1 + hstepA, voffA);
            PG8_WAIT_L(8); PG8_BAR; PG8_WAIT_L(0); PG8_MMA(0, 0, At, B0); PG8_BAR; PG8_SCHED;
            PG8_LDB(B1, 0, 1); PG8_STAGE(PG8_SB(0, 0), b2, voffB);
            PG8_BAR; PG8_WAIT_L(0); PG8_MMA(0, 1, At, B1); PG8_BAR;
            PG8_LDA(At, 0, 1); PG8_STAGE(PG8_SA(0, 0), a2, voffA);
            PG8_BAR; PG8_WAIT_L(0); PG8_MMA(1, 0, At, B0); PG8_BAR; PG8_SCHED;
            PG8_STAGE(PG8_SB(0, 1), b2 + hstepB, voffB);
            PG8_WAIT_V(6); PG8_BAR; PG8_MMA(1, 1, At, B1); PG8_BAR;
            PG8_LDB(B0, 1, 0); PG8_SCHED; PG8_LDA(At, 1, 0); PG8_STAGE(PG8_SA(0, 1), a2 + hstepA, voffA);
            PG8_WAIT_L(8); PG8_BAR; PG8_WAIT_L(0); PG8_MMA(0, 0, At, B0); PG8_BAR; PG8_SCHED;
            PG8_LDB(B1, 1, 1); PG8_STAGE(PG8_SB(1, 0), b3, voffB);
            PG8_BAR; PG8_WAIT_L(0); PG8_MMA(0, 1, At, B1); PG8_BAR;
            PG8_LDA(At, 1, 1); PG8_STAGE(PG8_SA(1, 0), a3, voffA);
            PG8_BAR; PG8_WAIT_L(0); PG8_MMA(1, 0, At, B0); PG8_BAR; PG8_SCHED;
            PG8_STAGE(PG8_SB(1, 1), b3 + hstepB, voffB);
            PG8_WAIT_V(6); PG8_BAR; PG8_MMA(1, 1, At, B1); PG8_BAR;
            }
        }
        if constexpr (ALIGN_EPI) { if (wr == 0) PG8_BAR; }
        E(acc, cur, wr, wc, fr, fq, ui & 1, has_next, nxt); S.done(cur);
        if (!has_next) break;
#pragma unroll
        for (int a = 0; a < 2; ++a)
#pragma unroll
            for (int b = 0; b < 2; ++b)
#pragma unroll
                for (int m = 0; m < 4; ++m)
#pragma unroll
                    for (int n = 0; n < 2; ++n) acc[a][b][m][n] = (f32x4){0.f, 0.f, 0.f, 0.f};
        cur = nxt; cA = nA; cB = nB; ++ui;
        if constexpr (ALIGN_EPI) { if (wr == 1) PG8_BAR; }
    }
    PG8_WAIT_V(0);
    if constexpr (!ALIGN_EPI) { if (wr == 0) PG8_BAR; }
    PG8_BAR;
#undef PG8_ABASE
#undef PG8_SA
#undef PG8_SB
#undef PG8_STAGE
#undef PG8_LDA
#undef PG8_LDB
#undef PG8_MMA
#undef PG8_WAIT_V
#undef PG8_WAIT_L
#undef PG8_BAR
#undef PG8_SCHED
}
}
constexpr int NWAVES = 8;
constexpr int M = 8192, D = 4096;
constexpr float RMS_EPS = 1e-6f;
constexpr int SSD_DI = 8192, SSD_NH = 128, SSD_HD = 64, SSD_NG = 8, SSD_DS = 128, SSD_CONV = 10240, SSD_IN = 18560, SSD_MAIN = 18432;
constexpr int POOL_W = 8192, POOL_GD = 2048;
constexpr int MOBA_H = 32, MOBA_DH = 128, MOBA_BLK = 256, MOBA_NB = 32, MOBA_W = 4096;

constexpr size_t MiB = 1u << 20;
constexpr size_t WS_CTL = 0, CTL_ZERO_BYTES = 1 * MiB;
constexpr size_t WS_W_SSD0_IN = 1 * MiB;
constexpr size_t WS_W_SSD0_OUT = WS_W_SSD0_IN + 145 * MiB;
constexpr size_t WS_W_POOL_IN = WS_W_SSD0_OUT + 64 * MiB;
constexpr size_t WS_W_POOL_GRP = WS_W_POOL_IN + 128 * MiB;
constexpr size_t WS_W_POOL_OUT = WS_W_POOL_GRP + 32 * MiB;
constexpr size_t WS_W_MOBA_IN = WS_W_POOL_OUT + 64 * MiB;
constexpr size_t WS_W_MOBA_OUT = WS_W_MOBA_IN + 128 * MiB;
constexpr size_t WS_W_SSD3_IN = WS_W_MOBA_OUT + 32 * MiB;
constexpr size_t WS_W_SSD3_OUT = WS_W_SSD3_IN + 145 * MiB;
constexpr size_t WS_ACT_A = WS_W_SSD3_OUT + 64 * MiB;
constexpr size_t WS_ACT_B = WS_ACT_A + 288 * MiB;
constexpr size_t WS_ACT_C = WS_ACT_B + 128 * MiB;
constexpr size_t WS_STATES = WS_ACT_C, WS_XT = WS_ACT_C + 128 * MiB;
constexpr size_t WS_XC = WS_ACT_C + 256 * MiB;
constexpr size_t WS_HB = WS_XC + 160 * MiB;
constexpr size_t WS_DT = WS_HB + 64 * MiB;
constexpr size_t WS_KMEAN = WS_DT + 4 * MiB;
constexpr size_t WS_DECAY = WS_KMEAN + 512 * 1024;
constexpr size_t WS_SSG = WS_DECAY + 64 * 1024;
constexpr size_t WS_END = WS_KMEAN + 1 * MiB;
constexpr size_t WS_BT = WS_XC;
constexpr int CW_TMO = 0, CW_CODE = 1;
constexpr int CW_BAR = 4096;
constexpr int CW_ROWSS = 16384;
static_assert((CW_ROWSS + 8 * M) * 4 <= (int)CTL_ZERO_BYTES, "CTL words inside the memset region");

constexpr int RING_OFF = 0, RING_BYTES = 131072;
constexpr int LDSCTL_OFF = RING_BYTES, MISC_OFF = LDSCTL_OFF + 320;
constexpr int LDS_BYTES = 147456;
static_assert(MISC_OFF + 128 <= LDS_BYTES, "LDS map");

#define GAS __attribute__((address_space(1)))
#define LAS __attribute__((address_space(3)))
typedef unsigned short bf16;
typedef unsigned v4u __attribute__((ext_vector_type(4)));
typedef unsigned v2u __attribute__((ext_vector_type(2)));
typedef float f32x4 __attribute__((ext_vector_type(4)));
typedef float f32x16 __attribute__((ext_vector_type(16)));
typedef short bf16x8 __attribute__((ext_vector_type(8)));
typedef GAS unsigned gu32;
#define RLX_AGENT __ATOMIC_RELAXED, __HIP_MEMORY_SCOPE_AGENT
#define LDS_WAIT() asm volatile("s_waitcnt lgkmcnt(0)" ::: "memory")
#define VM_WAIT() asm volatile("s_waitcnt vmcnt(0)" ::: "memory")
__device__ __forceinline__ unsigned f2bf(float f) { unsigned u = __builtin_bit_cast(unsigned, f); return (u + 0x7fffu + ((u >> 16) & 1u)) >> 16; }
typedef float f32x2_t_ __attribute__((ext_vector_type(2)));
typedef __bf16 bf16x2_t_ __attribute__((ext_vector_type(2)));
__device__ __forceinline__ unsigned pk2(float lo, float hi) { const f32x2_t_ v = {lo, hi}; return __builtin_bit_cast(unsigned, __builtin_convertvector(v, bf16x2_t_)); }
__device__ __forceinline__ float bflo(unsigned w) { return __builtin_bit_cast(float, w << 16); }
__device__ __forceinline__ float bfhi(unsigned w) { return __builtin_bit_cast(float, w & 0xffff0000u); }
__device__ __forceinline__ float bf1(bf16 b) { return __builtin_bit_cast(float, ((unsigned)b) << 16); }
__device__ __forceinline__ float silu_f(float x) { return x * __builtin_amdgcn_rcpf(1.f + __expf(-x)); }
__device__ __forceinline__ float wave_sum(float v) {
#pragma unroll
    for (int o = 1; o < 64; o <<= 1) v += __shfl_xor(v, o);
    return v;
}
__device__ __forceinline__ float wave_max(float v) {
#pragma unroll
    for (int o = 1; o < 64; o <<= 1) v = fmaxf(v, __shfl_xor(v, o));
    return v;
}
__device__ __forceinline__ f32x16 zero16() { f32x16 z;
#pragma unroll
    for (int j = 0; j < 16; ++j) z[j] = 0.f;
    asm volatile("" : "+v"(z)); return z; }
#define XB_TMO      128
#define XB_XCNT(j)  (256  + 64 * (j))
#define XB_XSUB(j)  (1280 + 64 * (j))
#define XB_XGEN(j)  (2304 + 64 * (j))
#define XB_TOP      3328
#define XB_TOPGEN   3392
#define XCD_BAR_WORDS 3456
#define XB_SPIN_CAP (1u << 18)

__device__ __forceinline__ unsigned xb_ld(unsigned* p)              { return __hip_atomic_load(p, __ATOMIC_RELAXED, __HIP_MEMORY_SCOPE_AGENT); }
__device__ __forceinline__ unsigned xb_add(unsigned* p, unsigned v) { return __hip_atomic_fetch_add(p, v, __ATOMIC_RELAXED, __HIP_MEMORY_SCOPE_AGENT); }
__device__ __forceinline__ unsigned xb_xcc_id() { return (unsigned)__builtin_amdgcn_s_getreg((3 << 11) | 20) & 0xFu; }
#define XB_SPIN(cond, bar) do { unsigned _sp = 0; while (cond) { __builtin_amdgcn_s_sleep(1); \
    if ((++_sp & 255u) == 0u) { if (xb_ld(&(bar)[XB_TMO])) break; if (_sp > XB_SPIN_CAP) { atomicAdd(&(bar)[XB_TMO], 1u); break; } } } } while (0)

struct XcdBarrier {
    unsigned* bar; unsigned x;
    volatile LAS unsigned* st;
};

__device__ __forceinline__ XcdBarrier xcd_barrier_post(unsigned* bar, volatile LAS unsigned* st) {
    XcdBarrier b; b.bar = bar; b.x = xb_xcc_id(); b.st = st;
    if (threadIdx.x == 0) (void)xb_add(&bar[XB_XCNT(b.x)], 1u);
    return b;
}
__device__ __forceinline__ void xcd_barrier_complete(unsigned* bar, unsigned x, unsigned& nloc, unsigned& nx) {
    const unsigned G = gridDim.x * gridDim.y * gridDim.z;
    unsigned sum, cnt, mine, sp = 0u;
    for (;;) {
        sum = 0u; cnt = 0u; mine = 0u;
#pragma unroll
        for (unsigned j = 0; j < 16; ++j) { const unsigned c = xb_ld(&bar[XB_XCNT(j)]); sum += c; cnt += (c > 0u) ? 1u : 0u; mine = (j == x) ? c : mine; }
        if (sum == G) break;
        __builtin_amdgcn_s_sleep(1);
        if ((++sp & 255u) == 0u) { if (xb_ld(&bar[XB_TMO])) break; if (sp > XB_SPIN_CAP) { atomicAdd(&bar[XB_TMO], 1u); break; } }
    }
    nloc = mine > 0u ? mine : 1u; nx = cnt > 0u ? cnt : 1u;
}

__device__ __forceinline__ void xcd_barrier(const XcdBarrier& b) {
    asm volatile("s_waitcnt vmcnt(0)" ::: "memory");
    __syncthreads();
    if (threadIdx.x == 0) {
        unsigned* bar = b.bar;
        __builtin_amdgcn_s_waitcnt(0);
        unsigned nloc = b.st[0], nx = b.st[1];
        if (nloc == 0u) { xcd_barrier_complete(bar, b.x, nloc, nx); b.st[0] = nloc; b.st[1] = nx; }
        const unsigned old = xb_add(&bar[XB_XSUB(b.x)], 1u);
        const unsigned gen = old / nloc;
        if (old + 1u == (gen + 1u) * nloc) {
            __builtin_amdgcn_fence(__ATOMIC_RELEASE, "agent");
            asm volatile("s_waitcnt vmcnt(0)" ::: "memory");
            const unsigned og = xb_add(&bar[XB_TOP], 1u);
            const unsigned tg = og / nx;
            if (og + 1u == (tg + 1u) * nx) xb_add(&bar[XB_TOPGEN], 1u);
            else XB_SPIN(xb_ld(&bar[XB_TOPGEN]) == tg, bar);
            __builtin_amdgcn_fence(__ATOMIC_ACQUIRE, "agent");
            xb_add(&bar[XB_XGEN(b.x)], 1u);
            asm volatile("s_waitcnt vmcnt(0)" ::: "memory");
        } else {
            XB_SPIN(xb_ld(&bar[XB_XGEN(b.x)]) == gen, bar);
            __builtin_amdgcn_fence(__ATOMIC_ACQUIRE, "agent");
            asm volatile("s_waitcnt vmcnt(0)" ::: "memory");
        }
    }
    __syncthreads();
}
struct Frame {
    LAS unsigned char* lds;
    volatile LAS unsigned* MISC;
    gu32* ctl;
    int tid, lane, wave;
    int G;
    unsigned char* ws;
};

namespace pg8 {
struct EpiRowScale {
    static constexpr bool PERM = true, KHOOK = false;
    bf16_t* O; int ldc; const unsigned long long* rowss;
    PG8_LAS float* tab;
    static __device__ __forceinline__ float rstd_of(unsigned long long ss) { return rsqrtf((float)ss * (1.0f / (4096.0f * 16777216.0f)) + 1e-6f); }
    __device__ __forceinline__ void pre(const Unit& u) const { if (threadIdx.x < 256) tab[threadIdx.x] = rstd_of(rowss[u.pm * BM + threadIdx.x]); }
    __device__ __forceinline__ void operator()(const f32x4 (&acc)[2][2][4][2], const Unit& u, int wr, int wc, int fr, int fq, int slot, bool has_next, const Unit& nxt) const {
        const int row0 = u.pm * BM + wr * 64 + fr, col0 = u.pn * BM + wc * 32 + 8 * fq;
        const bool fill = has_next && threadIdx.x < 256;
        unsigned long long ssn = 0; if (fill) ssn = rowss[nxt.pm * BM + threadIdx.x];
        float rsv[8];
#pragma unroll
        for (int i = 0; i < 8; ++i) rsv[i] = tab[slot * 256 + wr * 64 + fr + (i >> 2) * HALF + (i & 3) * 16];
#pragma unroll
        for (int ai = 0; ai < 2; ++ai)
#pragma unroll
            for (int m = 0; m < 4; ++m) { const int row = row0 + ai * HALF + m * 16; const float rs = rsv[ai * 4 + m];
                bf16_t* rowp = O + (size_t)row * ldc + col0;
#pragma unroll
                for (int bj = 0; bj < 2; ++bj) { const f32x4 v0 = acc[ai][bj][m][0] * rs, v1 = acc[ai][bj][m][1] * rs;
                    u32x4 w; w.x = cvt_pk_bf16(v0[0], v0[1]); w.y = cvt_pk_bf16(v0[2], v0[3]); w.z = cvt_pk_bf16(v1[0], v1[1]); w.w = cvt_pk_bf16(v1[2], v1[3]);
                    *(u32x4*)(rowp + bj * HALF) = w; } }
        if (fill) tab[(slot ^ 1) * 256 + threadIdx.x] = rstd_of(ssn);
    }
};
template <bool RESB, bool KH>
struct EpiResid {
    static constexpr bool PERM = true, KHOOK = KH;
    const float* res; const bf16_t* resb; float* out; bf16_t* hb; unsigned long long* rowss_next;
    const float* ssg; PG8_LAS float* tab;
    __device__ __forceinline__ void pre(const Unit&) const {}
    __device__ __forceinline__ void fill(const Unit& u) const {
        if (threadIdx.x < 256) {
            unsigned voff = (unsigned)(u.pm * BM + (int)threadIdx.x) * 4u; float s0, s1, s2, s3, s4, s5, s6, s7;
            asm volatile("global_load_dword %0, %8, %9\n\tv_add_u32 %8, 0x8000, %8\n\tglobal_load_dword %1, %8, %9\n\tv_add_u32 %8, 0x8000, %8\n\t"
                         "global_load_dword %2, %8, %9\n\tv_add_u32 %8, 0x8000, %8\n\tglobal_load_dword %3, %8, %9\n\tv_add_u32 %8, 0x8000, %8\n\t"
                         "global_load_dword %4, %8, %9\n\tv_add_u32 %8, 0x8000, %8\n\tglobal_load_dword %5, %8, %9\n\tv_add_u32 %8, 0x8000, %8\n\t"
                         "global_load_dword %6, %8, %9\n\tv_add_u32 %8, 0x8000, %8\n\tglobal_load_dword %7, %8, %9\n\ts_waitcnt vmcnt(0)"
                         : "=&v"(s0), "=&v"(s1), "=&v"(s2), "=&v"(s3), "=&v"(s4), "=&v"(s5), "=&v"(s6), "=&v"(s7), "+v"(voff) : "s"(ssg) : "memory");
            const float r0 = rsqrtf(s0 * (1.0f / 1024.0f) + 1e-6f), r1 = rsqrtf(s1 * (1.0f / 1024.0f) + 1e-6f), r2 = rsqrtf(s2 * (1.0f / 1024.0f) + 1e-6f), r3 = rsqrtf(s3 * (1.0f / 1024.0f) + 1e-6f);
            const float r4 = rsqrtf(s4 * (1.0f / 1024.0f) + 1e-6f), r5 = rsqrtf(s5 * (1.0f / 1024.0f) + 1e-6f), r6 = rsqrtf(s6 * (1.0f / 1024.0f) + 1e-6f), r7 = rsqrtf(s7 * (1.0f / 1024.0f) + 1e-6f);
            PG8_LAS float* tp = tab + threadIdx.x;
            tp[0] = r0 * __builtin_amdgcn_rcpf(r1); tp[256] = r1 * __builtin_amdgcn_rcpf(r2); tp[512] = r2 * __builtin_amdgcn_rcpf(r3); tp[768] = r3 * __builtin_amdgcn_rcpf(r4);
            tp[1024] = r4 * __builtin_amdgcn_rcpf(r5); tp[1280] = r5 * __builtin_amdgcn_rcpf(r6); tp[1536] = r6 * __builtin_amdgcn_rcpf(r7); tp[1792] = r7; }
    }
    __device__ __forceinline__ void khook(f32x4 (&acc)[2][2][4][2], int b, int wr, int fr) const {
#pragma unroll
        for (int ai = 0; ai < 2; ++ai)
#pragma unroll
            for (int m = 0; m < 4; ++m) { const float q = tab[b * 256 + wr * 64 + fr + ai * HALF + m * 16];
#pragma unroll
                for (int bj = 0; bj < 2; ++bj) { acc[ai][bj][m][0] *= q; acc[ai][bj][m][1] *= q; } }
    }
    __device__ __forceinline__ void operator()(const f32x4 (&acc_)[2][2][4][2], const Unit& u, int wr, int wc, int fr, int fq, int, bool, const Unit&) const {
        const int row0 = u.pm * BM + wr * 64 + fr, col0 = u.pn * BM + wc * 32 + 8 * fq;
        f32x4 acc[2][2][4][2];
#pragma unroll
        for (int ai = 0; ai < 2; ++ai)
#pragma unroll
            for (int m = 0; m < 4; ++m) { float q = 1.0f; if constexpr (KH) q = tab[7 * 256 + wr * 64 + fr + ai * HALF + m * 16];
#pragma unroll
                for (int bj = 0; bj < 2; ++bj) { acc[ai][bj][m][0] = KH ? acc_[ai][bj][m][0] * q : acc_[ai][bj][m][0]; acc[ai][bj][m][1] = KH ? acc_[ai][bj][m][1] * q : acc_[ai][bj][m][1]; } }
        if constexpr (RESB) {
            u32x4 R[2][4];
#define EPR_LOADB(b) { _Pragma("unroll") for (int q_ = 0; q_ < 4; ++q_) { const int rowl_ = row0 + ((b) >> 1) * HALF + (((b) & 1) * 2 + (q_ >> 1)) * 16; \
                R[(b) & 1][q_] = *(const u32x4*)(resb + (size_t)rowl_ * 4096 + col0 + (q_ & 1) * HALF); } }
            EPR_LOADB(0)
#pragma unroll
            for (int b = 0; b < 4; ++b) {
                if (b == 0) EPR_LOADB(1) else if (b == 1) EPR_LOADB(2) else if (b == 2) EPR_LOADB(3)
#pragma unroll
                for (int rl = 0; rl < 2; ++rl) { const int ai = b >> 1, m = (b & 1) * 2 + rl, row = row0 + ai * HALF + m * 16; const size_t off = (size_t)row * 4096 + col0; float ss = 0.f;
#pragma unroll
                    for (int bj = 0; bj < 2; ++bj) { const u32x4 rq = R[b & 1][rl * 2 + bj];
                        f32x4 o0, o1;
                        o0[0] = __builtin_bit_cast(float, rq.x << 16) + acc[ai][bj][m][0][0]; o0[1] = __builtin_bit_cast(float, rq.x & 0xffff0000u) + acc[ai][bj][m][0][1];
                        o0[2] = __builtin_bit_cast(float, rq.y << 16) + acc[ai][bj][m][0][2]; o0[3] = __builtin_bit_cast(float, rq.y & 0xffff0000u) + acc[ai][bj][m][0][3];
                        o1[0] = __builtin_bit_cast(float, rq.z << 16) + acc[ai][bj][m][1][0]; o1[1] = __builtin_bit_cast(float, rq.z & 0xffff0000u) + acc[ai][bj][m][1][1];
                        o1[2] = __builtin_bit_cast(float, rq.w << 16) + acc[ai][bj][m][1][2]; o1[3] = __builtin_bit_cast(float, rq.w & 0xffff0000u) + acc[ai][bj][m][1][3];
                        if (out) { *(f32x4*)(out + off + bj * HALF) = o0; *(f32x4*)(out + off + bj * HALF + 4) = o1; }
                        ss += (o0[0] * o0[0] + o0[1] * o0[1]) + (o0[2] * o0[2] + o0[3] * o0[3]) + (o1[0] * o1[0] + o1[1] * o1[1]) + (o1[2] * o1[2] + o1[3] * o1[3]);
                        if (hb) { u32x4 w; w.x = cvt_pk_bf16(o0[0], o0[1]); w.y = cvt_pk_bf16(o0[2], o0[3]); w.z = cvt_pk_bf16(o1[0], o1[1]); w.w = cvt_pk_bf16(o1[2], o1[3]);
                            *(u32x4*)(hb + off + bj * HALF) = w; } }
                    if (rowss_next) { ss += __shfl_xor(ss, 16); ss += __shfl_xor(ss, 32); if (fq == 0) atomicAdd(rowss_next + row, (unsigned long long)__float2ll_rn(ss * 16777216.0f)); } }
            }
#undef EPR_LOADB
        } else {
            f32x4 R[2][8];
#define EPR_LOAD(b) { _Pragma("unroll") for (int q_ = 0; q_ < 8; ++q_) { const int rowl_ = row0 + ((b) >> 1) * HALF + (((b) & 1) * 2 + (q_ >> 2)) * 16; \
                R[(b) & 1][q_] = *(const f32x4*)(res + (size_t)rowl_ * 4096 + col0 + ((q_ >> 1) & 1) * HALF + (q_ & 1) * 4); } }
            EPR_LOAD(0)
#pragma unroll
            for (int b = 0; b < 4; ++b) {
                if (b == 0) EPR_LOAD(1) else if (b == 1) EPR_LOAD(2) else if (b == 2) EPR_LOAD(3)
#pragma unroll
                for (int rl = 0; rl < 2; ++rl) { const int ai = b >> 1, m = (b & 1) * 2 + rl, row = row0 + ai * HALF + m * 16; const size_t off = (size_t)row * 4096 + col0; float ss = 0.f;
#pragma unroll
                    for (int bj = 0; bj < 2; ++bj) {
                        const f32x4 o0 = R[b & 1][rl * 4 + bj * 2] + acc[ai][bj][m][0], o1 = R[b & 1][rl * 4 + bj * 2 + 1] + acc[ai][bj][m][1];
                        if (out) { *(f32x4*)(out + off + bj * HALF) = o0; *(f32x4*)(out + off + bj * HALF + 4) = o1; }
                        ss += (o0[0] * o0[0] + o0[1] * o0[1]) + (o0[2] * o0[2] + o0[3] * o0[3]) + (o1[0] * o1[0] + o1[1] * o1[1]) + (o1[2] * o1[2] + o1[3] * o1[3]);
                        if (hb) { u32x4 w; w.x = cvt_pk_bf16(o0[0], o0[1]); w.y = cvt_pk_bf16(o0[2], o0[3]); w.z = cvt_pk_bf16(o1[0], o1[1]); w.w = cvt_pk_bf16(o1[2], o1[3]);
                            *(u32x4*)(hb + off + bj * HALF) = w; } }
                    if (rowss_next) { ss += __shfl_xor(ss, 16); ss += __shfl_xor(ss, 32); if (fq == 0) atomicAdd(rowss_next + row, (unsigned long long)__float2ll_rn(ss * 16777216.0f)); } }
            }
#undef EPR_LOAD
        }
    }
};
struct EpiPoolGrp {
    static constexpr bool PERM = true, KHOOK = false;
    bf16_t* O; const bf16_t* vz; const float* bg; const float* sc;
    __device__ __forceinline__ void pre(const Unit&) const {}
    __device__ __forceinline__ void operator()(const f32x4 (&acc)[2][2][4][2], const Unit& u, int wr, int wc, int fr, int fq, int, bool, const Unit&) const {
        const int row0 = u.pm * BM + wr * 64 + fr, col0 = u.pn * BM + wc * 32 + 8 * fq;
        f32x4 bv[2][2], sv[2][2];
#pragma unroll
        for (int bj = 0; bj < 2; ++bj)
#pragma unroll
            for (int n = 0; n < 2; ++n) { bv[bj][n] = *(const f32x4*)(bg + col0 + bj * HALF + 4 * n); sv[bj][n] = *(const f32x4*)(sc + col0 + bj * HALF + 4 * n); }
        u32x4 zz[8], wv[8];
#define EPG_LOAD(ai_) { _Pragma("unroll") for (int q_ = 0; q_ < 8; ++q_) zz[q_] = *(const u32x4*)(vz + (size_t)(row0 + (ai_) * HALF + (q_ >> 1) * 16) * 16384 + 8192 + col0 + (q_ & 1) * HALF); }
#define EPG_CALC(ai_) { _Pragma("unroll") for (int q_ = 0; q_ < 8; ++q_) { const int m_ = q_ >> 1, bj_ = q_ & 1; const u32x4 zq = zz[q_]; \
            const f32x4 v0 = (acc[ai_][bj_][m_][0] + bv[bj_][0]) * sv[bj_][0], v1 = (acc[ai_][bj_][m_][1] + bv[bj_][1]) * sv[bj_][1]; \
            float z[8]; z[0] = __builtin_bit_cast(float, zq.x << 16); z[1] = __builtin_bit_cast(float, zq.x & 0xffff0000u); z[2] = __builtin_bit_cast(float, zq.y << 16); z[3] = __builtin_bit_cast(float, zq.y & 0xffff0000u); \
            z[4] = __builtin_bit_cast(float, zq.z << 16); z[5] = __builtin_bit_cast(float, zq.z & 0xffff0000u); z[6] = __builtin_bit_cast(float, zq.w << 16); z[7] = __builtin_bit_cast(float, zq.w & 0xffff0000u); \
            float o[8]; \
            _Pragma("unroll") for (int j = 0; j < 4; ++j) { o[j] = v0[j] * (z[j] * __builtin_amdgcn_rcpf(1.f + __expf(-z[j]))); o[4 + j] = v1[j] * (z[4 + j] * __builtin_amdgcn_rcpf(1.f + __expf(-z[4 + j]))); } \
            wv[q_].x = cvt_pk_bf16(o[0], o[1]); wv[q_].y = cvt_pk_bf16(o[2], o[3]); wv[q_].z = cvt_pk_bf16(o[4], o[5]); wv[q_].w = cvt_pk_bf16(o[6], o[7]); } }
#define EPG_STORE(ai_) { _Pragma("unroll") for (int q_ = 0; q_ < 8; ++q_) *(u32x4*)(O + (size_t)(row0 + (ai_) * HALF + (q_ >> 1) * 16) * 8192 + col0 + (q_ & 1) * HALF) = wv[q_]; }
        EPG_LOAD(0) EPG_CALC(0) EPG_LOAD(1) EPG_STORE(0) EPG_CALC(1) EPG_STORE(1)
#undef EPG_LOAD
#undef EPG_CALC
#undef EPG_STORE
    }
};
}

__device__ __forceinline__ void p0_transpose_item(const float* W, int K, int N, bf16* WT, const float* gain, LAS float* scr, int item, int lane) {
    const int nblk = N / 32, kb = item / nblk, nb = item % nblk, k0 = 64 * kb, n0 = 32 * nb;
    const int kr = lane >> 3, nc = (lane & 7) * 4;
    f32x4 v[8];
#pragma unroll
    for (int i = 0; i < 8; ++i) v[i] = __builtin_nontemporal_load((const f32x4*)(W + (size_t)(k0 + 8 * i + kr) * N + n0 + nc));
#pragma unroll
    for (int i = 0; i < 8; ++i) { const float g = gain ? gain[k0 + 8 * i + kr] : 1.0f; *(LAS f32x4*)(scr + (8 * i + kr) * 36 + nc) = v[i] * g; }
    LDS_WAIT(); asm volatile("" ::: "memory");
    const int c = lane & 7;
#pragma unroll
    for (int j = 0; j < 4; ++j) { const int n = (lane >> 3) + 8 * j; const LAS float* s = scr + (8 * c) * 36 + n;
        v4u o; o.x = pk2(s[0 * 36], s[1 * 36]); o.y = pk2(s[2 * 36], s[3 * 36]); o.z = pk2(s[4 * 36], s[5 * 36]); o.w = pk2(s[6 * 36], s[7 * 36]);
        *(GAS v4u*)(WT + (size_t)(n0 + n) * K + k0 + 8 * c) = o; }
    LDS_WAIT(); asm volatile("" ::: "memory");
}
struct AllIn { const float* in[30]; };
__device__ __forceinline__ const float* ldin(int i) { int off = i * 8; asm volatile("" : "+s"(off));
    const char __attribute__((address_space(4)))* kp = (const char __attribute__((address_space(4)))*)__builtin_amdgcn_kernarg_segment_ptr();
    return *(const float* const __attribute__((address_space(4)))*)(kp + off); }
__device__ __forceinline__ void p0_prologue(Frame& F, const float* x, bf16* hb, unsigned long long* rowss0) {
    LAS float* scr = (LAS float*)(F.lds + RING_OFF + F.wave * 16384);
    const int gw = blockIdx.x * NWAVES + F.wave, NGW = F.G * NWAVES;
    unsigned char* ws = F.ws;
    constexpr int I_SIN = (D / 64) * (SSD_IN / 32), I_SOUT = (SSD_DI / 64) * (D / 32), I_PIN = (D / 64) * (16384 / 32), I_PG = (2048 / 64) * (2048 / 32), I_POUT = I_SOUT, I_MIN = I_PIN, I_MOUT = (D / 64) * (D / 32);
    constexpr int NITEMS = 2 * I_SIN + 2 * I_SOUT + I_PIN + 4 * I_PG + I_POUT + I_MIN + I_MOUT;
    for (int it = gw; it < NITEMS; it += NGW) {
        int r = NITEMS - 1 - it;
        if (r < I_SIN) { p0_transpose_item(ldin(2), D, SSD_IN, (bf16*)(ws + WS_W_SSD0_IN), ldin(1), scr, r, F.lane); continue; } r -= I_SIN;
        if (r < I_SOUT) { p0_transpose_item(ldin(9), SSD_DI, D, (bf16*)(ws + WS_W_SSD0_OUT), ldin(8), scr, r, F.lane); continue; } r -= I_SOUT;
        if (r < I_PIN) { p0_transpose_item(ldin(11), D, 16384, (bf16*)(ws + WS_W_POOL_IN), ldin(10), scr, r, F.lane); continue; } r -= I_PIN;
        if (r < 4 * I_PG) { const int g = r / I_PG; p0_transpose_item(ldin(12) + (size_t)g * 2048 * 2048, 2048, 2048, (bf16*)(ws + WS_W_POOL_GRP) + (size_t)g * 2048 * 2048, nullptr, scr, r % I_PG, F.lane); continue; } r -= 4 * I_PG;
        if (r < I_POUT) { p0_transpose_item(ldin(15), POOL_W, D, (bf16*)(ws + WS_W_POOL_OUT), nullptr, scr, r, F.lane); continue; } r -= I_POUT;
        if (r < I_MIN) { p0_transpose_item(ldin(17), D, 16384, (bf16*)(ws + WS_W_MOBA_IN), ldin(16), scr, r, F.lane); continue; } r -= I_MIN;
        if (r < I_MOUT) { p0_transpose_item(ldin(20), D, D, (bf16*)(ws + WS_W_MOBA_OUT), nullptr, scr, r, F.lane); continue; } r -= I_MOUT;
        if (r < I_SIN) { p0_transpose_item(ldin(22), D, SSD_IN, (bf16*)(ws + WS_W_SSD3_IN), ldin(21), scr, r, F.lane); continue; } r -= I_SIN;
        p0_transpose_item(ldin(29), SSD_DI, D, (bf16*)(ws + WS_W_SSD3_OUT), ldin(28), scr, r, F.lane);
    }
    for (int m = gw; m < M; m += NGW) {
        const GAS f32x4* xr = (const GAS f32x4*)(x + (size_t)m * D) + F.lane; GAS v2u* o8 = (GAS v2u*)(hb + (size_t)m * D) + F.lane; float s = 0.f;
#pragma unroll 4
        for (int j = 0; j < 16; ++j) { const f32x4 v = xr[64 * j]; s += (v.x * v.x + v.y * v.y) + (v.z * v.z + v.w * v.w); v2u w; w.x = pk2(v.x, v.y); w.y = pk2(v.z, v.w); o8[64 * j] = w; }
        s = wave_sum(s); if (F.lane == 0) rowss0[m] = (unsigned long long)__float2ll_rn(s * 16777216.0f);
    }
}

__device__ __forceinline__ void dt_phase(Frame& F, const bf16* A, const bf16* Wdt, const unsigned long long* rowss, const float* dt_bias, float* dt_out) {
    const int lane = F.lane, r = lane & 31, hh = lane >> 5;
    LAS float* P = (LAS float*)(F.lds + RING_OFF);
    for (int u = blockIdx.x; u < M / 32; u += F.G) {
        const bf16* ap = A + (size_t)(u * 32 + r) * D + F.wave * 512 + hh * 8;
        const bf16* bp = Wdt + (size_t)r * D + F.wave * 512 + hh * 8;
        f32x16 acc[4];
#pragma unroll
        for (int nb = 0; nb < 4; ++nb) acc[nb] = zero16();
#pragma unroll 4
        for (int ks = 0; ks < 32; ++ks) {
            const bf16x8 a = *(const bf16x8*)(ap + ks * 16);
#pragma unroll
            for (int nb = 0; nb < 4; ++nb) { const bf16x8 b = *(const bf16x8*)(bp + (size_t)nb * 32 * D + ks * 16); acc[nb] = __builtin_amdgcn_mfma_f32_32x32x16_bf16(a, b, acc[nb], 0, 0, 0); }
        }
#pragma unroll
        for (int nb = 0; nb < 4; ++nb)
#pragma unroll
            for (int j = 0; j < 16; ++j) { const int row = (j & 3) + 8 * (j >> 2) + 4 * hh; P[F.wave * 4096 + row * 128 + nb * 32 + r] = acc[nb][j]; }
        __syncthreads();
#pragma unroll
        for (int j = 0; j < 8; ++j) { const int idx = F.tid + 512 * j; float s = 0.f;
#pragma unroll
            for (int w = 0; w < 8; ++w) s += P[w * 4096 + idx];
            const int row = u * 32 + (idx >> 7), col = idx & 127;
            const float v = s * rsqrtf((float)rowss[row] * (1.0f / (4096.0f * 16777216.0f)) + RMS_EPS) + dt_bias[col];
            dt_out[(size_t)row * 128 + col] = fmaxf(v, 0.f) + log1pf(__expf(-fabsf(v))); }
        __syncthreads();
    }
}
__device__ __forceinline__ int pi32(int r) { return (r & ~0xC) | ((r & 4) << 1) | ((r & 8) >> 1); }
__device__ __forceinline__ void conv_phase(Frame& F, const bf16* zx, const float* cw, const float* cb, bf16* xc, bf16* xtile, bf16* btT, bf16* btok, bf16* ctok) {
    constexpr int NCG = SSD_CONV / 8, RUN = 16, NIT = (M / RUN) * NCG;
    LAS unsigned char* STG = F.lds + RING_OFF + F.wave * 8192;
    for (int it = blockIdx.x * 512 + F.tid; it < NIT; it += F.G * 512) {
        const int cg = it % NCG, tr = it / NCG, c0 = cg * 8, t0 = tr * RUN;
        v4u rows[RUN + 3];
#pragma unroll
        for (int i = 0; i < RUN + 3; ++i) { const int t = t0 - 3 + i; if (t >= 0) rows[i] = *(const v4u*)(zx + (size_t)t * SSD_MAIN + SSD_DI + c0); else { rows[i].x = 0u; rows[i].y = 0u; rows[i].z = 0u; rows[i].w = 0u; } }
        float w[4][8], b[8];
#pragma unroll
        for (int k = 0; k < 4; ++k) { const f32x4 a = *(const f32x4*)(cw + k * SSD_CONV + c0), bq = *(const f32x4*)(cw + k * SSD_CONV + c0 + 4);
#pragma unroll
            for (int j = 0; j < 4; ++j) { w[k][j] = a[j]; w[k][4 + j] = bq[j]; } }
        { const f32x4 a = *(const f32x4*)(cb + c0), bq = *(const f32x4*)(cb + c0 + 4);
#pragma unroll
          for (int j = 0; j < 4; ++j) { b[j] = a[j]; b[4 + j] = bq[j]; } }
        const int kind = c0 < SSD_DI ? 0 : (c0 < SSD_DI + 1024 ? 1 : 2);
        const int chunk = t0 >> 7, tl0 = t0 & 127;
        unsigned char* ptok; unsigned char* pch;
        if (kind == 0) { const int h = c0 >> 6, pt = (c0 >> 5) & 1, r0 = c0 & 31;
            ptok = (unsigned char*)(xc + (size_t)t0 * SSD_DI + c0);
            pch = (unsigned char*)(xtile + ((((size_t)chunk * 128 + h) * 2 + pt) * 8 + (tl0 >> 4)) * 512 + (size_t)r0 * 8); }
        else { const int n0 = (c0 - SSD_DI) & 127, g = ((c0 - SSD_DI) >> 7) & 7, ksN = n0 >> 4, h2N = (n0 >> 3) & 1, nt = n0 >> 5;
            ptok = (unsigned char*)((kind == 1 ? btok : ctok) + ((((size_t)chunk * 8 + g) * 4 + (tl0 >> 5)) * 8 + ksN) * 512 + (size_t)((tl0 & 16) + 32 * h2N) * 8);
            pch = (unsigned char*)(btT + ((((size_t)chunk * 8 + g) * 4 + nt) * 8 + (tl0 >> 4)) * 512 + (size_t)((n0 & 16) | ((n0 & 8) >> 1)) * 8); }
#pragma unroll
        for (int tb = 0; tb < RUN; tb += 8) {
            unsigned yp[8][4];
#pragma unroll
            for (int i = 0; i < 8; ++i) {
                float y[8];
#pragma unroll
                for (int j = 0; j < 8; ++j) { float a = b[j];
#pragma unroll
                    for (int k = 0; k < 4; ++k) { const v4u q = rows[tb + i + k]; const unsigned wd = (j >> 1) == 0 ? q.x : (j >> 1) == 1 ? q.y : (j >> 1) == 2 ? q.z : q.w; a += w[k][j] * ((j & 1) ? bfhi(wd) : bflo(wd)); }
                    y[j] = silu_f(a); }
                v4u o; o.x = pk2(y[0], y[1]); o.y = pk2(y[2], y[3]); o.z = pk2(y[4], y[5]); o.w = pk2(y[6], y[7]);
                const int ti = tb + i, pti = (ti & 3) | ((ti & 4) << 1) | ((ti & 8) >> 1);
                if (kind == 1) *(v4u*)(ptok + pti * 16) = o;
                else if (kind == 2) *(v4u*)(ptok + ti * 16) = o;
#pragma unroll
                for (int j = 0; j < 8; ++j) { const unsigned hb_ = f2bf(y[j]); if (i & 1) yp[j][i >> 1] |= hb_ << 16; else yp[j][i >> 1] = hb_; }
            }
            if (kind == 0) {
#pragma unroll
                for (int j = 0; j < 8; ++j) { v4u o; o.x = yp[j][0]; o.y = yp[j][1]; o.z = yp[j][2]; o.w = yp[j][3]; *(LAS v4u*)(STG + (F.lane * 8 + j) * 16) = o; }
                LDS_WAIT(); asm volatile("" ::: "memory");
                bf16* xbase = xtile + (((size_t)chunk * 256 + (c0 >> 5) - ((F.lane * 8) >> 5)) * 8 + (tl0 >> 4)) * 512 + (size_t)((tb >> 3) * 32) * 8;
#pragma unroll
                for (int s_ = 0; s_ < 8; ++s_) { const int hpl = 2 * s_ + (F.lane >> 5), slot = F.lane & 31;
                    const v4u o = *(const LAS v4u*)(STG + (hpl * 32 + slot) * 16);
                    *(v4u*)(xbase + (size_t)hpl * 8 * 512 + slot * 8) = o; }
                LDS_WAIT(); asm volatile("" ::: "memory");
            } else if (kind == 1) {
#pragma unroll
                for (int j = 0; j < 8; ++j) { v4u o; o.x = yp[j][0]; o.y = yp[j][1]; o.z = yp[j][2]; o.w = yp[j][3];
                    *(v4u*)(pch + (((j & 4) << 1) | (j & 3)) * 16 + (tb >> 3) * 512) = o; } }
        }
    }
}
__device__ __forceinline__ void ssd_s1_phase(Frame& F, const bf16* xtile, const bf16* btT, const float* dt, const float* a_log, bf16* states, float* decay) {
    const int lane = F.lane, h2 = lane >> 5;
    LAS float* w1 = (LAS float*)(F.lds + RING_OFF) + F.wave * 256;
    LAS unsigned char* BL = F.lds + RING_OFF + 16384;
    for (int u = blockIdx.x; u < 64 * SSD_NG; u += F.G) {
        const int c = u >> 3, g = u & 7, t0 = c * 128;
        float dec_out[2];
#pragma unroll
        for (int hh = 0; hh < 2; ++hh) { const int h = g * 16 + F.wave * 2 + hh; const float A = -__expf(a_log[h]);
            const float d0 = dt[(size_t)(t0 + 2 * lane) * 128 + h], d1 = dt[(size_t)(t0 + 2 * lane + 1) * 128 + h];
            const float a0 = d0 * A, a1 = d1 * A; float s = a0 + a1;
#pragma unroll
            for (int o = 1; o < 64; o <<= 1) { const float v = __shfl_up(s, o); if (lane >= o) s += v; }
            const float cs1 = s, cs0 = s - a1; const float cend = __shfl(s, 63);
            w1[hh * 128 + 2 * lane] = d0 * __expf(cend - cs0); w1[hh * 128 + 2 * lane + 1] = d1 * __expf(cend - cs1);
            dec_out[hh] = __expf(cend); }
        if (lane == 0) { decay[(c * 8 + g) * 32 + F.wave * 2] = dec_out[0]; decay[(c * 8 + g) * 32 + F.wave * 2 + 1] = dec_out[1]; }
        __syncthreads();
        { const bf16* bp = btT + ((((size_t)c * 8 + g) * 4) * 8) * 512 + (size_t)lane * 8; v4u bq[4];
#pragma unroll
          for (int i = 0; i < 4; ++i) bq[i] = *(const v4u*)(bp + (size_t)(F.wave * 4 + i) * 512);
#pragma unroll
          for (int i = 0; i < 4; ++i) *(LAS v4u*)(BL + (F.wave * 4 + i) * 1024 + lane * 16) = bq[i]; }
        __syncthreads();
        bf16x8 Xn[8];
        { const bf16* xp = xtile + ((((size_t)c * 128 + g * 16 + F.wave * 2) * 2) * 8) * 512 + (size_t)lane * 8;
#pragma unroll
          for (int ks = 0; ks < 8; ++ks) Xn[ks] = *(const bf16x8*)(xp + ks * 512); }
#pragma nounroll
        for (int item = 0; item < 4; ++item) { const int hh = item >> 1, pt = item & 1, h = g * 16 + F.wave * 2 + hh;
            bf16x8 Xf[8];
#pragma unroll
            for (int ks = 0; ks < 8; ++ks) { const v4u aq = __builtin_bit_cast(v4u, Xn[ks]);
                const f32x4 wa = *(const LAS f32x4*)(w1 + hh * 128 + ks * 16 + h2 * 8), wb = *(const LAS f32x4*)(w1 + hh * 128 + ks * 16 + h2 * 8 + 4);
                v4u as; as.x = pk2(bflo(aq.x) * wa.x, bfhi(aq.x) * wa.y); as.y = pk2(bflo(aq.y) * wa.z, bfhi(aq.y) * wa.w); as.z = pk2(bflo(aq.z) * wb.x, bfhi(aq.z) * wb.y); as.w = pk2(bflo(aq.w) * wb.z, bfhi(aq.w) * wb.w);
                Xf[ks] = __builtin_bit_cast(bf16x8, as); }
            if (item < 3) { const int hn = g * 16 + F.wave * 2 + ((item + 1) >> 1), ptn = (item + 1) & 1; const bf16* xp = xtile + ((((size_t)c * 128 + hn) * 2 + ptn) * 8) * 512 + (size_t)lane * 8;
#pragma unroll
                for (int ks = 0; ks < 8; ++ks) Xn[ks] = *(const bf16x8*)(xp + ks * 512); }
            bf16* sp = states + ((((size_t)c * 128 + h) * 2 + pt) * 8) * 512 + (size_t)lane * 8;
#pragma unroll
            for (int nt = 0; nt < 4; ++nt) { bf16x8 Bf[8];
#pragma unroll
                for (int ks = 0; ks < 8; ++ks) Bf[ks] = *(const LAS bf16x8*)(BL + (nt * 8 + ks) * 1024 + lane * 16);
                f32x16 acc = zero16();
#pragma unroll
                for (int ks = 0; ks < 8; ++ks) acc = __builtin_amdgcn_mfma_f32_32x32x16_bf16(Bf[ks], Xf[ks], acc, 0, 0, 0);
#pragma unroll
                for (int kk = 0; kk < 2; ++kk) { v4u o; o.x = pk2(acc[8 * kk], acc[8 * kk + 1]); o.y = pk2(acc[8 * kk + 2], acc[8 * kk + 3]); o.z = pk2(acc[8 * kk + 4], acc[8 * kk + 5]); o.w = pk2(acc[8 * kk + 6], acc[8 * kk + 7]);
                    *(v4u*)(sp + (size_t)(2 * nt + kk) * 512) = o; } }
        }
    }
}
__device__ __forceinline__ void ssd_s2_phase(Frame& F, bf16* states, const float* decay) {
    for (int it = blockIdx.x * 512 + F.tid; it < SSD_NH * 64 * 16; it += F.G * 512) {
        const int h = it >> 10; float H[8];
#pragma unroll
        for (int j = 0; j < 8; ++j) H[j] = 0.f;
        v4u* sp = (v4u*)(states + (size_t)it * 8);
#pragma unroll 8
        for (int c = 0; c < 64; ++c) { const v4u q = sp[(size_t)c * (128 * 64 * 16)]; const float dec = decay[(c * 8 + (h >> 4)) * 32 + (h & 15)];
            v4u o; o.x = pk2(H[0], H[1]); o.y = pk2(H[2], H[3]); o.z = pk2(H[4], H[5]); o.w = pk2(H[6], H[7]);
            sp[(size_t)c * (128 * 64 * 16)] = o;
            H[0] = H[0] * dec + bflo(q.x); H[1] = H[1] * dec + bfhi(q.x); H[2] = H[2] * dec + bflo(q.y); H[3] = H[3] * dec + bfhi(q.y);
            H[4] = H[4] * dec + bflo(q.z); H[5] = H[5] * dec + bfhi(q.z); H[6] = H[6] * dec + bflo(q.w); H[7] = H[7] * dec + bfhi(q.w); }
    }
}
__device__ __forceinline__ void ssd_s3_phase(Frame& F, const bf16* xc, const bf16* xtile, const bf16* btok, const bf16* ctok, const bf16* zx, const float* dt, const float* a_log, const float* dsk, float* ssg, const bf16* states, bf16* ybuf) {
    const int lane = F.lane, r = lane & 31, h2 = lane >> 5, li = F.wave >> 1, hhalf = F.wave & 1;
    LAS float* cst = (LAS float*)(F.lds + RING_OFF);
    LAS float* dtt = cst + 2048;
    LAS float* ssw = dtt + 2048;
    LAS float* TT = (LAS float*)(F.lds + RING_OFF + 20480) + F.wave * (32 * 36);
    const int el = lane >> 1, eh = lane & 1;
    for (int u = blockIdx.x; u < 64 * SSD_NG; u += F.G) {
        const int c = u >> 3, g = u & 7, t0 = c * 128;
#pragma unroll
        for (int hh = 0; hh < 2; ++hh) { const int hl = F.wave * 2 + hh, h = g * 16 + hl; const float A = -__expf(a_log[h]);
            const float d0 = dt[(size_t)(t0 + 2 * lane) * 128 + h], d1 = dt[(size_t)(t0 + 2 * lane + 1) * 128 + h];
            const float a1 = d1 * A; float s = d0 * A + a1;
#pragma unroll
            for (int o = 1; o < 64; o <<= 1) { const float v = __shfl_up(s, o); if (lane >= o) s += v; }
            cst[hl * 128 + 2 * lane] = s - a1; cst[hl * 128 + 2 * lane + 1] = s; dtt[hl * 128 + 2 * lane] = d0; dtt[hl * 128 + 2 * lane + 1] = d1; }
        __syncthreads();
        const bf16* cp = ctok + ((((size_t)c * 8 + g) * 4 + li) * 8) * 512 + (size_t)lane * 8;
        f32x16 CBt[4];
        { bf16x8 Cf[8];
#pragma unroll
          for (int ks = 0; ks < 8; ++ks) Cf[ks] = *(const bf16x8*)(cp + ks * 512);
#pragma unroll
          for (int si = 0; si < 4; ++si) {
            if (si <= li) { CBt[si] = zero16(); const bf16* bp = btok + ((((size_t)c * 8 + g) * 4 + si) * 8) * 512 + (size_t)lane * 8; bf16x8 Bf[8];
#pragma unroll
                for (int ks = 0; ks < 8; ++ks) Bf[ks] = *(const bf16x8*)(bp + ks * 512);
#pragma unroll
                for (int ks = 0; ks < 8; ++ks) CBt[si] = __builtin_amdgcn_mfma_f32_32x32x16_bf16(Bf[ks], Cf[ks], CBt[si], 0, 0, 0); }
          } }
        float ssq = 0.f;
        LAS unsigned char* HX = F.lds + RING_OFF + 57344 + hhalf * 32768;
        bf16x8 st[4];
        { const int h = g * 16 + hhalf * 8; const bf16* hp = states + ((((size_t)c * 128 + h) * 2) * 8 + li * 4) * 512 + (size_t)lane * 8;
#pragma unroll
          for (int f = 0; f < 4; ++f) st[f] = *(const bf16x8*)(hp + f * 512); }
#pragma nounroll
        for (int hq = 0; hq < 8; ++hq) {
            const int hl = hhalf * 8 + hq, h = g * 16 + hl;
            const float csl = cst[hl * 128 + 32 * li + r], Dh = dsk[h];
            __syncthreads();
            bf16x8 Cf[8];
            { const bf16* xp = xtile + ((((size_t)c * 128 + h) * 2) * 8 + li * 4) * 512 + (size_t)lane * 8; bf16x8 sx[4];
#pragma unroll
              for (int f = 0; f < 4; ++f) sx[f] = *(const bf16x8*)(xp + f * 512);
#pragma unroll
              for (int ks = 0; ks < 8; ++ks) Cf[ks] = *(const bf16x8*)(cp + ks * 512);
#pragma unroll
              for (int f = 0; f < 4; ++f) { *(LAS bf16x8*)(HX + (li * 4 + f) * 1024 + lane * 16) = st[f]; *(LAS bf16x8*)(HX + 16384 + (li * 4 + f) * 1024 + lane * 16) = sx[f]; } }
            { const int hn = g * 16 + hhalf * 8 + (hq < 7 ? hq + 1 : hq);
              const bf16* hp = states + ((((size_t)c * 128 + hn) * 2) * 8 + li * 4) * 512 + (size_t)lane * 8;
#pragma unroll
              for (int f = 0; f < 4; ++f) st[f] = *(const bf16x8*)(hp + f * 512); }
            __syncthreads();
            f32x16 acc[2];
#pragma unroll
            for (int pt = 0; pt < 2; ++pt) {
                acc[pt] = zero16();
#pragma unroll
                for (int ks = 0; ks < 8; ++ks) { const bf16x8 hf = *(const LAS bf16x8*)(HX + (pt * 8 + ks) * 1024 + lane * 16); acc[pt] = __builtin_amdgcn_mfma_f32_32x32x16_bf16(Cf[ks], hf, acc[pt], 0, 0, 0); }
            }
            v4u zq[2][2];
            asm volatile("" ::: "memory");
            { const size_t t = (size_t)(t0 + 32 * li + el); const int ch = h * 64 + eh * 16; zq[0][0] = *(const v4u*)(zx + t * SSD_MAIN + ch); zq[0][1] = *(const v4u*)(zx + t * SSD_MAIN + ch + 8); }
#pragma unroll
            for (int j = 0; j < 16; ++j) { const float e = __expf(cst[hl * 128 + 32 * li + (j & 3) + 8 * (j >> 2) + 4 * h2]); acc[0][j] *= e; acc[1][j] *= e; }
#pragma unroll
            for (int si = 0; si < 4; ++si) {
                if (si <= li) {
#pragma unroll
                    for (int kk = 0; kk < 2; ++kk) {
                        const int sl = 16 * kk + 8 * h2, s0 = 32 * si + sl;
                        const f32x4 ca = *(const LAS f32x4*)(cst + hl * 128 + s0), cb = *(const LAS f32x4*)(cst + hl * 128 + s0 + 4);
                        const f32x4 da = *(const LAS f32x4*)(dtt + hl * 128 + s0), db = *(const LAS f32x4*)(dtt + hl * 128 + s0 + 4);
                        float gv[8];
#pragma unroll
                        for (int jj = 0; jj < 8; ++jj) { const float cs_s = jj < 4 ? ca[jj & 3] : cb[jj & 3], dt_s = jj < 4 ? da[jj & 3] : db[jj & 3];
                            float v = CBt[si][8 * kk + jj] * __expf(fminf(csl - cs_s, 0.f)) * dt_s;
                            if (si == li && sl + jj > r) v = 0.f;
                            if (si == li && sl + jj == r) v += Dh;
                            gv[jj] = v; }
                        v4u gq; gq.x = pk2(gv[0], gv[1]); gq.y = pk2(gv[2], gv[3]); gq.z = pk2(gv[4], gv[5]); gq.w = pk2(gv[6], gv[7]);
                        const bf16x8 Gf = __builtin_bit_cast(bf16x8, gq);
#pragma unroll
                        for (int pt = 0; pt < 2; ++pt) { const bf16x8 xf = *(const LAS bf16x8*)(HX + 16384 + (pt * 8 + 2 * si + kk) * 1024 + lane * 16);
                            acc[pt] = __builtin_amdgcn_mfma_f32_32x32x16_bf16(Gf, xf, acc[pt], 0, 0, 0); }
                    }
                }
            }
#pragma unroll
            for (int pt = 0; pt < 2; ++pt) {
#pragma unroll
                for (int j = 0; j < 16; ++j) TT[((j & 3) + 8 * (j >> 2) + 4 * h2) * 36 + r] = acc[pt][j];
                LDS_WAIT(); asm volatile("" ::: "memory");
                const size_t t = (size_t)(t0 + 32 * li + el); const int ch = h * 64 + pt * 32 + eh * 16;
                if (pt == 0) { zq[1][0] = *(const v4u*)(zx + t * SSD_MAIN + ch + 32); zq[1][1] = *(const v4u*)(zx + t * SSD_MAIN + ch + 40); }
                const v4u z0 = zq[pt][0], z1 = zq[pt][1];
                const f32x4 a0 = *(const LAS f32x4*)(TT + el * 36 + eh * 16), a1 = *(const LAS f32x4*)(TT + el * 36 + eh * 16 + 4), a2 = *(const LAS f32x4*)(TT + el * 36 + eh * 16 + 8), a3 = *(const LAS f32x4*)(TT + el * 36 + eh * 16 + 12);
                float yv[16];
#define S3_Y(i, av, xw, zw, hi) { const float zs_ = (hi) ? bfhi(zw) : bflo(zw); const float y_ = (av) * silu_f(zs_); yv[i] = y_; ssq += y_ * y_; }
                S3_Y(0, a0.x, 0, z0.x, 0) S3_Y(1, a0.y, 0, z0.x, 1) S3_Y(2, a0.z, 0, z0.y, 0) S3_Y(3, a0.w, 0, z0.y, 1)
                S3_Y(4, a1.x, 0, z0.z, 0) S3_Y(5, a1.y, 0, z0.z, 1) S3_Y(6, a1.z, 0, z0.w, 0) S3_Y(7, a1.w, 0, z0.w, 1)
                S3_Y(8, a2.x, 0, z1.x, 0) S3_Y(9, a2.y, 0, z1.x, 1) S3_Y(10, a2.z, 0, z1.y, 0) S3_Y(11, a2.w, 0, z1.y, 1)
                S3_Y(12, a3.x, 0, z1.z, 0) S3_Y(13, a3.y, 0, z1.z, 1) S3_Y(14, a3.z, 0, z1.w, 0) S3_Y(15, a3.w, 0, z1.w, 1)
#undef S3_Y
                v4u o0, o1; o0.x = pk2(yv[0], yv[1]); o0.y = pk2(yv[2], yv[3]); o0.z = pk2(yv[4], yv[5]); o0.w = pk2(yv[6], yv[7]); o1.x = pk2(yv[8], yv[9]); o1.y = pk2(yv[10], yv[11]); o1.z = pk2(yv[12], yv[13]); o1.w = pk2(yv[14], yv[15]);
                *(v4u*)(ybuf + t * SSD_DI + ch) = o0; *(v4u*)(ybuf + t * SSD_DI + ch + 8) = o1;
                LDS_WAIT(); asm volatile("" ::: "memory");
            }
        }
        ssq += __shfl_xor(ssq, 1);
        if (eh == 0) ssw[hhalf * 128 + 32 * li + el] = ssq;
        __syncthreads();
        if (F.tid < 128) ssg[(size_t)g * M + t0 + F.tid] = ssw[F.tid] + ssw[128 + F.tid];
        __syncthreads();
    }
}
__device__ __forceinline__ void ssd_norm_phase(Frame& F, bf16* ybuf, const float* ssg, const float* norm_w) {
    const int gt = blockIdx.x * 512 + F.tid, chunk = gt & 1023, ch0 = chunk * 8, g = ch0 >> 10;
    const f32x4 wa = *(const f32x4*)(norm_w + ch0), wb = *(const f32x4*)(norm_w + ch0 + 4);
    const int tstep = (F.G * 512) >> 10;
    for (int t = gt >> 10; t < M; t += 4 * tstep) {
        v4u q[4]; float rs[4];
#pragma unroll
        for (int i = 0; i < 4; ++i) { const int ti = t + i * tstep; if (ti < M) { q[i] = *(const v4u*)(ybuf + (size_t)ti * SSD_DI + ch0); rs[i] = ssg[(size_t)g * M + ti]; } }
#pragma unroll
        for (int i = 0; i < 4; ++i) { const int ti = t + i * tstep; if (ti < M) { const float r_ = rsqrtf(rs[i] * (1.0f / 1024.0f) + RMS_EPS); v4u o;
            o.x = pk2(bflo(q[i].x) * r_ * wa.x, bfhi(q[i].x) * r_ * wa.y); o.y = pk2(bflo(q[i].y) * r_ * wa.z, bfhi(q[i].y) * r_ * wa.w);
            o.z = pk2(bflo(q[i].z) * r_ * wb.x, bfhi(q[i].z) * r_ * wb.y); o.w = pk2(bflo(q[i].w) * r_ * wb.z, bfhi(q[i].w) * r_ * wb.w);
            *(v4u*)(ybuf + (size_t)ti * SSD_DI + ch0) = o; } }
    }
}
template <int W> __device__ __forceinline__ void pool_item(const bf16* vz, bf16* dbuf, int c0, int t0) {
    constexpr int RUN = W == 16 ? 8 : 16, NR = RUN + W - 1;
    v4u rows[NR];
#pragma unroll
    for (int i = 0; i < NR; ++i) { const int t = t0 - (W - 1) + i; if (t >= 0) rows[i] = *(const v4u*)(vz + (size_t)t * 16384 + c0); else { rows[i].x = 0u; rows[i].y = 0u; rows[i].z = 0u; rows[i].w = 0u; } }
    float S[8];
#pragma unroll
    for (int j = 0; j < 8; ++j) S[j] = 0.f;
#define POOL_ACC(q, sgn) do { S[0] += sgn bflo((q).x); S[1] += sgn bfhi((q).x); S[2] += sgn bflo((q).y); S[3] += sgn bfhi((q).y); S[4] += sgn bflo((q).z); S[5] += sgn bfhi((q).z); S[6] += sgn bflo((q).w); S[7] += sgn bfhi((q).w); } while (0)
#pragma unroll
    for (int i = 0; i < W - 1; ++i) POOL_ACC(rows[i], +);
#pragma unroll
    for (int i = 0; i < RUN; ++i) { const int t = t0 + i; const v4u q = rows[W - 1 + i]; POOL_ACC(q, +);
        const float inv = __builtin_amdgcn_rcpf((float)(t + 1 < W ? t + 1 : W));
        v4u o; o.x = pk2(S[0] * inv - bflo(q.x), S[1] * inv - bfhi(q.x)); o.y = pk2(S[2] * inv - bflo(q.y), S[3] * inv - bfhi(q.y)); o.z = pk2(S[4] * inv - bflo(q.z), S[5] * inv - bfhi(q.z)); o.w = pk2(S[6] * inv - bflo(q.w), S[7] * inv - bfhi(q.w));
        *(v4u*)(dbuf + (size_t)t * POOL_W + c0) = o;
        POOL_ACC(rows[i], -); }
#undef POOL_ACC
}
template <int W> __device__ __forceinline__ void pool_group(Frame& F, const bf16* vz, bf16* dbuf, int gsel) {
    constexpr int NCG = POOL_GD / 8, RUN = W == 16 ? 8 : 16, NIT = (M / RUN) * NCG;
    for (int it = blockIdx.x * 512 + F.tid; it < NIT; it += F.G * 512) pool_item<W>(vz, dbuf, gsel * POOL_GD + (it % NCG) * 8, (it / NCG) * RUN);
}
__device__ __forceinline__ void pool_phase(Frame& F, const bf16* vz, bf16* dbuf) {
    pool_group<2>(F, vz, dbuf, 0); asm volatile("" ::: "memory");
    pool_group<4>(F, vz, dbuf, 1); asm volatile("" ::: "memory");
    pool_group<8>(F, vz, dbuf, 2); asm volatile("" ::: "memory");
    pool_group<16>(F, vz, dbuf, 3);
}

typedef short s16x4 __attribute__((ext_vector_type(4)));
__device__ __forceinline__ void qknorm_phase(Frame& F, bf16* qkvg, const float* qw, const float* kw, bf16* kmb, bf16* ktile, bf16* vtile) {
    LAS float* red = (LAS float*)(F.lds + 132096);
    LAS unsigned char* KL = F.lds + RING_OFF + F.wave * 16384;
    LAS unsigned char* VL = KL + 8192;
    const int lane = F.lane, r = lane & 31, h2 = lane >> 5;
    const int pr = (r & ~0xC) | ((r & 4) << 1) | ((r & 8) >> 1);
    const float qw0 = qw[2 * lane], qw1 = qw[2 * lane + 1], kw0 = kw[2 * lane], kw1 = kw[2 * lane + 1];
    for (int it = blockIdx.x; it < MOBA_NB * MOBA_H; it += F.G) {
        const int n = it / MOBA_H, h = it % MOBA_H; float ks0 = 0.f, ks1 = 0.f; const int tb = n * 256 + F.wave * 32;
#pragma unroll 8
        for (int i = 0; i < 32; ++i) { const int t = tb + i;
            unsigned* qp = (unsigned*)(qkvg + (size_t)t * 16384 + h * 128) + lane;
            const unsigned qv = *qp, kv = *((const unsigned*)(qkvg + (size_t)t * 16384 + 4096 + h * 128) + lane), vv = *((const unsigned*)(qkvg + (size_t)t * 16384 + 8192 + h * 128) + lane);
            const float q0 = bflo(qv), q1 = bfhi(qv), k0 = bflo(kv), k1 = bfhi(kv);
            const float qs = wave_sum(q0 * q0 + q1 * q1), ks = wave_sum(k0 * k0 + k1 * k1);
            const float qr = rsqrtf(qs * (1.0f / 128.0f) + RMS_EPS), kr = rsqrtf(ks * (1.0f / 128.0f) + RMS_EPS);
            const unsigned qo = pk2(q0 * qr * qw0, q1 * qr * qw1), ko = pk2(k0 * kr * kw0, k1 * kr * kw1);
            *qp = qo; ks0 += bflo(ko); ks1 += bfhi(ko);
            *(LAS unsigned*)(KL + i * 256 + lane * 4) = ko; *(LAS unsigned*)(VL + i * 256 + lane * 4) = vv; }
        red[F.wave * 128 + 2 * lane] = ks0; red[F.wave * 128 + 2 * lane + 1] = ks1;
        LDS_WAIT(); asm volatile("" ::: "memory");
        { const size_t tbase = ((((size_t)h * MOBA_NB + n) * 8 + F.wave) * 8) * 512 + (size_t)lane * 8;
#pragma unroll
          for (int ks = 0; ks < 8; ++ks) *(v4u*)(ktile + tbase + (size_t)ks * 512) = *(const LAS v4u*)(KL + pr * 256 + (16 * ks + 8 * h2) * 2);
          const int qq = (lane & 15) >> 2, pp = lane & 3, b16 = (lane >> 4) & 1;
#pragma unroll
          for (int kk = 0; kk < 2; ++kk)
#pragma unroll
              for (int dt = 0; dt < 4; ++dt) {
                  const LAS unsigned char* a0 = VL + (16 * kk + 8 * h2 + qq) * 256 + (dt * 32 + 16 * b16 + 4 * pp) * 2;
                  const s16x4 lo = __builtin_amdgcn_ds_read_tr16_b64_v4i16((LAS s16x4*)a0), hi = __builtin_amdgcn_ds_read_tr16_b64_v4i16((LAS s16x4*)(a0 + 4 * 256));
                  bf16x8 f; f[0] = lo[0]; f[1] = lo[1]; f[2] = lo[2]; f[3] = lo[3]; f[4] = hi[0]; f[5] = hi[1]; f[6] = hi[2]; f[7] = hi[3];
                  *(bf16x8*)(vtile + tbase + (size_t)(kk * 4 + dt) * 512) = f; } }
        __syncthreads();
        if (F.tid < 128) { float s = 0.f;
#pragma unroll
            for (int w = 0; w < 8; ++w) s += red[w * 128 + F.tid];
            kmb[((size_t)h * MOBA_NB + n) * 128 + F.tid] = (bf16)f2bf(s * (1.0f / 256.0f)); }
        __syncthreads();
    }
}

__device__ __forceinline__ void moba_gate_phase(Frame& F, const bf16* qkvg, const bf16* kmb, int* cntg, unsigned short* listg, unsigned char* selvg) {
    const int lane = F.lane, r = lane & 31, h2 = lane >> 5;
    LAS unsigned short* LIST = (LAS unsigned short*)(F.lds + RING_OFF);
    LAS int* CNTW = (LAS int*)(F.lds + RING_OFF + 16384);
    LAS int* TOT = (LAS int*)(F.lds + RING_OFF + 17408);
    for (int u = blockIdx.x; u < MOBA_H * MOBA_NB; u += F.G) {
        const int h = u >> 5, j = u & 31;
        int s0 = -1, s1 = -1, s2 = -1;
        { const bf16* qp = qkvg + (size_t)(j * 256 + F.wave * 32 + r) * 16384 + h * 128 + h2 * 8; const bf16* kp = kmb + ((size_t)h * MOBA_NB + r) * 128 + h2 * 8;
          f32x16 gs = zero16();
#pragma unroll
          for (int ks = 0; ks < 8; ++ks) { const bf16x8 a = *(const bf16x8*)(kp + ks * 16), b = *(const bf16x8*)(qp + ks * 16); gs = __builtin_amdgcn_mfma_f32_32x32x16_bf16(a, b, gs, 0, 0, 0); }
          float v0 = -INFINITY, v1 = -INFINITY, v2 = -INFINITY;
#pragma unroll
          for (int n = 0; n < 32; ++n) { const int ri = (n & 3) + 4 * (n >> 3); const float own = gs[ri], oth = __shfl_xor(own, 32);
              float s = (((n >> 2) & 1) == h2) ? own : oth; if (n >= j) s = -INFINITY;
              if (s > v0) { v2 = v1; s2 = s1; v1 = v0; s1 = s0; v0 = s; s0 = n; } else if (s > v1) { v2 = v1; s2 = s1; v1 = s; s1 = n; } else if (s > v2) { v2 = s; s2 = n; } }
        }
        if (h2 == 0) selvg[(size_t)(j * 256 + F.wave * 32 + r) * MOBA_H + h] = (unsigned char)((s0 >= 0 ? 1 : 0) | (s1 >= 0 ? 2 : 0) | (s2 >= 0 ? 4 : 0));
#pragma unroll 4
        for (int n = 0; n < 32; ++n) { const unsigned long long b = __ballot(h2 == 0 && (s0 == n || s1 == n || s2 == n)); if (lane == 0) CNTW[F.wave * 32 + n] = __popcll(b); }
        __syncthreads();
        int basev = 0, totv = 0;
        if (lane < 32) {
#pragma unroll
            for (int w = 0; w < 8; ++w) { const int cval = CNTW[w * 32 + lane]; if (w < F.wave) basev += cval; totv += cval; } }
#pragma unroll 4
        for (int n = 0; n < 32; ++n) { const bool mine = h2 == 0 && (s0 == n || s1 == n || s2 == n); const unsigned long long b = __ballot(mine);
            const int base = __builtin_amdgcn_readlane(basev, n);
            if (mine) { const int pos = base + __popcll(b & ((1ull << lane) - 1ull)); const int slot = (s0 == n) ? 0 : (s1 == n) ? 1 : 2; LIST[n * 256 + pos] = (unsigned short)((F.wave * 32 + r) | (slot << 8)); } }
        if (F.wave == 0 && lane < 32) { TOT[lane] = totv; cntg[((size_t)h * 32 + lane) * 32 + j] = totv; }
        __syncthreads();
        for (int i = F.tid; i < 32 * 256; i += 512) { const int n = i >> 8, pos = i & 255; if (pos < TOT[n]) listg[(((size_t)h * 32 + n) * 32 + j) * 256 + pos] = LIST[i]; }
        __syncthreads();
    }
}
__device__ __forceinline__ void moba_kv_phase(Frame& F, const bf16* qkvg, const bf16* ktile, const bf16* vtile, const int* cntg, const unsigned short* listg, const float* qw, const float* kw, bf16* part, float* lpart) {
    const int lane = F.lane, r = lane & 31, h2 = lane >> 5;
    LAS unsigned char* KV = F.lds + RING_OFF;
    LAS int* CHO = (LAS int*)(F.lds + 132096);
    LAS int* PJ = (LAS int*)(F.lds + 136320);
    float c2;
    { float mq = fmaxf(fabsf(qw[2 * lane]), fabsf(qw[2 * lane + 1])), mk = fmaxf(fabsf(kw[2 * lane]), fabsf(kw[2 * lane + 1])); mq = wave_max(mq); mk = wave_max(mk);
      c2 = (11.3137085f * mq * mk * 1.03f + 0.1f) * 1.44269504f; }
    const float c1 = 0.08838834764831845f * 1.44269504f;
    for (int i = F.tid; i < 1024; i += 512) { const int n = i & 31; int E = 0; const int* cp = cntg + (size_t)i * 32;
        for (int j = n + 1; j < 32; ++j) E += cp[j];
        CHO[i] = (8 + ((E + 31) >> 5) + 7) >> 3; }
    __syncthreads();
    if (F.wave == 0) { int loc[16]; int s = 0;
#pragma unroll
        for (int k = 0; k < 16; ++k) { loc[k] = CHO[lane * 16 + k]; s += loc[k]; }
        int inc = s;
#pragma unroll
        for (int o = 1; o < 64; o <<= 1) { const int v = __shfl_up(inc, o); if (lane >= o) inc += v; }
        int run = inc - s;
#pragma unroll
        for (int k = 0; k < 16; ++k) { CHO[lane * 16 + k] = run; run += loc[k]; }
        if (lane == 63) CHO[1024] = inc; }
    __syncthreads();
    const int NC = CHO[1024];
    const int cbeg = (int)(((long)blockIdx.x * NC) / F.G), cend = (int)(((long)(blockIdx.x + 1) * NC) / F.G);
    int cur_hn = -1;
    for (int cid = cbeg; cid < cend; ++cid) {
        int lo = 0, hi = 1023;
        while (lo < hi) { const int mid = (lo + hi + 1) >> 1; if (CHO[mid] <= cid) lo = mid; else hi = mid - 1; }
        const int h = lo >> 5, n = lo & 31, c = cid - CHO[lo];
        const bool reload = lo != cur_hn; cur_hn = lo;
        if (reload) {
            __syncthreads();
            if (F.wave == 0) { int v = (lane < 32 && lane > n) ? cntg[((size_t)h * 32 + n) * 32 + lane] : 0; int inc = v;
#pragma unroll
                for (int o = 1; o < 32; o <<= 1) { const int w = __shfl_up(inc, o); if (lane >= o) inc += w; }
                if (lane < 32) PJ[lane] = inc - v; if (lane == 31) PJ[32] = inc; }
            const v4u* ks = (const v4u*)(ktile + (((size_t)h * MOBA_NB + n) * 64) * 512); const v4u* vs = (const v4u*)(vtile + (((size_t)h * MOBA_NB + n) * 64) * 512);
            v4u kb[8], vb[8];
#pragma unroll
            for (int k = 0; k < 8; ++k) { kb[k] = ks[F.tid + 512 * k]; vb[k] = vs[F.tid + 512 * k]; }
#pragma unroll
            for (int k = 0; k < 8; ++k) { *(LAS v4u*)(KV + (F.tid + 512 * k) * 16) = kb[k]; *(LAS v4u*)(KV + 65536 + (F.tid + 512 * k) * 16) = vb[k]; }
            __syncthreads();
        }
        const int E = PJ[32], T = 8 + ((E + 31) >> 5), ti = c * 8 + F.wave;
        int q = 0, slot = 3, tq = 0, nkt = 0; bool valid = false, own = false;
        if (ti < 8) { own = true; q = ti * 32 + r; tq = n * 256 + q; nkt = ti + 1; valid = true; }
        else if (ti < T) { int e = (ti - 8) * 32 + r; valid = e < E; if (!valid) e = (ti - 8) * 32; int jj = n + 1;
            for (int j2 = n + 2; j2 < 32; ++j2) if (PJ[j2] <= e) jj = j2;
            const int ent = listg[(((size_t)h * 32 + n) * 32 + jj) * 256 + (e - PJ[jj])]; q = ent & 255; slot = ent >> 8; tq = jj * 256 + q; nkt = 8; }
        if (nkt > 0) {
            f32x16 O[4]; float lsum = 0.f;
#pragma unroll
            for (int dt = 0; dt < 4; ++dt) O[dt] = zero16();
            bf16x8 Qf[8];
            { const bf16* qp = qkvg + (size_t)tq * 16384 + h * 128 + h2 * 8;
#pragma unroll
              for (int ks = 0; ks < 8; ++ks) Qf[ks] = *(const bf16x8*)(qp + ks * 16); }
#pragma nounroll
            for (int kt = 0; kt < nkt; ++kt) {
                f32x16 S = zero16();
#pragma unroll
                for (int ks = 0; ks < 8; ++ks) { const bf16x8 kf = *(const LAS bf16x8*)(KV + ((kt * 8 + ks) * 64 + lane) * 16); S = __builtin_amdgcn_mfma_f32_32x32x16_bf16(kf, Qf[ks], S, 0, 0, 0); }
                const bool diag = own && (kt == nkt - 1);
                float p[16];
#pragma unroll
                for (int i = 0; i < 16; ++i) { float pv = __builtin_amdgcn_exp2f(S[i] * c1 - c2); if (diag && (kt * 32 + 16 * (i >> 3) + 8 * h2 + (i & 7)) > q) pv = 0.f; p[i] = pv; lsum += pv; }
#pragma unroll
                for (int kk = 0; kk < 2; ++kk) { v4u pq; pq.x = pk2(p[8 * kk], p[8 * kk + 1]); pq.y = pk2(p[8 * kk + 2], p[8 * kk + 3]); pq.z = pk2(p[8 * kk + 4], p[8 * kk + 5]); pq.w = pk2(p[8 * kk + 6], p[8 * kk + 7]);
                    const bf16x8 Pf = __builtin_bit_cast(bf16x8, pq);
#pragma unroll
                    for (int dt = 0; dt < 4; ++dt) { const bf16x8 vf = *(const LAS bf16x8*)(KV + 65536 + ((kt * 8 + kk * 4 + dt) * 64 + lane) * 16); O[dt] = __builtin_amdgcn_mfma_f32_32x32x16_bf16(vf, Pf, O[dt], 0, 0, 0); } }
            }
            lsum += __shfl_xor(lsum, 32);
            {
                const size_t dst = ((size_t)tq * MOBA_H + h) * 4 + slot; if (valid && h2 == 0) lpart[dst] = lsum;
                bf16* pr_ = part + dst * 128 + 8 * h2;
#pragma unroll
                for (int dt = 0; dt < 4; ++dt)
#pragma unroll
                    for (int rp = 0; rp < 2; ++rp) {
                        const unsigned x0 = pk2(O[dt][8 * rp], O[dt][8 * rp + 1]), x1 = pk2(O[dt][8 * rp + 2], O[dt][8 * rp + 3]), y0 = pk2(O[dt][8 * rp + 4], O[dt][8 * rp + 5]), y1 = pk2(O[dt][8 * rp + 6], O[dt][8 * rp + 7]);
                        const auto s0 = __builtin_amdgcn_permlane32_swap(x0, y0, false, false), s1 = __builtin_amdgcn_permlane32_swap(x1, y1, false, false);
                        v4u w; w.x = s0[0]; w.y = s1[0]; w.z = s0[1]; w.w = s1[1];
                        if (valid) *(v4u*)(pr_ + dt * 32 + 16 * rp) = w; } }
        }
    }
}
__device__ __forceinline__ void moba_combine_phase(Frame& F, const bf16* qkvg, const unsigned char* selvg, const bf16* part, const float* lpart, bf16* obuf) {
    for (int it = blockIdx.x * 512 + F.tid; it < M * MOBA_H * 4; it += F.G * 512) {
        const int qd = it & 3, th = it >> 2, h = th & 31, t = th >> 5; const unsigned vm = selvg[th] | 8u;
        v4u w[4][4]; float lv[4];
#pragma unroll
        for (int sl = 0; sl < 4; ++sl) { const bool v = (vm >> sl) & 1u; const size_t rd = (size_t)th * 4 + (v ? sl : 3); lv[sl] = lpart[rd]; const v4u* pp = (const v4u*)(part + rd * 128 + qd * 32);
#pragma unroll
            for (int c = 0; c < 4; ++c) w[sl][c] = pp[c]; }
        const v4u* gp = (const v4u*)(qkvg + (size_t)t * 16384 + 12288 + h * 128 + qd * 32); v4u gq[4];
#pragma unroll
        for (int c = 0; c < 4; ++c) gq[c] = gp[c];
        float o[32]; float l = 0.f;
#pragma unroll
        for (int i = 0; i < 32; ++i) o[i] = 0.f;
#pragma unroll
        for (int sl = 0; sl < 4; ++sl) { const bool v = (vm >> sl) & 1u; const unsigned m = v ? 0xffffffffu : 0u; l += v ? lv[sl] : 0.f;
#pragma unroll
            for (int c = 0; c < 4; ++c) { v4u q = w[sl][c]; q.x &= m; q.y &= m; q.z &= m; q.w &= m;
                o[8 * c] += bflo(q.x); o[8 * c + 1] += bfhi(q.x); o[8 * c + 2] += bflo(q.y); o[8 * c + 3] += bfhi(q.y); o[8 * c + 4] += bflo(q.z); o[8 * c + 5] += bfhi(q.z); o[8 * c + 6] += bflo(q.w); o[8 * c + 7] += bfhi(q.w); } }
        const float inv = 1.0f / l; v4u* op = (v4u*)(obuf + (size_t)t * MOBA_W + h * 128 + qd * 32);
#pragma unroll
        for (int c = 0; c < 4; ++c) { const v4u g_ = gq[c]; v4u r_;
            r_.x = pk2(o[8 * c] * inv * silu_f(bflo(g_.x)), o[8 * c + 1] * inv * silu_f(bfhi(g_.x))); r_.y = pk2(o[8 * c + 2] * inv * silu_f(bflo(g_.y)), o[8 * c + 3] * inv * silu_f(bfhi(g_.y)));
            r_.z = pk2(o[8 * c + 4] * inv * silu_f(bflo(g_.z)), o[8 * c + 5] * inv * silu_f(bfhi(g_.z))); r_.w = pk2(o[8 * c + 6] * inv * silu_f(bflo(g_.w)), o[8 * c + 7] * inv * silu_f(bfhi(g_.w))); op[c] = r_; }
    }
}
#ifndef MK_N_LAUNCHES
#define MK_N_LAUNCHES 1
#endif
__device__ __forceinline__ void xcd_skew(int ticks_per_xcd) {
    const unsigned long long t0 = __builtin_amdgcn_s_memrealtime(); const unsigned long long want = (unsigned long long)(((blockIdx.x >> 3) & 31) * ticks_per_xcd);
    while (__builtin_amdgcn_s_memrealtime() - t0 < want) __builtin_amdgcn_s_sleep(2);
}
constexpr int N_PHASES = 25;
struct Args { AllIn I; float* out; unsigned char* ws; int ph_lo, ph_hi; };
#define INP(i) ldin(i)
__global__ void __launch_bounds__(NWAVES * 64, 2) mk_fwd(Args args) {
    extern __shared__ __attribute__((aligned(16))) unsigned char lds[];
    Frame F;
    F.lds = (LAS unsigned char*)lds;
    F.MISC = (volatile LAS unsigned*)(F.lds + MISC_OFF);
    F.tid = threadIdx.x; F.lane = F.tid & 63; F.wave = __builtin_amdgcn_readfirstlane(F.tid >> 6);
    F.G = gridDim.x; F.ws = args.ws;
    F.ctl = (gu32*)(args.ws + WS_CTL);
    for (int u = F.tid; u < (LDS_BYTES - LDSCTL_OFF) / 4; u += NWAVES * 64) ((LAS unsigned*)(F.lds + LDSCTL_OFF))[u] = 0u;
    __syncthreads();
    const int lo = args.ph_lo, hi = args.ph_hi;
    XcdBarrier bar; bar.bar = (unsigned*)(F.ctl + CW_BAR); bar.x = 0; bar.st = nullptr;
    if (hi - lo > 1) bar = xcd_barrier_post((unsigned*)(F.ctl + CW_BAR), F.MISC + 8);
#define IN(k) (lo <= (k) && (k) < hi)
#define SEAM(k) do { if (IN(k) && IN((k) + 1)) xcd_barrier(bar); } while (0)
#define WSP(T, off) ((T*)(args.ws + (off)))
#define ROWSS(l) ((unsigned long long*)(F.ctl + CW_ROWSS) + (l) * M)

    if (IN(0)) { p0_prologue(F, INP(0), WSP(bf16, WS_HB), ROWSS(0)); } SEAM(0);

#define SSD_LAYER(REPV) { constexpr int rep = (REPV); \
        constexpr int pb = rep ? 18 : 1, ib = rep ? 22 : 2, layer = rep ? 3 : 0; \
        if (IN(pb + 0)) { \
            const bf16* Win_t = WSP(const bf16, rep ? WS_W_SSD3_IN : WS_W_SSD0_IN); \
            pg8::Gemm g{WSP(const bf16, WS_HB), Win_t, M, SSD_MAIN, D, D, D, 0}; pg8::StaticOrder S; S.init(M, SSD_MAIN, F.G, (int)blockIdx.x); \
            pg8::EpiRowScale E{WSP(bf16, WS_ACT_A), SSD_MAIN, ROWSS(layer), (LAS float*)(F.lds + 132096)}; \
            pg8::gemm_phase<pg8::EpiRowScale, pg8::StaticOrder, true, true>(F.lds + RING_OFF, g, S, E); \
            __syncthreads(); \
            dt_phase(F, WSP(const bf16, WS_HB), Win_t + (size_t)SSD_MAIN * D, ROWSS(layer), INP(ib + 3), WSP(float, WS_DT)); \
        } \
        SEAM(pb + 0); \
        if (IN(pb + 1)) conv_phase(F, WSP(const bf16, WS_ACT_A), INP(ib + 1), INP(ib + 2), WSP(bf16, WS_XC), WSP(bf16, WS_XT), WSP(bf16, WS_BT), WSP(bf16, WS_BT + 16 * MiB), WSP(bf16, WS_BT + 32 * MiB)); \
        SEAM(pb + 1); \
        if (IN(pb + 2)) ssd_s1_phase(F, WSP(const bf16, WS_XT), WSP(const bf16, WS_BT), WSP(const float, WS_DT), INP(ib + 4), WSP(bf16, WS_STATES), WSP(float, WS_DECAY)); \
        SEAM(pb + 2); \
        if (IN(pb + 3)) ssd_s2_phase(F, WSP(bf16, WS_STATES), WSP(const float, WS_DECAY)); \
        SEAM(pb + 3); \
        if (IN(pb + 4)) ssd_s3_phase(F, WSP(const bf16, WS_XC), WSP(const bf16, WS_XT), WSP(const bf16, WS_BT + 16 * MiB), WSP(const bf16, WS_BT + 32 * MiB), WSP(const bf16, WS_ACT_A), WSP(const float, WS_DT), INP(ib + 4), INP(ib + 5), WSP(float, WS_SSG), WSP(const bf16, WS_STATES), WSP(bf16, WS_ACT_B)); \
        SEAM(pb + 4); \
        if (IN(pb + 6)) { \
            pg8::Gemm g{WSP(const bf16, WS_ACT_B), WSP(const bf16, rep ? WS_W_SSD3_OUT : WS_W_SSD0_OUT), M, D, SSD_DI, SSD_DI, SSD_DI, 0}; pg8::StaticOrder S; S.init(M, D, F.G, (int)blockIdx.x); \
            if constexpr (rep == 0) { pg8::EpiResid<false, true> E{INP(0), (const bf16*)nullptr, (float*)nullptr, WSP(bf16, WS_HB), ROWSS(1), WSP(const float, WS_SSG), (LAS float*)(F.lds + 132096)}; \
                pg8::gemm_phase<pg8::EpiResid<false, true>, pg8::StaticOrder, true, true>(F.lds + RING_OFF, g, S, E); } \
            else { pg8::EpiResid<true, true> E{(const float*)nullptr, WSP(const bf16, WS_HB), args.out, (bf16*)nullptr, (unsigned long long*)nullptr, WSP(const float, WS_SSG), (LAS float*)(F.lds + 132096)}; \
                pg8::gemm_phase<pg8::EpiResid<true, true>, pg8::StaticOrder, true, true>(F.lds + RING_OFF, g, S, E); } \
        } \
        SEAM(pb + 6); \
    }
    SSD_LAYER(0)
    {
            if (IN(8)) {
                pg8::Gemm g{WSP(const bf16, WS_HB), WSP(const bf16, WS_W_POOL_IN), M, 16384, D, D, D, 0}; pg8::StaticOrder S; S.init(M, 16384, F.G, (int)blockIdx.x);
                pg8::EpiRowScale E{WSP(bf16, WS_ACT_A), 16384, ROWSS(1), (LAS float*)(F.lds + 132096)};
                pg8::gemm_phase<pg8::EpiRowScale, pg8::StaticOrder, true, true>(F.lds + RING_OFF, g, S, E);
            }
            SEAM(8);
            if (IN(9)) pool_phase(F, WSP(const bf16, WS_ACT_A), WSP(bf16, WS_ACT_B));
            SEAM(9);
            if (IN(10)) {
                pg8::Gemm g{WSP(const bf16, WS_ACT_B), WSP(const bf16, WS_W_POOL_GRP), M, POOL_W, POOL_GD, POOL_W, POOL_GD, POOL_GD / 256}; pg8::StaticOrder S; S.init(M, POOL_W, F.G, (int)blockIdx.x);
                pg8::EpiPoolGrp E{WSP(bf16, WS_ACT_C), WSP(const bf16, WS_ACT_A), INP(13), INP(14)};
                pg8::gemm_phase<pg8::EpiPoolGrp, pg8::StaticOrder, true, true>(F.lds + RING_OFF, g, S, E);
            }
            SEAM(10);
            if (IN(11)) {
                pg8::Gemm g{WSP(const bf16, WS_ACT_C), WSP(const bf16, WS_W_POOL_OUT), M, D, POOL_W, POOL_W, POOL_W, 0}; pg8::StaticOrder S; S.init(M, D, F.G, (int)blockIdx.x);
                pg8::EpiResid<true, false> E{(const float*)nullptr, WSP(const bf16, WS_HB), (float*)nullptr, WSP(bf16, WS_HB), ROWSS(2), (const float*)nullptr, (LAS float*)nullptr};
                pg8::gemm_phase<pg8::EpiResid<true, false>, pg8::StaticOrder, true, true>(F.lds + RING_OFF, g, S, E);
            }
            SEAM(11);
            if (IN(12)) {
                pg8::Gemm g{WSP(const bf16, WS_HB), WSP(const bf16, WS_W_MOBA_IN), M, 16384, D, D, D, 0}; pg8::StaticOrder S; S.init(M, 16384, F.G, (int)blockIdx.x);
                pg8::EpiRowScale E{WSP(bf16, WS_ACT_A), 16384, ROWSS(2), (LAS float*)(F.lds + 132096)};
                pg8::gemm_phase<pg8::EpiRowScale, pg8::StaticOrder, true, true>(F.lds + RING_OFF, g, S, E);
            }
            SEAM(12);
            if (IN(13)) qknorm_phase(F, WSP(bf16, WS_ACT_A), INP(18), INP(19), WSP(bf16, WS_KMEAN), WSP(bf16, WS_XC + 72 * MiB), WSP(bf16, WS_XC));
            SEAM(13);
            if (IN(14)) moba_gate_phase(F, WSP(const bf16, WS_ACT_A), WSP(const bf16, WS_KMEAN), WSP(int, WS_XC + 136 * MiB), WSP(unsigned short, WS_XC + 138 * MiB), WSP(unsigned char, WS_XC + 137 * MiB));
            SEAM(14);
            if (IN(15)) moba_kv_phase(F, WSP(const bf16, WS_ACT_A), WSP(const bf16, WS_XC + 72 * MiB), WSP(const bf16, WS_XC), WSP(const int, WS_XC + 136 * MiB), WSP(const unsigned short, WS_XC + 138 * MiB), INP(18), INP(19), WSP(bf16, WS_ACT_C), WSP(float, WS_XC + 64 * MiB));
            SEAM(15);
            if (IN(16)) moba_combine_phase(F, WSP(const bf16, WS_ACT_A), WSP(const unsigned char, WS_XC + 137 * MiB), WSP(const bf16, WS_ACT_C), WSP(const float, WS_XC + 64 * MiB), WSP(bf16, WS_ACT_B));
            SEAM(16);
            if (IN(17)) {
                pg8::Gemm g{WSP(const bf16, WS_ACT_B), WSP(const bf16, WS_W_MOBA_OUT), M, D, MOBA_W, MOBA_W, MOBA_W, 0}; pg8::StaticOrder S; S.init(M, D, F.G, (int)blockIdx.x);
                pg8::EpiResid<true, false> E{(const float*)nullptr, WSP(const bf16, WS_HB), (float*)nullptr, WSP(bf16, WS_HB), ROWSS(3), (const float*)nullptr, (LAS float*)nullptr};
                pg8::gemm_phase<pg8::EpiResid<true, false>, pg8::StaticOrder, true, true>(F.lds + RING_OFF, g, S, E);
            }
            SEAM(17);
        }
    SSD_LAYER(1)
#undef SSD_LAYER
#undef IN
#undef SEAM
#undef WSP
#undef ROWSS
}

extern "C" void kernel_launch(void* const* d_in, const int* in_sizes, int n_in, void* d_out, int out_size, void* d_ws, size_t ws_size, hipStream_t stream) {
    static int grid = 0;
    if (grid == 0) {
        if (n_in != 30 || in_sizes[0] != M * D || out_size != M * D || ws_size < WS_END) { fprintf(stderr, "kernel_launch: unexpected shapes: n_in %d in0 %d out %d ws %zu (need %zu)\n", n_in, n_in > 0 ? in_sizes[0] : -1, out_size, ws_size, (size_t)WS_END); grid = -1; return; }
        int dev = 0, cus = 0, per_cu = 0;
        if (hipGetDevice(&dev) != hipSuccess || hipDeviceGetAttribute(&cus, hipDeviceAttributeMultiprocessorCount, dev) != hipSuccess) { grid = -1; return; }
        if (hipFuncSetAttribute((const void*)mk_fwd, hipFuncAttributeMaxDynamicSharedMemorySize, LDS_BYTES) != hipSuccess) { fprintf(stderr, "kernel_launch: hipFuncSetAttribute failed\n"); grid = -1; return; }
        if (hipOccupancyMaxActiveBlocksPerMultiprocessor(&per_cu, (const void*)mk_fwd, NWAVES * 64, LDS_BYTES) != hipSuccess || per_cu < 1)
            fprintf(stderr, "kernel_launch: occupancy query reports %d workgroups per CU\n", per_cu);
        (void)hipGetLastError();
        grid = cus;
    }
    if (grid < 0) return;
    if (hipMemsetAsync((char*)d_ws + WS_CTL, 0, CTL_ZERO_BYTES, stream) != hipSuccess) { fprintf(stderr, "kernel_launch: memset failed\n"); return; }
    Args a{};
    for (int i = 0; i < 30; ++i) a.I.in[i] = (const float*)d_in[i];
    a.out = (float*)d_out; a.ws = (unsigned char*)d_ws;
#if MK_N_LAUNCHES == 1
    a.ph_lo = 0; a.ph_hi = N_PHASES;
    hipLaunchKernelGGL(mk_fwd, dim3(grid), dim3(NWAVES * 64), LDS_BYTES, stream, a);
#else
    for (int li = 0; li < N_PHASES; ++li) { a.ph_lo = li; a.ph_hi = li + 1; hipLaunchKernelGGL(mk_fwd, dim3(grid), dim3(NWAVES * 64), LDS_BYTES, stream, a); }
#endif
}
```

```cpp
#include <hip/hip_runtime.h>
#include <cstdio>
#include <cstdint>
#define MK_N_LAUNCHES 1
namespace pg8 {
#define PG8_LAS __attribute__((address_space(3)))
typedef unsigned short bf16_t;
typedef short bf16x8 __attribute__((ext_vector_type(8)));
typedef float f32x4 __attribute__((ext_vector_type(4)));
typedef unsigned u32x4 __attribute__((ext_vector_type(4)));
constexpr int BM = 256, BK = 64, HALF = 128, HTB = HALF * BK * 2  , STAGE_BYTES = 8 * HTB, NXCD = 8, WGM = 4;

__host__ __device__ __forceinline__ int lds_byte(int r, int c) { const int st = (r >> 4) * 2 + (c >> 5), rr = r & 15, cc = c & 31, ob = rr * 64 + cc * 2; return st * 1024 + (ob ^ (((ob >> 9) & 1) << 5)); }
__host__ __device__ __forceinline__ void stage_rc(int b, int& R, int& C) { const int st = b / 1024, sb = b % 1024, swz = sb ^ (((sb >> 9) & 1) << 5); R = (st >> 1) * 16 + swz / 64; C = (st & 1) * 32 + (swz % 64) / 2; }
__host__ __device__ __forceinline__ int perm32(int rho) { const int n = rho >> 4, i = rho & 15; return 8 * (i >> 2) + 4 * n + (i & 3); }

struct Unit { int pm, pn; };
struct Gemm { const bf16_t* A; const bf16_t* Bt; int M, N, K, lda, ldb, gdiv; };

struct StaticOrder {
    int nM, nN, nwg, G, c;
    __host__ __device__ void init(int M, int N, int G_, int c_) { nM = M / BM; nN = N / BM; nwg = nM * nN; G = G_; c = c_; }
    __host__ __device__ bool next(int i, Unit& u) const {
        const long L = (long)i * G + c; if (L >= nwg) return false;
        int wgid = (int)L; { const int q = nwg / NXCD, r = nwg % NXCD, xcd = wgid % NXCD, off = wgid / NXCD; wgid = (xcd < r ? xcd * (q + 1) : r * (q + 1) + (xcd - r) * q) + off; }
        const int nig = WGM * nN, gid = wgid / nig, fm = gid * WGM, gsz = (nM - fm) < WGM ? (nM - fm) : WGM;
        u.pm = fm + ((wgid % nig) % gsz); u.pn = (wgid % nig) / gsz; return true;
    }
    __device__ __forceinline__ void a_ready(const Unit&) const {}
    __device__ __forceinline__ void done(const Unit&) const {}
};

__device__ __forceinline__ unsigned cvt_pk_bf16(float lo, float hi) { unsigned r; asm volatile("v_cvt_pk_bf16_f32 %0, %1, %2" : "=v"(r) : "v"(lo), "v"(hi)); return r; }

template <class Epi, class Sched, bool ALIGN_EPI = false, bool SP2 = false>
__device__ __forceinline__ void gemm_phase(PG8_LAS unsigned char* lds, const Gemm g, const Sched& S, const Epi& E) {
    const int tid = threadIdx.x, wid = __builtin_amdgcn_readfirstlane(tid >> 6), lane = tid & 63, wr = wid >> 2, wc = wid & 3, fr = lane & 15, fq = lane >> 4;
    const int K = g.K, nt = K / BK;
    unsigned voffA[2], voffB[2];
#pragma unroll
    for (int i = 0; i < 2; ++i) { int R, C; stage_rc(tid * 16 + i * 8192, R, C); const int Rb = Epi::PERM ? ((R & ~31) + perm32(R & 31)) : R;
        voffA[i] = (unsigned)(R * g.lda + C) * 2u; voffB[i] = (unsigned)(Rb * g.ldb + C) * 2u; }
    const size_t kstep = (size_t)(BK * 2);
    const size_t hstepA = (size_t)HALF * g.lda * 2, hstepB = (size_t)HALF * g.ldb * 2;
    const size_t tstepA = 2 * hstepA, tstepB = 2 * hstepB;
    const unsigned ldsw = (unsigned)wid * 1024u;
    const int aoff = lds_byte(wr * 64 + fr, fq * 8), boff = lds_byte(wc * 32 + fr, fq * 8);
#define PG8_SA(b, h) (((b) * 2 + (h)) * HTB)
#define PG8_SB(b, h) ((4 + (b) * 2 + (h)) * HTB)
#define PG8_STAGE(bufoff, gbase, voff) do { _Pragma("unroll") for (int _i = 0; _i < 2; ++_i) \
        __builtin_amdgcn_global_load_lds((const unsigned*)((const char*)(gbase) + (voff)[_i]), (PG8_LAS unsigned*)(lds + (bufoff) + ldsw + _i * 8192), 16, 0, 0); } while (0)
#define PG8_LDA(dst, b, h) do { _Pragma("unroll") for (int m = 0; m < 4; ++m) _Pragma("unroll") for (int k = 0; k < 2; ++k) dst[m][k] = *(const PG8_LAS bf16x8*)(lds + PG8_SA(b, h) + aoff + m * 2048 + k * 1024); } while (0)
#define PG8_LDB(dst, b, h) do { _Pragma("unroll") for (int n = 0; n < 2; ++n) _Pragma("unroll") for (int k = 0; k < 2; ++k) dst[n][k] = *(const PG8_LAS bf16x8*)(lds + PG8_SB(b, h) + boff + n * 2048 + k * 1024); } while (0)
#define PG8_MMA(ai, bj, At, Bt) do { __builtin_amdgcn_s_setprio(1); _Pragma("unroll") for (int m = 0; m < 4; ++m) _Pragma("unroll") for (int n = 0; n < 2; ++n) _Pragma("unroll") for (int k = 0; k < 2; ++k) \
        acc[ai][bj][m][n] = __builtin_amdgcn_mfma_f32_16x16x32_bf16(Bt[n][k], At[m][k], acc[ai][bj][m][n], 0, 0, 0); __builtin_amdgcn_s_setprio(0); } while (0)
#define PG8_WAIT_V(n) asm volatile("s_waitcnt vmcnt(" #n ")" ::: "memory")
#define PG8_WAIT_L(n) asm volatile("s_waitcnt lgkmcnt(" #n ")" ::: "memory")
#define PG8_BAR __builtin_amdgcn_s_barrier()
#define PG8_SCHED __builtin_amdgcn_sched_barrier(0)
#define PG8_ABASE(u) ((const char*)g.A + (size_t)(u).pm * tstepA + (g.gdiv ? (size_t)((u).pn / g.gdiv) * (size_t)K * 2 : (size_t)0))
    Unit cur, nxt; int ui = 0;
    if (!S.next(0, cur)) return;
    f32x4 acc[2][2][4][2];
#pragma unroll
    for (int a = 0; a < 2; ++a)
#pragma unroll
        for (int b = 0; b < 2; ++b)
#pragma unroll
            for (int m = 0; m < 4; ++m)
#pragma unroll
                for (int n = 0; n < 2; ++n) acc[a][b][m][n] = (f32x4){0.f, 0.f, 0.f, 0.f};
    bf16x8 At[4][2], B0[2][2], B1[2][2];
    const char* cA = PG8_ABASE(cur); const char* cB = (const char*)g.Bt + (size_t)cur.pn * tstepB;
    S.a_ready(cur);
    E.pre(cur);
    if constexpr (SP2) {
        PG8_STAGE(PG8_SB(0, 0), cB, voffB); PG8_STAGE(PG8_SB(0, 1), cB + hstepB, voffB); PG8_STAGE(PG8_SA(0, 0), cA, voffA); PG8_STAGE(PG8_SA(0, 1), cA + hstepA, voffA);
        if (wr == 1) PG8_BAR;
        PG8_WAIT_V(2); PG8_BAR;
        PG8_STAGE(PG8_SB(1, 0), cB + kstep, voffB); PG8_STAGE(PG8_SA(1, 0), cA + kstep, voffA); PG8_STAGE(PG8_SB(1, 1), cB + hstepB + kstep, voffB);
        PG8_WAIT_V(6); PG8_BAR;
    } else {
        PG8_STAGE(PG8_SB(0, 0), cB, voffB); PG8_STAGE(PG8_SA(0, 0), cA, voffA); PG8_STAGE(PG8_SB(0, 1), cB + hstepB, voffB); PG8_STAGE(PG8_SA(0, 1), cA + hstepA, voffA);
        if (wr == 1) PG8_BAR;
        PG8_WAIT_V(4); PG8_BAR;
        PG8_STAGE(PG8_SB(1, 0), cB + kstep, voffB); PG8_STAGE(PG8_SA(1, 0), cA + kstep, voffA); PG8_STAGE(PG8_SB(1, 1), cB + hstepB + kstep, voffB);
        PG8_WAIT_V(6); PG8_BAR;
    }
    for (;;) {
        const bool has_next = S.next(ui + 1, nxt);
        const char* nA = has_next ? PG8_ABASE(nxt) : cA; const char* nB = has_next ? (const char*)g.Bt + (size_t)nxt.pn * tstepB : cB;
        for (int t = 0; t < nt; t += 2) {
            const bool last = (t == nt - 2);
            if constexpr (Epi::KHOOK) {
                if (t == 2) E.fill(cur);
                if (t > 0 && (t & 15) == 0) E.khook(acc, (t >> 4) - 1, wr, fr);
            }
            const char* a1 = cA + (size_t)(t + 1) * kstep;
            const char* a2 = last ? nA : cA + (size_t)(t + 2) * kstep; const char* b2 = last ? nB : cB + (size_t)(t + 2) * kstep;
            const char* a3 = a2 + kstep; const char* b3 = b2 + kstep;
            if (last && has_next) S.a_ready(nxt);
            if constexpr (SP2) {
            PG8_LDB(B0, 0, 0); PG8_LDB(B1, 0, 1); PG8_SCHED; PG8_LDA(At, 0, 0); PG8_STAGE(PG8_SA(1, 1), a1 + hstepA, voffA);
            PG8_WAIT_V(8); PG8_WAIT_L(0); PG8_BAR; PG8_MMA(0, 0, At, B0); PG8_MMA(0, 1, At, B1); PG8_BAR; PG8_SCHED;
            PG8_LDA(At, 0, 1); PG8_STAGE(PG8_SB(0, 0), b2, voffB); PG8_STAGE(PG8_SB(0, 1), b2 + hstepB, voffB); PG8_STAGE(PG8_SA(0, 0), a2, voffA);
            PG8_WAIT_V(8); PG8_WAIT_L(0); PG8_BAR; PG8_MMA(1, 0, At, B0); PG8_MMA(1, 1, At, B1); PG8_BAR; PG8_SCHED;
            PG8_LDB(B0, 1, 0); PG8_LDB(B1, 1, 1); PG8_SCHED; PG8_LDA(At, 1, 0); PG8_STAGE(PG8_SA(0, 1), a2 + hstepA, voffA);
            PG8_WAIT_V(8); PG8_WAIT_L(0); PG8_BAR; PG8_MMA(0, 0, At, B0); PG8_MMA(0, 1, At, B1); PG8_BAR; PG8_SCHED;
            PG8_LDA(At, 1, 1); PG8_STAGE(PG8_SB(1, 0), b3, voffB); PG8_STAGE(PG8_SB(1, 1), b3 + hstepB, voffB); PG8_STAGE(PG8_SA(1, 0), a3, voffA);
            PG8_WAIT_V(8); PG8_WAIT_L(0); PG8_BAR; PG8_MMA(1, 0, At, B0); PG8_MMA(1, 1, At, B1); PG8_BAR; PG8_SCHED;
            } else {
            PG8_LDB(B0, 0, 0); PG8_SCHED; PG8_LDA(At, 0, 0); PG8_STAGE(PG8_SA(1, 1), a1 + hstepA, voffA);
            PG8_WAIT_L(8); PG8_BAR; PG8_WAIT_L(0); PG8_MMA(0, 0, At, B0); PG8_BAR; PG8_SCHED;
            PG8_LDB(B1, 0, 1); PG8_STAGE(PG8_SB(0, 0), b2, voffB);
            PG8_BAR; PG8_WAIT_L(0); PG8_MMA(0, 1, At, B1); PG8_BAR;
            PG8_LDA(At, 0, 1); PG8_STAGE(PG8_SA(0, 0), a2, voffA);
            PG8_BAR; PG8_WAIT_L(0); PG8_MMA(1, 0, At, B0); PG8_BAR; PG8_SCHED;
            PG8_STAGE(PG8_SB(0, 1), b2 + hstepB, voffB);
            PG8_WAIT_V(6); PG8_BAR; PG8_MMA(1, 1, At, B1); PG8_BAR;
            PG8_LDB(B0, 1, 0); PG8_SCHED; PG8_LDA(At, 1, 0); PG8_STAGE(PG8_SA(0, 1), a2 + hstepA, voffA);
            PG8_WAIT_L(8); PG8_BAR; PG8_WAIT_L(0); PG8_MMA(0, 0, At, B0); PG8_BAR; PG8_SCHED;
            PG8_LDB(B1, 1, 1); PG8_STAGE(PG8_SB(1, 0), b3, voffB);
            PG8_BAR; PG8_WAIT_L(0); PG8_MMA(0, 1, At, B1); PG8_BAR;
            PG8_LDA(At, 1, 1); PG8_STAGE(PG8_SA(1, 0), a3, voffA);
            PG8_BAR; PG8_WAIT_L(0); PG8_MMA(1, 0, At, B0); PG8_BAR; PG8_SCHED;
            PG8_STAGE(PG8_SB(1, 1), b3 + hstepB, voffB);
            PG8_WAIT_V(6); PG8_BAR; PG8_MMA(1, 1, At, B1); PG8_BAR;
            }
        }
        if constexpr (ALIGN_EPI) { if (wr == 0) PG8_BAR; }
        E(acc, cur, wr, wc, fr, fq, ui & 1, has_next, nxt); S.done(cur);
        if (!has_next) break;
#pragma unroll
        for (int a = 0; a < 2; ++a)
#pragma unroll
            for (int b = 0; b < 2; ++b)
#pragma unroll
                for (int m = 0; m < 4; ++m)
#pragma unroll
                    for (int n = 0; n < 2; ++n) acc[a][b][m][n] = (f32x4){0.f, 0.f, 0.f, 0.f};
        cur = nxt; cA = nA; cB = nB; ++ui;
        if constexpr (ALIGN_EPI) { if (wr == 1) PG8_BAR; }
    }
    PG8_WAIT_V(0);
    if constexpr (!ALIGN_EPI) { if (wr == 0) PG8_BAR; }
    PG8_BAR;
#undef PG8_ABASE
#undef PG8_SA
#undef PG8_SB
#undef PG8_STAGE
#undef PG8_LDA
#undef PG8_LDB
#undef PG8_MMA
#undef PG8_WAIT_V
#undef PG8_WAIT_L
#undef PG8_BAR
#undef PG8_SCHED
}
}
constexpr int NWAVES = 8;
constexpr int M = 8192, D = 4096;
constexpr float RMS_EPS = 1e-6f;
constexpr int SSD_DI = 8192, SSD_NH = 128, SSD_HD = 64, SSD_NG = 8, SSD_DS = 128, SSD_CONV = 10240, SSD_IN = 18560, SSD_MAIN = 18432;
constexpr int POOL_W = 8192, POOL_GD = 2048;
constexpr int MOBA_H = 32, MOBA_DH = 128, MOBA_BLK = 256, MOBA_NB = 32, MOBA_W = 4096;

constexpr size_t MiB = 1u << 20;
constexpr size_t WS_CTL = 0, CTL_ZERO_BYTES = 1 * MiB;
constexpr size_t WS_W_SSD0_IN = 1 * MiB;
constexpr size_t WS_W_SSD0_OUT = WS_W_SSD0_IN + 145 * MiB;
constexpr size_t WS_W_POOL_IN = WS_W_SSD0_OUT + 64 * MiB;
constexpr size_t WS_W_POOL_GRP = WS_W_POOL_IN + 128 * MiB;
constexpr size_t WS_W_POOL_OUT = WS_W_POOL_GRP + 32 * MiB;
constexpr size_t WS_W_MOBA_IN = WS_W_POOL_OUT + 64 * MiB;
constexpr size_t WS_W_MOBA_OUT = WS_W_MOBA_IN + 128 * MiB;
constexpr size_t WS_W_SSD3_IN = WS_W_MOBA_OUT + 32 * MiB;
constexpr size_t WS_W_SSD3_OUT = WS_W_SSD3_IN + 145 * MiB;
constexpr size_t WS_ACT_A = WS_W_SSD3_OUT + 64 * MiB;
constexpr size_t WS_ACT_B = WS_ACT_A + 288 * MiB;
constexpr size_t WS_ACT_C = WS_ACT_B + 128 * MiB;
constexpr size_t WS_STATES = WS_ACT_C, WS_XT = WS_ACT_C + 128 * MiB;
constexpr size_t WS_XC = WS_ACT_C + 256 * MiB;
constexpr size_t WS_HB = WS_XC + 160 * MiB;
constexpr size_t WS_DT = WS_HB + 64 * MiB;
constexpr size_t WS_KMEAN = WS_DT + 4 * MiB;
constexpr size_t WS_DECAY = WS_KMEAN + 512 * 1024;
constexpr size_t WS_SSG = WS_DECAY + 64 * 1024;
constexpr size_t WS_END = WS_KMEAN + 1 * MiB;
constexpr size_t WS_BT = WS_XC;
constexpr int CW_TMO = 0, CW_CODE = 1;
constexpr int CW_BAR = 4096;
constexpr int CW_ROWSS = 16384;
static_assert((CW_ROWSS + 8 * M) * 4 <= (int)CTL_ZERO_BYTES, "CTL words inside the memset region");

constexpr int RING_OFF = 0, RING_BYTES = 131072;
constexpr int LDSCTL_OFF = RING_BYTES, MISC_OFF = LDSCTL_OFF + 320;
constexpr int LDS_BYTES = 147456;
static_assert(MISC_OFF + 128 <= LDS_BYTES, "LDS map");

#define GAS __attribute__((address_space(1)))
#define LAS __attribute__((address_space(3)))
typedef unsigned short bf16;
typedef unsigned v4u __attribute__((ext_vector_type(4)));
typedef unsigned v2u __attribute__((ext_vector_type(2)));
typedef float f32x4 __attribute__((ext_vector_type(4)));
typedef float f32x16 __attribute__((ext_vector_type(16)));
typedef short bf16x8 __attribute__((ext_vector_type(8)));
typedef GAS unsigned gu32;
#define RLX_AGENT __ATOMIC_RELAXED, __HIP_MEMORY_SCOPE_AGENT
#define LDS_WAIT() asm volatile("s_waitcnt lgkmcnt(0)" ::: "memory")
#define VM_WAIT() asm volatile("s_waitcnt vmcnt(0)" ::: "memory")
__device__ __forceinline__ unsigned f2bf(float f) { unsigned u = __builtin_bit_cast(unsigned, f); return (u + 0x7fffu + ((u >> 16) & 1u)) >> 16; }
typedef float f32x2_t_ __attribute__((ext_vector_type(2)));
typedef __bf16 bf16x2_t_ __attribute__((ext_vector_type(2)));
__device__ __forceinline__ unsigned pk2(float lo, float hi) { const f32x2_t_ v = {lo, hi}; return __builtin_bit_cast(unsigned, __builtin_convertvector(v, bf16x2_t_)); }
__device__ __forceinline__ float bflo(unsigned w) { return __builtin_bit_cast(float, w << 16); }
__device__ __forceinline__ float bfhi(unsigned w) { return __builtin_bit_cast(float, w & 0xffff0000u); }
__device__ __forceinline__ float bf1(bf16 b) { return __builtin_bit_cast(float, ((unsigned)b) << 16); }
__device__ __forceinline__ float silu_f(float x) { return x * __builtin_amdgcn_rcpf(1.f + __expf(-x)); }
__device__ __forceinline__ float wave_sum(float v) {
#pragma unroll
    for (int o = 1; o < 64; o <<= 1) v += __shfl_xor(v, o);
    return v;
}
__device__ __forceinline__ float wave_max(float v) {
#pragma unroll
    for (int o = 1; o < 64; o <<= 1) v = fmaxf(v, __shfl_xor(v, o));
    return v;
}
__device__ __forceinline__ f32x16 zero16() { f32x16 z;
#pragma unroll
    for (int j = 0; j < 16; ++j) z[j] = 0.f;
    asm volatile("" : "+v"(z)); return z; }
#define XB_TMO      128
#define XB_XCNT(j)  (256  + 64 * (j))
#define XB_XSUB(j)  (1280 + 64 * (j))
#define XB_XGEN(j)  (2304 + 64 * (j))
#define XB_TOP      3328
#define XB_TOPGEN   3392
#define XCD_BAR_WORDS 3456
#define XB_SPIN_CAP (1u << 18)

__device__ __forceinline__ unsigned xb_ld(unsigned* p)              { return __hip_atomic_load(p, __ATOMIC_RELAXED, __HIP_MEMORY_SCOPE_AGENT); }
__device__ __forceinline__ unsigned xb_add(unsigned* p, unsigned v) { return __hip_atomic_fetch_add(p, v, __ATOMIC_RELAXED, __HIP_MEMORY_SCOPE_AGENT); }
__device__ __forceinline__ unsigned xb_xcc_id() { return (unsigned)__builtin_amdgcn_s_getreg((3 << 11) | 20) & 0xFu; }
#define XB_SPIN(cond, bar) do { unsigned _sp = 0; while (cond) { __builtin_amdgcn_s_sleep(1); \
    if ((++_sp & 255u) == 0u) { if (xb_ld(&(bar)[XB_TMO])) break; if (_sp > XB_SPIN_CAP) { atomicAdd(&(bar)[XB_TMO], 1u); break; } } } } while (0)

struct XcdBarrier {
    unsigned* bar; unsigned x;
    volatile LAS unsigned* st;
};

__device__ __forceinline__ XcdBarrier xcd_barrier_post(unsigned* bar, volatile LAS unsigned* st) {
    XcdBarrier b; b.bar = bar; b.x = xb_xcc_id(); b.st = st;
    if (threadIdx.x == 0) (void)xb_add(&bar[XB_XCNT(b.x)], 1u);
    return b;
}
__device__ __forceinline__ void xcd_barrier_complete(unsigned* bar, unsigned x, unsigned& nloc, unsigned& nx) {
    const unsigned G = gridDim.x * gridDim.y * gridDim.z;
    unsigned sum, cnt, mine, sp = 0u;
    for (;;) {
        sum = 0u; cnt = 0u; mine = 0u;
#pragma unroll
        for (unsigned j = 0; j < 16; ++j) { const unsigned c = xb_ld(&bar[XB_XCNT(j)]); sum += c; cnt += (c > 0u) ? 1u : 0u; mine = (j == x) ? c : mine; }
        if (sum == G) break;
        __builtin_amdgcn_s_sleep(1);
        if ((++sp & 255u) == 0u) { if (xb_ld(&bar[XB_TMO])) break; if (sp > XB_SPIN_CAP) { atomicAdd(&bar[XB_TMO], 1u); break; } }
    }
    nloc = mine > 0u ? mine : 1u; nx = cnt > 0u ? cnt : 1u;
}

__device__ __forceinline__ void xcd_barrier(const XcdBarrier& b) {
    asm volatile("s_waitcnt vmcnt(0)" ::: "memory");
    __syncthreads();
    if (threadIdx.x == 0) {
        unsigned* bar = b.bar;
        __builtin_amdgcn_s_waitcnt(0);
        unsigned nloc = b.st[0], nx = b.st[1];
        if (nloc == 0u) { xcd_barrier_complete(bar, b.x, nloc, nx); b.st[0] = nloc; b.st[1] = nx; }
        const unsigned old = xb_add(&bar[XB_XSUB(b.x)], 1u);
        const unsigned gen = old / nloc;
        if (old + 1u == (gen + 1u) * nloc) {
            __builtin_amdgcn_fence(__ATOMIC_RELEASE, "agent");
            asm volatile("s_waitcnt vmcnt(0)" ::: "memory");
            const unsigned og = xb_add(&bar[XB_TOP], 1u);
            const unsigned tg = og / nx;
            if (og + 1u == (tg + 1u) * nx) xb_add(&bar[XB_TOPGEN], 1u);
            else XB_SPIN(xb_ld(&bar[XB_TOPGEN]) == tg, bar);
            __builtin_amdgcn_fence(__ATOMIC_ACQUIRE, "agent");
            xb_add(&bar[XB_XGEN(b.x)], 1u);
            asm volatile("s_waitcnt vmcnt(0)" ::: "memory");
        } else {
            XB_SPIN(xb_ld(&bar[XB_XGEN(b.x)]) == gen, bar);
            __builtin_amdgcn_fence(__ATOMIC_ACQUIRE, "agent");
            asm volatile("s_waitcnt vmcnt(0)" ::: "memory");
        }
    }
    __syncthreads();
}
struct Frame {
    LAS unsigned char* lds;
    volatile LAS unsigned* MISC;
    gu32* ctl;
    int tid, lane, wave;
    int G;
    unsigned char* ws;
};

namespace pg8 {
struct EpiRowScale {
    static constexpr bool PERM = true, KHOOK = false;
    bf16_t* O; int ldc; const unsigned long long* rowss;
    PG8_LAS float* tab;
    static __device__ __forceinline__ float rstd_of(unsigned long long ss) { return rsqrtf((float)ss * (1.0f / (4096.0f * 16777216.0f)) + 1e-6f); }
    __device__ __forceinline__ void pre(const Unit& u) const { if (threadIdx.x < 256) tab[threadIdx.x] = rstd_of(rowss[u.pm * BM + threadIdx.x]); }
    __device__ __forceinline__ void operator()(const f32x4 (&acc)[2][2][4][2], const Unit& u, int wr, int wc, int fr, int fq, int slot, bool has_next, const Unit& nxt) const {
        const int row0 = u.pm * BM + wr * 64 + fr, col0 = u.pn * BM + wc * 32 + 8 * fq;
        const bool fill = has_next && threadIdx.x < 256;
        unsigned long long ssn = 0; if (fill) ssn = rowss[nxt.pm * BM + threadIdx.x];
        float rsv[8];
#pragma unroll
        for (int i = 0; i < 8; ++i) rsv[i] = tab[slot * 256 + wr * 64 + fr + (i >> 2) * HALF + (i & 3) * 16];
#pragma unroll
        for (int ai = 0; ai < 2; ++ai)
#pragma unroll
            for (int m = 0; m < 4; ++m) { const int row = row0 + ai * HALF + m * 16; const float rs = rsv[ai * 4 + m];
                bf16_t* rowp = O + (size_t)row * ldc + col0;
#pragma unroll
                for (int bj = 0; bj < 2; ++bj) { const f32x4 v0 = acc[ai][bj][m][0] * rs, v1 = acc[ai][bj][m][1] * rs;
                    u32x4 w; w.x = cvt_pk_bf16(v0[0], v0[1]); w.y = cvt_pk_bf16(v0[2], v0[3]); w.z = cvt_pk_bf16(v1[0], v1[1]); w.w = cvt_pk_bf16(v1[2], v1[3]);
                    *(u32x4*)(rowp + bj * HALF) = w; } }
        if (fill) tab[(slot ^ 1) * 256 + threadIdx.x] = rstd_of(ssn);
    }
};
template <bool RESB, bool KH>
struct EpiResid {
    static constexpr bool PERM = true, KHOOK = KH;
    const float* res; const bf16_t* resb; float* out; bf16_t* hb; unsigned long long* rowss_next;
    const float* ssg; PG8_LAS float* tab;
    __device__ __forceinline__ void pre(const Unit&) const {}
    __device__ __forceinline__ void fill(const Unit& u) const {
        if (threadIdx.x < 256) {
            unsigned voff = (unsigned)(u.pm * BM + (int)threadIdx.x) * 4u; float s0, s1, s2, s3, s4, s5, s6, s7;
            asm volatile("global_load_dword %0, %8, %9\n\tv_add_u32 %8, 0x8000, %8\n\tglobal_load_dword %1, %8, %9\n\tv_add_u32 %8, 0x8000, %8\n\t"
                         "global_load_dword %2, %8, %9\n\tv_add_u32 %8, 0x8000, %8\n\tglobal_load_dword %3, %8, %9\n\tv_add_u32 %8, 0x8000, %8\n\t"
                         "global_load_dword %4, %8, %9\n\tv_add_u32 %8, 0x8000, %8\n\tglobal_load_dword %5, %8, %9\n\tv_add_u32 %8, 0x8000, %8\n\t"
                         "global_load_dword %6, %8, %9\n\tv_add_u32 %8, 0x8000, %8\n\tglobal_load_dword %7, %8, %9\n\ts_waitcnt vmcnt(0)"
                         : "=&v"(s0), "=&v"(s1), "=&v"(s2), "=&v"(s3), "=&v"(s4), "=&v"(s5), "=&v"(s6), "=&v"(s7), "+v"(voff) : "s"(ssg) : "memory");
            const float r0 = rsqrtf(s0 * (1.0f / 1024.0f) + 1e-6f), r1 = rsqrtf(s1 * (1.0f / 1024.0f) + 1e-6f), r2 = rsqrtf(s2 * (1.0f / 1024.0f) + 1e-6f), r3 = rsqrtf(s3 * (1.0f / 1024.0f) + 1e-6f);
            const float r4 = rsqrtf(s4 * (1.0f / 1024.0f) + 1e-6f), r5 = rsqrtf(s5 * (1.0f / 1024.0f) + 1e-6f), r6 = rsqrtf(s6 * (1.0f / 1024.0f) + 1e-6f), r7 = rsqrtf(s7 * (1.0f / 1024.0f) + 1e-6f);
            PG8_LAS float* tp = tab + threadIdx.x;
            tp[0] = r0 * __builtin_amdgcn_rcpf(r1); tp[256] = r1 * __builtin_amdgcn_rcpf(r2); tp[512] = r2 * __builtin_amdgcn_rcpf(r3); tp[768] = r3 * __builtin_amdgcn_rcpf(r4);
            tp[1024] = r4 * __builtin_amdgcn_rcpf(r5); tp[1280] = r5 * __builtin_amdgcn_rcpf(r6); tp[1536] = r6 * __builtin_amdgcn_rcpf(r7); tp[1792] = r7; }
    }
    __device__ __forceinline__ void khook(f32x4 (&acc)[2][2][4][2], int b, int wr, int fr) const {
#pragma unroll
        for (int ai = 0; ai < 2; ++ai)
#pragma unroll
            for (int m = 0; m < 4; ++m) { const float q = tab[b * 256 + wr * 64 + fr + ai * HALF + m * 16];
#pragma unroll
                for (int bj = 0; bj < 2; ++bj) { acc[ai][bj][m][0] *= q; acc[ai][bj][m][1] *= q; } }
    }
    __device__ __forceinline__ void operator()(const f32x4 (&acc_)[2][2][4][2], const Unit& u, int wr, int wc, int fr, int fq, int, bool, const Unit&) const {
        const int row0 = u.pm * BM + wr * 64 + fr, col0 = u.pn * BM + wc * 32 + 8 * fq;
        f32x4 acc[2][2][4][2];
#pragma unroll
        for (int ai = 0; ai < 2; ++ai)
#pragma unroll
            for (int m = 0; m < 4; ++m) { float q = 1.0f; if constexpr (KH) q = tab[7 * 256 + wr * 64 + fr + ai * HALF + m * 16];
#pragma unroll
                for (int bj = 0; bj < 2; ++bj) { acc[ai][bj][m][0] = KH ? acc_[ai][bj][m][0] * q : acc_[ai][bj][m][0]; acc[ai][bj][m][1] = KH ? acc_[ai][bj][m][1] * q : acc_[ai][bj][m][1]; } }
        if constexpr (RESB) {
            u32x4 R[2][4];
#define EPR_LOADB(b) { _Pragma("unroll") for (int q_ = 0; q_ < 4; ++q_) { const int rowl_ = row0 + ((b) >> 1) * HALF + (((b) & 1) * 2 + (q_ >> 1)) * 16; \
                R[(b) & 1][q_] = *(const u32x4*)(resb + (size_t)rowl_ * 4096 + col0 + (q_ & 1) * HALF); } }
            EPR_LOADB(0)
#pragma unroll
            for (int b = 0; b < 4; ++b) {
                if (b == 0) EPR_LOADB(1) else if (b == 1) EPR_LOADB(2) else if (b == 2) EPR_LOADB(3)
#pragma unroll
                for (int rl = 0; rl < 2; ++rl) { const int ai = b >> 1, m = (b & 1) * 2 + rl, row = row0 + ai * HALF + m * 16; const size_t off = (size_t)row * 4096 + col0; float ss = 0.f;
#pragma unroll
                    for (int bj = 0; bj < 2; ++bj) { const u32x4 rq = R[b & 1][rl * 2 + bj];
                        f32x4 o0, o1;
                        o0[0] = __builtin_bit_cast(float, rq.x << 16) + acc[ai][bj][m][0][0]; o0[1] = __builtin_bit_cast(float, rq.x & 0xffff0000u) + acc[ai][bj][m][0][1];
                        o0[2] = __builtin_bit_cast(float, rq.y << 16) + acc[ai][bj][m][0][2]; o0[3] = __builtin_bit_cast(float, rq.y & 0xffff0000u) + acc[ai][bj][m][0][3];
                        o1[0] = __builtin_bit_cast(float, rq.z << 16) + acc[ai][bj][m][1][0]; o1[1] = __builtin_bit_cast(float, rq.z & 0xffff0000u) + acc[ai][bj][m][1][1];
                        o1[2] = __builtin_bit_cast(float, rq.w << 16) + acc[ai][bj][m][1][2]; o1[3] = __builtin_bit_cast(float, rq.w & 0xffff0000u) + acc[ai][bj][m][1][3];
                        if (out) { *(f32x4*)(out + off + bj * HALF) = o0; *(f32x4*)(out + off + bj * HALF + 4) = o1; }
                        ss += (o0[0] * o0[0] + o0[1] * o0[1]) + (o0[2] * o0[2] + o0[3] * o0[3]) + (o1[0] * o1[0] + o1[1] * o1[1]) + (o1[2] * o1[2] + o1[3] * o1[3]);
                        if (hb) { u32x4 w; w.x = cvt_pk_bf16(o0[0], o0[1]); w.y = cvt_pk_bf16(o0[2], o0[3]); w.z = cvt_pk_bf16(o1[0], o1[1]); w.w = cvt_pk_bf16(o1[2], o1[3]);
                            *(u32x4*)(hb + off + bj * HALF) = w; } }
                    if (rowss_next) { ss += __shfl_xor(ss, 16); ss += __shfl_xor(ss, 32); if (fq == 0) atomicAdd(rowss_next + row, (unsigned long long)__float2ll_rn(ss * 16777216.0f)); } }
            }
#undef EPR_LOADB
        } else {
            f32x4 R[2][8];
#define EPR_LOAD(b) { _Pragma("unroll") for (int q_ = 0; q_ < 8; ++q_) { const int rowl_ = row0 + ((b) >> 1) * HALF + (((b) & 1) * 2 + (q_ >> 2)) * 16; \
                R[(b) & 1][q_] = *(const f32x4*)(res + (size_t)rowl_ * 4096 + col0 + ((q_ >> 1) & 1) * HALF + (q_ & 1) * 4); } }
            EPR_LOAD(0)
#pragma unroll
            for (int b = 0; b < 4; ++b) {
                if (b == 0) EPR_LOAD(1) else if (b == 1) EPR_LOAD(2) else if (b == 2) EPR_LOAD(3)
#pragma unroll
                for (int rl = 0; rl < 2; ++rl) { const int ai = b >> 1, m = (b & 1) * 2 + rl, row = row0 + ai * HALF + m * 16; const size_t off = (size_t)row * 4096 + col0; float ss = 0.f;
#pragma unroll
                    for (int bj = 0; bj < 2; ++bj) {
                        const f32x4 o0 = R[b & 1][rl * 4 + bj * 2] + acc[ai][bj][m][0], o1 = R[b & 1][rl * 4 + bj * 2 + 1] + acc[ai][bj][m][1];
                        if (out) { *(f32x4*)(out + off + bj * HALF) = o0; *(f32x4*)(out + off + bj * HALF + 4) = o1; }
                        ss += (o0[0] * o0[0] + o0[1] * o0[1]) + (o0[2] * o0[2] + o0[3] * o0[3]) + (o1[0] * o1[0] + o1[1] * o1[1]) + (o1[2] * o1[2] + o1[3] * o1[3]);
                        if (hb) { u32x4 w; w.x = cvt_pk_bf16(o0[0], o0[1]); w.y = cvt_pk_bf16(o0[2], o0[3]); w.z = cvt_pk_bf16(o1[0], o1[1]); w.w = cvt_pk_bf16(o1[2], o1[3]);
                            *(u32x4*)(hb + off + bj * HALF) = w; } }
                    if (rowss_next) { ss += __shfl_xor(ss, 16); ss += __shfl_xor(ss, 32); if (fq == 0) atomicAdd(rowss_next + row, (unsigned long long)__float2ll_rn(ss * 16777216.0f)); } }
            }
#undef EPR_LOAD
        }
    }
};
struct EpiPoolGrp {
    static constexpr bool PERM = true, KHOOK = false;
    bf16_t* O; const bf16_t* vz; const float* bg; const float* sc;
    __device__ __forceinline__ void pre(const Unit&) const {}
    __device__ __forceinline__ void operator()(const f32x4 (&acc)[2][2][4][2], const Unit& u, int wr, int wc, int fr, int fq, int, bool, const Unit&) const {
        const int row0 = u.pm * BM + wr * 64 + fr, col0 = u.pn * BM + wc * 32 + 8 * fq;
        f32x4 bv[2][2], sv[2][2];
#pragma unroll
        for (int bj = 0; bj < 2; ++bj)
#pragma unroll
            for (int n = 0; n < 2; ++n) { bv[bj][n] = *(const f32x4*)(bg + col0 + bj * HALF + 4 * n); sv[bj][n] = *(const f32x4*)(sc + col0 + bj * HALF + 4 * n); }
        u32x4 zz[8], wv[8];
#define EPG_LOAD(ai_) { _Pragma("unroll") for (int q_ = 0; q_ < 8; ++q_) zz[q_] = *(const u32x4*)(vz + (size_t)(row0 + (ai_) * HALF + (q_ >> 1) * 16) * 16384 + 8192 + col0 + (q_ & 1) * HALF); }
#define EPG_CALC(ai_) { _Pragma("unroll") for (int q_ = 0; q_ < 8; ++q_) { const int m_ = q_ >> 1, bj_ = q_ & 1; const u32x4 zq = zz[q_]; \
            const f32x4 v0 = (acc[ai_][bj_][m_][0] + bv[bj_][0]) * sv[bj_][0], v1 = (acc[ai_][bj_][m_][1] + bv[bj_][1]) * sv[bj_][1]; \
            float z[8]; z[0] = __builtin_bit_cast(float, zq.x << 16); z[1] = __builtin_bit_cast(float, zq.x & 0xffff0000u); z[2] = __builtin_bit_cast(float, zq.y << 16); z[3] = __builtin_bit_cast(float, zq.y & 0xffff0000u); \
            z[4] = __builtin_bit_cast(float, zq.z << 16); z[5] = __builtin_bit_cast(float, zq.z & 0xffff0000u); z[6] = __builtin_bit_cast(float, zq.w << 16); z[7] = __builtin_bit_cast(float, zq.w & 0xffff0000u); \
            float o[8]; \
            _Pragma("unroll") for (int j = 0; j < 4; ++j) { o[j] = v0[j] * (z[j] * __builtin_amdgcn_rcpf(1.f + __expf(-z[j]))); o[4 + j] = v1[j] * (z[4 + j] * __builtin_amdgcn_rcpf(1.f + __expf(-z[4 + j]))); } \
            wv[q_].x = cvt_pk_bf16(o[0], o[1]); wv[q_].y = cvt_pk_bf16(o[2], o[3]); wv[q_].z = cvt_pk_bf16(o[4], o[5]); wv[q_].w = cvt_pk_bf16(o[6], o[7]); } }
#define EPG_STORE(ai_) { _Pragma("unroll") for (int q_ = 0; q_ < 8; ++q_) *(u32x4*)(O + (size_t)(row0 + (ai_) * HALF + (q_ >> 1) * 16) * 8192 + col0 + (q_ & 1) * HALF) = wv[q_]; }
        EPG_LOAD(0) EPG_CALC(0) EPG_LOAD(1) EPG_STORE(0) EPG_CALC(1) EPG_STORE(1)
#undef EPG_LOAD
#undef EPG_CALC
#undef EPG_STORE
    }
};
}

__device__ __forceinline__ void p0_transpose_item(const float* W, int K, int N, bf16* WT, const float* gain, LAS float* scr, int item, int lane) {
    const int nblk = N / 32, kb = item / nblk, nb = item % nblk, k0 = 64 * kb, n0 = 32 * nb;
    const int kr = lane >> 3, nc = (lane & 7) * 4;
    f32x4 v[8];
#pragma unroll
    for (int i = 0; i < 8; ++i) v[i] = __builtin_nontemporal_load((const f32x4*)(W + (size_t)(k0 + 8 * i + kr) * N + n0 + nc));
#pragma unroll
    for (int i = 0; i < 8; ++i) { const float g = gain ? gain[k0 + 8 * i + kr] : 1.0f; *(LAS f32x4*)(scr + (8 * i + kr) * 36 + nc) = v[i] * g; }
    LDS_WAIT(); asm volatile("" ::: "memory");
    const int c = lane & 7;
#pragma unroll
    for (int j = 0; j < 4; ++j) { const int n = (lane >> 3) + 8 * j; const LAS float* s = scr + (8 * c) * 36 + n;
        v4u o; o.x = pk2(s[0 * 36], s[1 * 36]); o.y = pk2(s[2 * 36], s[3 * 36]); o.z = pk2(s[4 * 36], s[5 * 36]); o.w = pk2(s[6 * 36], s[7 * 36]);
        *(GAS v4u*)(WT + (size_t)(n0 + n) * K + k0 + 8 * c) = o; }
    LDS_WAIT(); asm volatile("" ::: "memory");
}
struct AllIn { const float* in[30]; };
__device__ __forceinline__ const float* ldin(int i) { int off = i * 8; asm volatile("" : "+s"(off));
    const char __attribute__((address_space(4)))* kp = (const char __attribute__((address_space(4)))*)__builtin_amdgcn_kernarg_segment_ptr();
    return *(const float* const __attribute__((address_space(4)))*)(kp + off); }
__device__ __forceinline__ void p0_prologue(Frame& F, const float* x, bf16* hb, unsigned long long* rowss0) {
    LAS float* scr = (LAS float*)(F.lds + RING_OFF + F.wave * 16384);
    const int gw = blockIdx.x * NWAVES + F.wave, NGW = F.G * NWAVES;
    unsigned char* ws = F.ws;
    constexpr int I_SIN = (D / 64) * (SSD_IN / 32), I_SOUT = (SSD_DI / 64) * (D / 32), I_PIN = (D / 64) * (16384 / 32), I_PG = (2048 / 64) * (2048 / 32), I_POUT = I_SOUT, I_MIN = I_PIN, I_MOUT = (D / 64) * (D / 32);
    constexpr int NITEMS = 2 * I_SIN + 2 * I_SOUT + I_PIN + 4 * I_PG + I_POUT + I_MIN + I_MOUT;
    for (int it = gw; it < NITEMS; it += NGW) {
        int r = it;
        if (r < I_SIN) { p0_transpose_item(ldin(2), D, SSD_IN, (bf16*)(ws + WS_W_SSD0_IN), ldin(1), scr, r, F.lane); continue; } r -= I_SIN;
        if (r < I_SOUT) { p0_transpose_item(ldin(9), SSD_DI, D, (bf16*)(ws + WS_W_SSD0_OUT), ldin(8), scr, r, F.lane); continue; } r -= I_SOUT;
        if (r < I_PIN) { p0_transpose_item(ldin(11), D, 16384, (bf16*)(ws + WS_W_POOL_IN), ldin(10), scr, r, F.lane); continue; } r -= I_PIN;
        if (r < 4 * I_PG) { const int g = r / I_PG; p0_transpose_item(ldin(12) + (size_t)g * 2048 * 2048, 2048, 2048, (bf16*)(ws + WS_W_POOL_GRP) + (size_t)g * 2048 * 2048, nullptr, scr, r % I_PG, F.lane); continue; } r -= 4 * I_PG;
        if (r < I_POUT) { p0_transpose_item(ldin(15), POOL_W, D, (bf16*)(ws + WS_W_POOL_OUT), nullptr, scr, r, F.lane); continue; } r -= I_POUT;
        if (r < I_MIN) { p0_transpose_item(ldin(17), D, 16384, (bf16*)(ws + WS_W_MOBA_IN), ldin(16), scr, r, F.lane); continue; } r -= I_MIN;
        if (r < I_MOUT) { p0_transpose_item(ldin(20), D, D, (bf16*)(ws + WS_W_MOBA_OUT), nullptr, scr, r, F.lane); continue; } r -= I_MOUT;
        if (r < I_SIN) { p0_transpose_item(ldin(22), D, SSD_IN, (bf16*)(ws + WS_W_SSD3_IN), ldin(21), scr, r, F.lane); continue; } r -= I_SIN;
        p0_transpose_item(ldin(29), SSD_DI, D, (bf16*)(ws + WS_W_SSD3_OUT), ldin(28), scr, r, F.lane);
    }
    for (int m = gw; m < M; m += NGW) {
        const GAS f32x4* xr = (const GAS f32x4*)(x + (size_t)m * D) + F.lane; GAS v2u* o8 = (GAS v2u*)(hb + (size_t)m * D) + F.lane; float s = 0.f;
#pragma unroll 4
        for (int j = 0; j < 16; ++j) { const f32x4 v = xr[64 * j]; s += (v.x * v.x + v.y * v.y) + (v.z * v.z + v.w * v.w); v2u w; w.x = pk2(v.x, v.y); w.y = pk2(v.z, v.w); o8[64 * j] = w; }
        s = wave_sum(s); if (F.lane == 0) rowss0[m] = (unsigned long long)__float2ll_rn(s * 16777216.0f);
    }
}

__device__ __forceinline__ void dt_phase(Frame& F, const bf16* A, const bf16* Wdt, const unsigned long long* rowss, const float* dt_bias, float* dt_out) {
    const int lane = F.lane, r = lane & 31, hh = lane >> 5;
    LAS float* P = (LAS float*)(F.lds + RING_OFF);
    for (int u = blockIdx.x; u < M / 32; u += F.G) {
        const bf16* ap = A + (size_t)(u * 32 + r) * D + F.wave * 512 + hh * 8;
        const bf16* bp = Wdt + (size_t)r * D + F.wave * 512 + hh * 8;
        f32x16 acc[4];
#pragma unroll
        for (int nb = 0; nb < 4; ++nb) acc[nb] = zero16();
#pragma unroll 4
        for (int ks = 0; ks < 32; ++ks) {
            const bf16x8 a = *(const bf16x8*)(ap + ks * 16);
#pragma unroll
            for (int nb = 0; nb < 4; ++nb) { const bf16x8 b = *(const bf16x8*)(bp + (size_t)nb * 32 * D + ks * 16); acc[nb] = __builtin_amdgcn_mfma_f32_32x32x16_bf16(a, b, acc[nb], 0, 0, 0); }
        }
#pragma unroll
        for (int nb = 0; nb < 4; ++nb)
#pragma unroll
            for (int j = 0; j < 16; ++j) { const int row = (j & 3) + 8 * (j >> 2) + 4 * hh; P[F.wave * 4096 + row * 128 + nb * 32 + r] = acc[nb][j]; }
        __syncthreads();
#pragma unroll
        for (int j = 0; j < 8; ++j) { const int idx = F.tid + 512 * j; float s = 0.f;
#pragma unroll
            for (int w = 0; w < 8; ++w) s += P[w * 4096 + idx];
            const int row = u * 32 + (idx >> 7), col = idx & 127;
            const float v = s * rsqrtf((float)rowss[row] * (1.0f / (4096.0f * 16777216.0f)) + RMS_EPS) + dt_bias[col];
            dt_out[(size_t)row * 128 + col] = fmaxf(v, 0.f) + log1pf(__expf(-fabsf(v))); }
        __syncthreads();
    }
}
__device__ __forceinline__ int pi32(int r) { return (r & ~0xC) | ((r & 4) << 1) | ((r & 8) >> 1); }
__device__ __forceinline__ void conv_phase(Frame& F, const bf16* zx, const float* cw, const float* cb, bf16* xc, bf16* xtile, bf16* btT, bf16* btok, bf16* ctok) {
    constexpr int NCG = SSD_CONV / 8, RUN = 16, NIT = (M / RUN) * NCG;
    LAS unsigned char* STG = F.lds + RING_OFF + F.wave * 8192;
    for (int it = blockIdx.x * 512 + F.tid; it < NIT; it += F.G * 512) {
        const int cg = it % NCG, tr = it / NCG, c0 = cg * 8, t0 = tr * RUN;
        v4u rows[RUN + 3];
#pragma unroll
        for (int i = 0; i < RUN + 3; ++i) { const int t = t0 - 3 + i; if (t >= 0) rows[i] = *(const v4u*)(zx + (size_t)t * SSD_MAIN + SSD_DI + c0); else { rows[i].x = 0u; rows[i].y = 0u; rows[i].z = 0u; rows[i].w = 0u; } }
        float w[4][8], b[8];
#pragma unroll
        for (int k = 0; k < 4; ++k) { const f32x4 a = *(const f32x4*)(cw + k * SSD_CONV + c0), bq = *(const f32x4*)(cw + k * SSD_CONV + c0 + 4);
#pragma unroll
            for (int j = 0; j < 4; ++j) { w[k][j] = a[j]; w[k][4 + j] = bq[j]; } }
        { const f32x4 a = *(const f32x4*)(cb + c0), bq = *(const f32x4*)(cb + c0 + 4);
#pragma unroll
          for (int j = 0; j < 4; ++j) { b[j] = a[j]; b[4 + j] = bq[j]; } }
        const int kind = c0 < SSD_DI ? 0 : (c0 < SSD_DI + 1024 ? 1 : 2);
        const int chunk = t0 >> 7, tl0 = t0 & 127;
        unsigned char* ptok; unsigned char* pch;
        if (kind == 0) { const int h = c0 >> 6, pt = (c0 >> 5) & 1, r0 = c0 & 31;
            ptok = (unsigned char*)(xc + (size_t)t0 * SSD_DI + c0);
            pch = (unsigned char*)(xtile + ((((size_t)chunk * 128 + h) * 2 + pt) * 8 + (tl0 >> 4)) * 512 + (size_t)r0 * 8); }
        else { const int n0 = (c0 - SSD_DI) & 127, g = ((c0 - SSD_DI) >> 7) & 7, ksN = n0 >> 4, h2N = (n0 >> 3) & 1, nt = n0 >> 5;
            ptok = (unsigned char*)((kind == 1 ? btok : ctok) + ((((size_t)chunk * 8 + g) * 4 + (tl0 >> 5)) * 8 + ksN) * 512 + (size_t)((tl0 & 16) + 32 * h2N) * 8);
            pch = (unsigned char*)(btT + ((((size_t)chunk * 8 + g) * 4 + nt) * 8 + (tl0 >> 4)) * 512 + (size_t)((n0 & 16) | ((n0 & 8) >> 1)) * 8); }
#pragma unroll
        for (int tb = 0; tb < RUN; tb += 8) {
            unsigned yp[8][4];
#pragma unroll
            for (int i = 0; i < 8; ++i) {
                float y[8];
#pragma unroll
                for (int j = 0; j < 8; ++j) { float a = b[j];
#pragma unroll
                    for (int k = 0; k < 4; ++k) { const v4u q = rows[tb + i + k]; const unsigned wd = (j >> 1) == 0 ? q.x : (j >> 1) == 1 ? q.y : (j >> 1) == 2 ? q.z : q.w; a += w[k][j] * ((j & 1) ? bfhi(wd) : bflo(wd)); }
                    y[j] = silu_f(a); }
                v4u o; o.x = pk2(y[0], y[1]); o.y = pk2(y[2], y[3]); o.z = pk2(y[4], y[5]); o.w = pk2(y[6], y[7]);
                const int ti = tb + i, pti = (ti & 3) | ((ti & 4) << 1) | ((ti & 8) >> 1);
                if (kind == 1) *(v4u*)(ptok + pti * 16) = o;
                else if (kind == 2) *(v4u*)(ptok + ti * 16) = o;
#pragma unroll
                for (int j = 0; j < 8; ++j) { const unsigned hb_ = f2bf(y[j]); if (i & 1) yp[j][i >> 1] |= hb_ << 16; else yp[j][i >> 1] = hb_; }
            }
            if (kind == 0) {
#pragma unroll
                for (int j = 0; j < 8; ++j) { v4u o; o.x = yp[j][0]; o.y = yp[j][1]; o.z = yp[j][2]; o.w = yp[j][3]; *(LAS v4u*)(STG + (F.lane * 8 + j) * 16) = o; }
                LDS_WAIT(); asm volatile("" ::: "memory");
                bf16* xbase = xtile + (((size_t)chunk * 256 + (c0 >> 5) - ((F.lane * 8) >> 5)) * 8 + (tl0 >> 4)) * 512 + (size_t)((tb >> 3) * 32) * 8;
#pragma unroll
                for (int s_ = 0; s_ < 8; ++s_) { const int hpl = 2 * s_ + (F.lane >> 5), slot = F.lane & 31;
                    const v4u o = *(const LAS v4u*)(STG + (hpl * 32 + slot) * 16);
                    *(v4u*)(xbase + (size_t)hpl * 8 * 512 + slot * 8) = o; }
                LDS_WAIT(); asm volatile("" ::: "memory");
            } else if (kind == 1) {
#pragma unroll
                for (int j = 0; j < 8; ++j) { v4u o; o.x = yp[j][0]; o.y = yp[j][1]; o.z = yp[j][2]; o.w = yp[j][3];
                    *(v4u*)(pch + (((j & 4) << 1) | (j & 3)) * 16 + (tb >> 3) * 512) = o; } }
        }
    }
}
__device__ __forceinline__ void ssd_s1_phase(Frame& F, const bf16* xtile, const bf16* btT, const float* dt, const float* a_log, bf16* states, float* decay) {
    const int lane = F.lane, h2 = lane >> 5;
    LAS float* w1 = (LAS float*)(F.lds + RING_OFF) + F.wave * 256;
    LAS unsigned char* BL = F.lds + RING_OFF + 16384;
    for (int u = blockIdx.x; u < 64 * SSD_NG; u += F.G) {
        const int c = u >> 3, g = u & 7, t0 = c * 128;
        float dec_out[2];
#pragma unroll
        for (int hh = 0; hh < 2; ++hh) { const int h = g * 16 + F.wave * 2 + hh; const float A = -__expf(a_log[h]);
            const float d0 = dt[(size_t)(t0 + 2 * lane) * 128 + h], d1 = dt[(size_t)(t0 + 2 * lane + 1) * 128 + h];
            const float a0 = d0 * A, a1 = d1 * A; float s = a0 + a1;
#pragma unroll
            for (int o = 1; o < 64; o <<= 1) { const float v = __shfl_up(s, o); if (lane >= o) s += v; }
            const float cs1 = s, cs0 = s - a1; const float cend = __shfl(s, 63);
            w1[hh * 128 + 2 * lane] = d0 * __expf(cend - cs0); w1[hh * 128 + 2 * lane + 1] = d1 * __expf(cend - cs1);
            dec_out[hh] = __expf(cend); }
        if (lane == 0) { decay[(c * 8 + g) * 32 + F.wave * 2] = dec_out[0]; decay[(c * 8 + g) * 32 + F.wave * 2 + 1] = dec_out[1]; }
        __syncthreads();
        { const bf16* bp = btT + ((((size_t)c * 8 + g) * 4) * 8) * 512 + (size_t)lane * 8; v4u bq[4];
#pragma unroll
          for (int i = 0; i < 4; ++i) bq[i] = *(const v4u*)(bp + (size_t)(F.wave * 4 + i) * 512);
#pragma unroll
          for (int i = 0; i < 4; ++i) *(LAS v4u*)(BL + (F.wave * 4 + i) * 1024 + lane * 16) = bq[i]; }
        __syncthreads();
        bf16x8 Xn[8];
        { const bf16* xp = xtile + ((((size_t)c * 128 + g * 16 + F.wave * 2) * 2) * 8) * 512 + (size_t)lane * 8;
#pragma unroll
          for (int ks = 0; ks < 8; ++ks) Xn[ks] = *(const bf16x8*)(xp + ks * 512); }
#pragma nounroll
        for (int item = 0; item < 4; ++item) { const int hh = item >> 1, pt = item & 1, h = g * 16 + F.wave * 2 + hh;
            bf16x8 Xf[8];
#pragma unroll
            for (int ks = 0; ks < 8; ++ks) { const v4u aq = __builtin_bit_cast(v4u, Xn[ks]);
                const f32x4 wa = *(const LAS f32x4*)(w1 + hh * 128 + ks * 16 + h2 * 8), wb = *(const LAS f32x4*)(w1 + hh * 128 + ks * 16 + h2 * 8 + 4);
                v4u as; as.x = pk2(bflo(aq.x) * wa.x, bfhi(aq.x) * wa.y); as.y = pk2(bflo(aq.y) * wa.z, bfhi(aq.y) * wa.w); as.z = pk2(bflo(aq.z) * wb.x, bfhi(aq.z) * wb.y); as.w = pk2(bflo(aq.w) * wb.z, bfhi(aq.w) * wb.w);
                Xf[ks] = __builtin_bit_cast(bf16x8, as); }
            if (item < 3) { const int hn = g * 16 + F.wave * 2 + ((item + 1) >> 1), ptn = (item + 1) & 1; const bf16* xp = xtile + ((((size_t)c * 128 + hn) * 2 + ptn) * 8) * 512 + (size_t)lane * 8;
#pragma unroll
                for (int ks = 0; ks < 8; ++ks) Xn[ks] = *(const bf16x8*)(xp + ks * 512); }
            bf16* sp = states + ((((size_t)c * 128 + h) * 2 + pt) * 8) * 512 + (size_t)lane * 8;
#pragma unroll
            for (int nt = 0; nt < 4; ++nt) { bf16x8 Bf[8];
#pragma unroll
                for (int ks = 0; ks < 8; ++ks) Bf[ks] = *(const LAS bf16x8*)(BL + (nt * 8 + ks) * 1024 + lane * 16);
                f32x16 acc = zero16();
#pragma unroll
                for (int ks = 0; ks < 8; ++ks) acc = __builtin_amdgcn_mfma_f32_32x32x16_bf16(Bf[ks], Xf[ks], acc, 0, 0, 0);
#pragma unroll
                for (int kk = 0; kk < 2; ++kk) { v4u o; o.x = pk2(acc[8 * kk], acc[8 * kk + 1]); o.y = pk2(acc[8 * kk + 2], acc[8 * kk + 3]); o.z = pk2(acc[8 * kk + 4], acc[8 * kk + 5]); o.w = pk2(acc[8 * kk + 6], acc[8 * kk + 7]);
                    *(v4u*)(sp + (size_t)(2 * nt + kk) * 512) = o; } }
        }
    }
}
__device__ __forceinline__ void ssd_s2_phase(Frame& F, bf16* states, const float* decay) {
    for (int it = blockIdx.x * 512 + F.tid; it < SSD_NH * 64 * 16; it += F.G * 512) {
        const int h = it >> 10; float H[8];
#pragma unroll
        for (int j = 0; j < 8; ++j) H[j] = 0.f;
        v4u* sp = (v4u*)(states + (size_t)it * 8);
#pragma unroll 8
        for (int c = 0; c < 64; ++c) { const v4u q = sp[(size_t)c * (128 * 64 * 16)]; const float dec = decay[(c * 8 + (h >> 4)) * 32 + (h & 15)];
            v4u o; o.x = pk2(H[0], H[1]); o.y = pk2(H[2], H[3]); o.z = pk2(H[4], H[5]); o.w = pk2(H[6], H[7]);
            sp[(size_t)c * (128 * 64 * 16)] = o;
            H[0] = H[0] * dec + bflo(q.x); H[1] = H[1] * dec + bfhi(q.x); H[2] = H[2] * dec + bflo(q.y); H[3] = H[3] * dec + bfhi(q.y);
            H[4] = H[4] * dec + bflo(q.z); H[5] = H[5] * dec + bfhi(q.z); H[6] = H[6] * dec + bflo(q.w); H[7] = H[7] * dec + bfhi(q.w); }
    }
}
__device__ __forceinline__ void ssd_s3_phase(Frame& F, const bf16* xc, const bf16* xtile, const bf16* btok, const bf16* ctok, const bf16* zx, const float* dt, const float* a_log, const float* dsk, float* ssg, const bf16* states, bf16* ybuf) {
    const int lane = F.lane, r = lane & 31, h2 = lane >> 5, li = F.wave >> 1, hhalf = F.wave & 1;
    LAS float* cst = (LAS float*)(F.lds + RING_OFF);
    LAS float* dtt = cst + 2048;
    LAS float* ssw = dtt + 2048;
    LAS float* TT = (LAS float*)(F.lds + RING_OFF + 20480) + F.wave * (32 * 36);
    const int el = lane >> 1, eh = lane & 1;
    for (int u = blockIdx.x; u < 64 * SSD_NG; u += F.G) {
        const int c = u >> 3, g = u & 7, t0 = c * 128;
#pragma unroll
        for (int hh = 0; hh < 2; ++hh) { const int hl = F.wave * 2 + hh, h = g * 16 + hl; const float A = -__expf(a_log[h]);
            const float d0 = dt[(size_t)(t0 + 2 * lane) * 128 + h], d1 = dt[(size_t)(t0 + 2 * lane + 1) * 128 + h];
            const float a1 = d1 * A; float s = d0 * A + a1;
#pragma unroll
            for (int o = 1; o < 64; o <<= 1) { const float v = __shfl_up(s, o); if (lane >= o) s += v; }
            cst[hl * 128 + 2 * lane] = s - a1; cst[hl * 128 + 2 * lane + 1] = s; dtt[hl * 128 + 2 * lane] = d0; dtt[hl * 128 + 2 * lane + 1] = d1; }
        __syncthreads();
        const bf16* cp = ctok + ((((size_t)c * 8 + g) * 4 + li) * 8) * 512 + (size_t)lane * 8;
        f32x16 CBt[4];
        { bf16x8 Cf[8];
#pragma unroll
          for (int ks = 0; ks < 8; ++ks) Cf[ks] = *(const bf16x8*)(cp + ks * 512);
#pragma unroll
          for (int si = 0; si < 4; ++si) {
            if (si <= li) { CBt[si] = zero16(); const bf16* bp = btok + ((((size_t)c * 8 + g) * 4 + si) * 8) * 512 + (size_t)lane * 8; bf16x8 Bf[8];
#pragma unroll
                for (int ks = 0; ks < 8; ++ks) Bf[ks] = *(const bf16x8*)(bp + ks * 512);
#pragma unroll
                for (int ks = 0; ks < 8; ++ks) CBt[si] = __builtin_amdgcn_mfma_f32_32x32x16_bf16(Bf[ks], Cf[ks], CBt[si], 0, 0, 0); }
          } }
        float ssq = 0.f;
        LAS unsigned char* HX = F.lds + RING_OFF + 57344 + hhalf * 32768;
        bf16x8 st[4];
        { const int h = g * 16 + hhalf * 8; const bf16* hp = states + ((((size_t)c * 128 + h) * 2) * 8 + li * 4) * 512 + (size_t)lane * 8;
#pragma unroll
          for (int f = 0; f < 4; ++f) st[f] = *(const bf16x8*)(hp + f * 512); }
#pragma nounroll
        for (int hq = 0; hq < 8; ++hq) {
            const int hl = hhalf * 8 + hq, h = g * 16 + hl;
            const float csl = cst[hl * 128 + 32 * li + r], Dh = dsk[h];
            __syncthreads();
            bf16x8 Cf[8];
            { const bf16* xp = xtile + ((((size_t)c * 128 + h) * 2) * 8 + li * 4) * 512 + (size_t)lane * 8; bf16x8 sx[4];
#pragma unroll
              for (int f = 0; f < 4; ++f) sx[f] = *(const bf16x8*)(xp + f * 512);
#pragma unroll
              for (int ks = 0; ks < 8; ++ks) Cf[ks] = *(const bf16x8*)(cp + ks * 512);
#pragma unroll
              for (int f = 0; f < 4; ++f) { *(LAS bf16x8*)(HX + (li * 4 + f) * 1024 + lane * 16) = st[f]; *(LAS bf16x8*)(HX + 16384 + (li * 4 + f) * 1024 + lane * 16) = sx[f]; } }
            { const int hn = g * 16 + hhalf * 8 + (hq < 7 ? hq + 1 : hq);
              const bf16* hp = states + ((((size_t)c * 128 + hn) * 2) * 8 + li * 4) * 512 + (size_t)lane * 8;
#pragma unroll
              for (int f = 0; f < 4; ++f) st[f] = *(const bf16x8*)(hp + f * 512); }
            __syncthreads();
            f32x16 acc[2];
#pragma unroll
            for (int pt = 0; pt < 2; ++pt) {
                acc[pt] = zero16();
#pragma unroll
                for (int ks = 0; ks < 8; ++ks) { const bf16x8 hf = *(const LAS bf16x8*)(HX + (pt * 8 + ks) * 1024 + lane * 16); acc[pt] = __builtin_amdgcn_mfma_f32_32x32x16_bf16(Cf[ks], hf, acc[pt], 0, 0, 0); }
            }
            v4u zq[2][2];
            asm volatile("" ::: "memory");
            { const size_t t = (size_t)(t0 + 32 * li + el); const int ch = h * 64 + eh * 16; zq[0][0] = *(const v4u*)(zx + t * SSD_MAIN + ch); zq[0][1] = *(const v4u*)(zx + t * SSD_MAIN + ch + 8); }
#pragma unroll
            for (int j = 0; j < 16; ++j) { const float e = __expf(cst[hl * 128 + 32 * li + (j & 3) + 8 * (j >> 2) + 4 * h2]); acc[0][j] *= e; acc[1][j] *= e; }
#pragma unroll
            for (int si = 0; si < 4; ++si) {
                if (si <= li) {
#pragma unroll
                    for (int kk = 0; kk < 2; ++kk) {
                        const int sl = 16 * kk + 8 * h2, s0 = 32 * si + sl;
                        const f32x4 ca = *(const LAS f32x4*)(cst + hl * 128 + s0), cb = *(const LAS f32x4*)(cst + hl * 128 + s0 + 4);
                        const f32x4 da = *(const LAS f32x4*)(dtt + hl * 128 + s0), db = *(const LAS f32x4*)(dtt + hl * 128 + s0 + 4);
                        float gv[8];
#pragma unroll
                        for (int jj = 0; jj < 8; ++jj) { const float cs_s = jj < 4 ? ca[jj & 3] : cb[jj & 3], dt_s = jj < 4 ? da[jj & 3] : db[jj & 3];
                            float v = CBt[si][8 * kk + jj] * __expf(fminf(csl - cs_s, 0.f)) * dt_s;
                            if (si == li && sl + jj > r) v = 0.f;
                            if (si == li && sl + jj == r) v += Dh;
                            gv[jj] = v; }
                        v4u gq; gq.x = pk2(gv[0], gv[1]); gq.y = pk2(gv[2], gv[3]); gq.z = pk2(gv[4], gv[5]); gq.w = pk2(gv[6], gv[7]);
                        const bf16x8 Gf = __builtin_bit_cast(bf16x8, gq);
#pragma unroll
                        for (int pt = 0; pt < 2; ++pt) { const bf16x8 xf = *(const LAS bf16x8*)(HX + 16384 + (pt * 8 + 2 * si + kk) * 1024 + lane * 16);
                            acc[pt] = __builtin_amdgcn_mfma_f32_32x32x16_bf16(Gf, xf, acc[pt], 0, 0, 0); }
                    }
                }
            }
#pragma unroll
            for (int pt = 0; pt < 2; ++pt) {
#pragma unroll
                for (int j = 0; j < 16; ++j) TT[((j & 3) + 8 * (j >> 2) + 4 * h2) * 36 + r] = acc[pt][j];
                LDS_WAIT(); asm volatile("" ::: "memory");
                const size_t t = (size_t)(t0 + 32 * li + el); const int ch = h * 64 + pt * 32 + eh * 16;
                if (pt == 0) { zq[1][0] = *(const v4u*)(zx + t * SSD_MAIN + ch + 32); zq[1][1] = *(const v4u*)(zx + t * SSD_MAIN + ch + 40); }
                const v4u z0 = zq[pt][0], z1 = zq[pt][1];
                const f32x4 a0 = *(const LAS f32x4*)(TT + el * 36 + eh * 16), a1 = *(const LAS f32x4*)(TT + el * 36 + eh * 16 + 4), a2 = *(const LAS f32x4*)(TT + el * 36 + eh * 16 + 8), a3 = *(const LAS f32x4*)(TT + el * 36 + eh * 16 + 12);
                float yv[16];
#define S3_Y(i, av, xw, zw, hi) { const float zs_ = (hi) ? bfhi(zw) : bflo(zw); const float y_ = (av) * silu_f(zs_); yv[i] = y_; ssq += y_ * y_; }
                S3_Y(0, a0.x, 0, z0.x, 0) S3_Y(1, a0.y, 0, z0.x, 1) S3_Y(2, a0.z, 0, z0.y, 0) S3_Y(3, a0.w, 0, z0.y, 1)
                S3_Y(4, a1.x, 0, z0.z, 0) S3_Y(5, a1.y, 0, z0.z, 1) S3_Y(6, a1.z, 0, z0.w, 0) S3_Y(7, a1.w, 0, z0.w, 1)
                S3_Y(8, a2.x, 0, z1.x, 0) S3_Y(9, a2.y, 0, z1.x, 1) S3_Y(10, a2.z, 0, z1.y, 0) S3_Y(11, a2.w, 0, z1.y, 1)
                S3_Y(12, a3.x, 0, z1.z, 0) S3_Y(13, a3.y, 0, z1.z, 1) S3_Y(14, a3.z, 0, z1.w, 0) S3_Y(15, a3.w, 0, z1.w, 1)
#undef S3_Y
                v4u o0, o1; o0.x = pk2(yv[0], yv[1]); o0.y = pk2(yv[2], yv[3]); o0.z = pk2(yv[4], yv[5]); o0.w = pk2(yv[6], yv[7]); o1.x = pk2(yv[8], yv[9]); o1.y = pk2(yv[10], yv[11]); o1.z = pk2(yv[12], yv[13]); o1.w = pk2(yv[14], yv[15]);
                *(v4u*)(ybuf + t * SSD_DI + ch) = o0; *(v4u*)(ybuf + t * SSD_DI + ch + 8) = o1;
                LDS_WAIT(); asm volatile("" ::: "memory");
            }
        }
        ssq += __shfl_xor(ssq, 1);
        if (eh == 0) ssw[hhalf * 128 + 32 * li + el] = ssq;
        __syncthreads();
        if (F.tid < 128) ssg[(size_t)g * M + t0 + F.tid] = ssw[F.tid] + ssw[128 + F.tid];
        __syncthreads();
    }
}
__device__ __forceinline__ void ssd_norm_phase(Frame& F, bf16* ybuf, const float* ssg, const float* norm_w) {
    const int gt = blockIdx.x * 512 + F.tid, chunk = gt & 1023, ch0 = chunk * 8, g = ch0 >> 10;
    const f32x4 wa = *(const f32x4*)(norm_w + ch0), wb = *(const f32x4*)(norm_w + ch0 + 4);
    const int tstep = (F.G * 512) >> 10;
    for (int t = gt >> 10; t < M; t += 4 * tstep) {
        v4u q[4]; float rs[4];
#pragma unroll
        for (int i = 0; i < 4; ++i) { const int ti = t + i * tstep; if (ti < M) { q[i] = *(const v4u*)(ybuf + (size_t)ti * SSD_DI + ch0); rs[i] = ssg[(size_t)g * M + ti]; } }
#pragma unroll
        for (int i = 0; i < 4; ++i) { const int ti = t + i * tstep; if (ti < M) { const float r_ = rsqrtf(rs[i] * (1.0f / 1024.0f) + RMS_EPS); v4u o;
            o.x = pk2(bflo(q[i].x) * r_ * wa.x, bfhi(q[i].x) * r_ * wa.y); o.y = pk2(bflo(q[i].y) * r_ * wa.z, bfhi(q[i].y) * r_ * wa.w);
            o.z = pk2(bflo(q[i].z) * r_ * wb.x, bfhi(q[i].z) * r_ * wb.y); o.w = pk2(bflo(q[i].w) * r_ * wb.z, bfhi(q[i].w) * r_ * wb.w);
            *(v4u*)(ybuf + (size_t)ti * SSD_DI + ch0) = o; } }
    }
}
template <int W> __device__ __forceinline__ void pool_item(const bf16* vz, bf16* dbuf, int c0, int t0) {
    constexpr int RUN = W == 16 ? 8 : 16, NR = RUN + W - 1;
    v4u rows[NR];
#pragma unroll
    for (int i = 0; i < NR; ++i) { const int t = t0 - (W - 1) + i; if (t >= 0) rows[i] = *(const v4u*)(vz + (size_t)t * 16384 + c0); else { rows[i].x = 0u; rows[i].y = 0u; rows[i].z = 0u; rows[i].w = 0u; } }
    float S[8];
#pragma unroll
    for (int j = 0; j < 8; ++j) S[j] = 0.f;
#define POOL_ACC(q, sgn) do { S[0] += sgn bflo((q).x); S[1] += sgn bfhi((q).x); S[2] += sgn bflo((q).y); S[3] += sgn bfhi((q).y); S[4] += sgn bflo((q).z); S[5] += sgn bfhi((q).z); S[6] += sgn bflo((q).w); S[7] += sgn bfhi((q).w); } while (0)
#pragma unroll
    for (int i = 0; i < W - 1; ++i) POOL_ACC(rows[i], +);
#pragma unroll
    for (int i = 0; i < RUN; ++i) { const int t = t0 + i; const v4u q = rows[W - 1 + i]; POOL_ACC(q, +);
        const float inv = __builtin_amdgcn_rcpf((float)(t + 1 < W ? t + 1 : W));
        v4u o; o.x = pk2(S[0] * inv - bflo(q.x), S[1] * inv - bfhi(q.x)); o.y = pk2(S[2] * inv - bflo(q.y), S[3] * inv - bfhi(q.y)); o.z = pk2(S[4] * inv - bflo(q.z), S[5] * inv - bfhi(q.z)); o.w = pk2(S[6] * inv - bflo(q.w), S[7] * inv - bfhi(q.w));
        *(v4u*)(dbuf + (size_t)t * POOL_W + c0) = o;
        POOL_ACC(rows[i], -); }
#undef POOL_ACC
}
template <int W> __device__ __forceinline__ void pool_group(Frame& F, const bf16* vz, bf16* dbuf, int gsel) {
    constexpr int NCG = POOL_GD / 8, RUN = W == 16 ? 8 : 16, NIT = (M / RUN) * NCG;
    for (int it = blockIdx.x * 512 + F.tid; it < NIT; it += F.G * 512) pool_item<W>(vz, dbuf, gsel * POOL_GD + (it % NCG) * 8, (it / NCG) * RUN);
}
__device__ __forceinline__ void pool_phase(Frame& F, const bf16* vz, bf16* dbuf) {
    pool_group<2>(F, vz, dbuf, 0); asm volatile("" ::: "memory");
    pool_group<4>(F, vz, dbuf, 1); asm volatile("" ::: "memory");
    pool_group<8>(F, vz, dbuf, 2); asm volatile("" ::: "memory");
    pool_group<16>(F, vz, dbuf, 3);
}

typedef short s16x4 __attribute__((ext_vector_type(4)));
__device__ __forceinline__ void qknorm_phase(Frame& F, bf16* qkvg, const float* qw, const float* kw, bf16* kmb, bf16* ktile, bf16* vtile) {
    LAS float* red = (LAS float*)(F.lds + 132096);
    LAS unsigned char* KL = F.lds + RING_OFF + F.wave * 16384;
    LAS unsigned char* VL = KL + 8192;
    const int lane = F.lane, r = lane & 31, h2 = lane >> 5;
    const int pr = (r & ~0xC) | ((r & 4) << 1) | ((r & 8) >> 1);
    const float qw0 = qw[2 * lane], qw1 = qw[2 * lane + 1], kw0 = kw[2 * lane], kw1 = kw[2 * lane + 1];
    for (int it = blockIdx.x; it < MOBA_NB * MOBA_H; it += F.G) {
        const int n = it / MOBA_H, h = it % MOBA_H; float ks0 = 0.f, ks1 = 0.f; const int tb = n * 256 + F.wave * 32;
#pragma unroll 8
        for (int i = 0; i < 32; ++i) { const int t = tb + i;
            unsigned* qp = (unsigned*)(qkvg + (size_t)t * 16384 + h * 128) + lane;
            const unsigned qv = *qp, kv = *((const unsigned*)(qkvg + (size_t)t * 16384 + 4096 + h * 128) + lane), vv = *((const unsigned*)(qkvg + (size_t)t * 16384 + 8192 + h * 128) + lane);
            const float q0 = bflo(qv), q1 = bfhi(qv), k0 = bflo(kv), k1 = bfhi(kv);
            const float qs = wave_sum(q0 * q0 + q1 * q1), ks = wave_sum(k0 * k0 + k1 * k1);
            const float qr = rsqrtf(qs * (1.0f / 128.0f) + RMS_EPS), kr = rsqrtf(ks * (1.0f / 128.0f) + RMS_EPS);
            const unsigned qo = pk2(q0 * qr * qw0, q1 * qr * qw1), ko = pk2(k0 * kr * kw0, k1 * kr * kw1);
            *qp = qo; ks0 += bflo(ko); ks1 += bfhi(ko);
            *(LAS unsigned*)(KL + i * 256 + lane * 4) = ko; *(LAS unsigned*)(VL + i * 256 + lane * 4) = vv; }
        red[F.wave * 128 + 2 * lane] = ks0; red[F.wave * 128 + 2 * lane + 1] = ks1;
        LDS_WAIT(); asm volatile("" ::: "memory");
        { const size_t tbase = ((((size_t)h * MOBA_NB + n) * 8 + F.wave) * 8) * 512 + (size_t)lane * 8;
#pragma unroll
          for (int ks = 0; ks < 8; ++ks) *(v4u*)(ktile + tbase + (size_t)ks * 512) = *(const LAS v4u*)(KL + pr * 256 + (16 * ks + 8 * h2) * 2);
          const int qq = (lane & 15) >> 2, pp = lane & 3, b16 = (lane >> 4) & 1;
#pragma unroll
          for (int kk = 0; kk < 2; ++kk)
#pragma unroll
              for (int dt = 0; dt < 4; ++dt) {
                  const LAS unsigned char* a0 = VL + (16 * kk + 8 * h2 + qq) * 256 + (dt * 32 + 16 * b16 + 4 * pp) * 2;
                  const s16x4 lo = __builtin_amdgcn_ds_read_tr16_b64_v4i16((LAS s16x4*)a0), hi = __builtin_amdgcn_ds_read_tr16_b64_v4i16((LAS s16x4*)(a0 + 4 * 256));
                  bf16x8 f; f[0] = lo[0]; f[1] = lo[1]; f[2] = lo[2]; f[3] = lo[3]; f[4] = hi[0]; f[5] = hi[1]; f[6] = hi[2]; f[7] = hi[3];
                  *(bf16x8*)(vtile + tbase + (size_t)(kk * 4 + dt) * 512) = f; } }
        __syncthreads();
        if (F.tid < 128) { float s = 0.f;
#pragma unroll
            for (int w = 0; w < 8; ++w) s += red[w * 128 + F.tid];
            kmb[((size_t)h * MOBA_NB + n) * 128 + F.tid] = (bf16)f2bf(s * (1.0f / 256.0f)); }
        __syncthreads();
    }
}

__device__ __forceinline__ void moba_gate_phase(Frame& F, const bf16* qkvg, const bf16* kmb, int* cntg, unsigned short* listg, unsigned char* selvg) {
    const int lane = F.lane, r = lane & 31, h2 = lane >> 5;
    LAS unsigned short* LIST = (LAS unsigned short*)(F.lds + RING_OFF);
    LAS int* CNTW = (LAS int*)(F.lds + RING_OFF + 16384);
    LAS int* TOT = (LAS int*)(F.lds + RING_OFF + 17408);
    for (int u = blockIdx.x; u < MOBA_H * MOBA_NB; u += F.G) {
        const int h = u >> 5, j = u & 31;
        int s0 = -1, s1 = -1, s2 = -1;
        { const bf16* qp = qkvg + (size_t)(j * 256 + F.wave * 32 + r) * 16384 + h * 128 + h2 * 8; const bf16* kp = kmb + ((size_t)h * MOBA_NB + r) * 128 + h2 * 8;
          f32x16 gs = zero16();
#pragma unroll
          for (int ks = 0; ks < 8; ++ks) { const bf16x8 a = *(const bf16x8*)(kp + ks * 16), b = *(const bf16x8*)(qp + ks * 16); gs = __builtin_amdgcn_mfma_f32_32x32x16_bf16(a, b, gs, 0, 0, 0); }
          float v0 = -INFINITY, v1 = -INFINITY, v2 = -INFINITY;
#pragma unroll
          for (int n = 0; n < 32; ++n) { const int ri = (n & 3) + 4 * (n >> 3); const float own = gs[ri], oth = __shfl_xor(own, 32);
              float s = (((n >> 2) & 1) == h2) ? own : oth; if (n >= j) s = -INFINITY;
              if (s > v0) { v2 = v1; s2 = s1; v1 = v0; s1 = s0; v0 = s; s0 = n; } else if (s > v1) { v2 = v1; s2 = s1; v1 = s; s1 = n; } else if (s > v2) { v2 = s; s2 = n; } }
        }
        if (h2 == 0) selvg[(size_t)(j * 256 + F.wave * 32 + r) * MOBA_H + h] = (unsigned char)((s0 >= 0 ? 1 : 0) | (s1 >= 0 ? 2 : 0) | (s2 >= 0 ? 4 : 0));
#pragma unroll 4
        for (int n = 0; n < 32; ++n) { const unsigned long long b = __ballot(h2 == 0 && (s0 == n || s1 == n || s2 == n)); if (lane == 0) CNTW[F.wave * 32 + n] = __popcll(b); }
        __syncthreads();
        int basev = 0, totv = 0;
        if (lane < 32) {
#pragma unroll
            for (int w = 0; w < 8; ++w) { const int cval = CNTW[w * 32 + lane]; if (w < F.wave) basev += cval; totv += cval; } }
#pragma unroll 4
        for (int n = 0; n < 32; ++n) { const bool mine = h2 == 0 && (s0 == n || s1 == n || s2 == n); const unsigned long long b = __ballot(mine);
            const int base = __builtin_amdgcn_readlane(basev, n);
            if (mine) { const int pos = base + __popcll(b & ((1ull << lane) - 1ull)); const int slot = (s0 == n) ? 0 : (s1 == n) ? 1 : 2; LIST[n * 256 + pos] = (unsigned short)((F.wave * 32 + r) | (slot << 8)); } }
        if (F.wave == 0 && lane < 32) { TOT[lane] = totv; cntg[((size_t)h * 32 + lane) * 32 + j] = totv; }
        __syncthreads();
        for (int i = F.tid; i < 32 * 256; i += 512) { const int n = i >> 8, pos = i & 255; if (pos < TOT[n]) listg[(((size_t)h * 32 + n) * 32 + j) * 256 + pos] = LIST[i]; }
        __syncthreads();
    }
}
__device__ __forceinline__ void moba_kv_phase(Frame& F, const bf16* qkvg, const bf16* ktile, const bf16* vtile, const int* cntg, const unsigned short* listg, const float* qw, const float* kw, bf16* part, float* lpart) {
    const int lane = F.lane, r = lane & 31, h2 = lane >> 5;
    LAS unsigned char* KV = F.lds + RING_OFF;
    LAS int* CHO = (LAS int*)(F.lds + 132096);
    LAS int* PJ = (LAS int*)(F.lds + 136320);
    float c2;
    { float mq = fmaxf(fabsf(qw[2 * lane]), fabsf(qw[2 * lane + 1])), mk = fmaxf(fabsf(kw[2 * lane]), fabsf(kw[2 * lane + 1])); mq = wave_max(mq); mk = wave_max(mk);
      c2 = (11.3137085f * mq * mk * 1.03f + 0.1f) * 1.44269504f; }
    const float c1 = 0.08838834764831845f * 1.44269504f;
    for (int i = F.tid; i < 1024; i += 512) { const int n = i & 31; int E = 0; const int* cp = cntg + (size_t)i * 32;
        for (int j = n + 1; j < 32; ++j) E += cp[j];
        CHO[i] = (8 + ((E + 31) >> 5) + 7) >> 3; }
    __syncthreads();
    if (F.wave == 0) { int loc[16]; int s = 0;
#pragma unroll
        for (int k = 0; k < 16; ++k) { loc[k] = CHO[lane * 16 + k]; s += loc[k]; }
        int inc = s;
#pragma unroll
        for (int o = 1; o < 64; o <<= 1) { const int v = __shfl_up(inc, o); if (lane >= o) inc += v; }
        int run = inc - s;
#pragma unroll
        for (int k = 0; k < 16; ++k) { CHO[lane * 16 + k] = run; run += loc[k]; }
        if (lane == 63) CHO[1024] = inc; }
    __syncthreads();
    const int NC = CHO[1024];
    const int cbeg = (int)(((long)blockIdx.x * NC) / F.G), cend = (int)(((long)(blockIdx.x + 1) * NC) / F.G);
    int cur_hn = -1;
    for (int cid = cbeg; cid < cend; ++cid) {
        int lo = 0, hi = 1023;
        while (lo < hi) { const int mid = (lo + hi + 1) >> 1; if (CHO[mid] <= cid) lo = mid; else hi = mid - 1; }
        const int h = lo >> 5, n = lo & 31, c = cid - CHO[lo];
        const bool reload = lo != cur_hn; cur_hn = lo;
        if (reload) {
            __syncthreads();
            if (F.wave == 0) { int v = (lane < 32 && lane > n) ? cntg[((size_t)h * 32 + n) * 32 + lane] : 0; int inc = v;
#pragma unroll
                for (int o = 1; o < 32; o <<= 1) { const int w = __shfl_up(inc, o); if (lane >= o) inc += w; }
                if (lane < 32) PJ[lane] = inc - v; if (lane == 31) PJ[32] = inc; }
            const v4u* ks = (const v4u*)(ktile + (((size_t)h * MOBA_NB + n) * 64) * 512); const v4u* vs = (const v4u*)(vtile + (((size_t)h * MOBA_NB + n) * 64) * 512);
            v4u kb[8], vb[8];
#pragma unroll
            for (int k = 0; k < 8; ++k) { kb[k] = ks[F.tid + 512 * k]; vb[k] = vs[F.tid + 512 * k]; }
#pragma unroll
            for (int k = 0; k < 8; ++k) { *(LAS v4u*)(KV + (F.tid + 512 * k) * 16) = kb[k]; *(LAS v4u*)(KV + 65536 + (F.tid + 512 * k) * 16) = vb[k]; }
            __syncthreads();
        }
        const int E = PJ[32], T = 8 + ((E + 31) >> 5), ti = c * 8 + F.wave;
        int q = 0, slot = 3, tq = 0, nkt = 0; bool valid = false, own = false;
        if (ti < 8) { own = true; q = ti * 32 + r; tq = n * 256 + q; nkt = ti + 1; valid = true; }
        else if (ti < T) { int e = (ti - 8) * 32 + r; valid = e < E; if (!valid) e = (ti - 8) * 32; int jj = n + 1;
            for (int j2 = n + 2; j2 < 32; ++j2) if (PJ[j2] <= e) jj = j2;
            const int ent = listg[(((size_t)h * 32 + n) * 32 + jj) * 256 + (e - PJ[jj])]; q = ent & 255; slot = ent >> 8; tq = jj * 256 + q; nkt = 8; }
        if (nkt > 0) {
            f32x16 O[4]; float lsum = 0.f;
#pragma unroll
            for (int dt = 0; dt < 4; ++dt) O[dt] = zero16();
            bf16x8 Qf[8];
            { const bf16* qp = qkvg + (size_t)tq * 16384 + h * 128 + h2 * 8;
#pragma unroll
              for (int ks = 0; ks < 8; ++ks) Qf[ks] = *(const bf16x8*)(qp + ks * 16); }
#pragma nounroll
            for (int kt = 0; kt < nkt; ++kt) {
                f32x16 S = zero16();
#pragma unroll
                for (int ks = 0; ks < 8; ++ks) { const bf16x8 kf = *(const LAS bf16x8*)(KV + ((kt * 8 + ks) * 64 + lane) * 16); S = __builtin_amdgcn_mfma_f32_32x32x16_bf16(kf, Qf[ks], S, 0, 0, 0); }
                const bool diag = own && (kt == nkt - 1);
                float p[16];
#pragma unroll
                for (int i = 0; i < 16; ++i) { float pv = __builtin_amdgcn_exp2f(S[i] * c1 - c2); if (diag && (kt * 32 + 16 * (i >> 3) + 8 * h2 + (i & 7)) > q) pv = 0.f; p[i] = pv; lsum += pv; }
#pragma unroll
                for (int kk = 0; kk < 2; ++kk) { v4u pq; pq.x = pk2(p[8 * kk], p[8 * kk + 1]); pq.y = pk2(p[8 * kk + 2], p[8 * kk + 3]); pq.z = pk2(p[8 * kk + 4], p[8 * kk + 5]); pq.w = pk2(p[8 * kk + 6], p[8 * kk + 7]);
                    const bf16x8 Pf = __builtin_bit_cast(bf16x8, pq);
#pragma unroll
                    for (int dt = 0; dt < 4; ++dt) { const bf16x8 vf = *(const LAS bf16x8*)(KV + 65536 + ((kt * 8 + kk * 4 + dt) * 64 + lane) * 16); O[dt] = __builtin_amdgcn_mfma_f32_32x32x16_bf16(vf, Pf, O[dt], 0, 0, 0); } }
            }
            lsum += __shfl_xor(lsum, 32);
            {
                const size_t dst = ((size_t)tq * MOBA_H + h) * 4 + slot; if (valid && h2 == 0) lpart[dst] = lsum;
                bf16* pr_ = part + dst * 128 + 8 * h2;
#pragma unroll
                for (int dt = 0; dt < 4; ++dt)
#pragma unroll
                    for (int rp = 0; rp < 2; ++rp) {
                        const unsigned x0 = pk2(O[dt][8 * rp], O[dt][8 * rp + 1]), x1 = pk2(O[dt][8 * rp + 2], O[dt][8 * rp + 3]), y0 = pk2(O[dt][8 * rp + 4], O[dt][8 * rp + 5]), y1 = pk2(O[dt][8 * rp + 6], O[dt][8 * rp + 7]);
                        const auto s0 = __builtin_amdgcn_permlane32_swap(x0, y0, false, false), s1 = __builtin_amdgcn_permlane32_swap(x1, y1, false, false);
                        v4u w; w.x = s0[0]; w.y = s1[0]; w.z = s0[1]; w.w = s1[1];
                        if (valid) *(v4u*)(pr_ + dt * 32 + 16 * rp) = w; } }
        }
    }
}
__device__ __forceinline__ void moba_combine_phase(Frame& F, const bf16* qkvg, const unsigned char* selvg, const bf16* part, const float* lpart, bf16* obuf) {
    for (int it = blockIdx.x * 512 + F.tid; it < M * MOBA_H * 4; it += F.G * 512) {
        const int qd = it & 3, th = it >> 2, h = th & 31, t = th >> 5; const unsigned vm = selvg[th] | 8u;
        v4u w[4][4]; float lv[4];
#pragma unroll
        for (int sl = 0; sl < 4; ++sl) { const bool v = (vm >> sl) & 1u; const size_t rd = (size_t)th * 4 + (v ? sl : 3); lv[sl] = lpart[rd]; const v4u* pp = (const v4u*)(part + rd * 128 + qd * 32);
#pragma unroll
            for (int c = 0; c < 4; ++c) w[sl][c] = pp[c]; }
        const v4u* gp = (const v4u*)(qkvg + (size_t)t * 16384 + 12288 + h * 128 + qd * 32); v4u gq[4];
#pragma unroll
        for (int c = 0; c < 4; ++c) gq[c] = gp[c];
        float o[32]; float l = 0.f;
#pragma unroll
        for (int i = 0; i < 32; ++i) o[i] = 0.f;
#pragma unroll
        for (int sl = 0; sl < 4; ++sl) { const bool v = (vm >> sl) & 1u; const unsigned m = v ? 0xffffffffu : 0u; l += v ? lv[sl] : 0.f;
#pragma unroll
            for (int c = 0; c < 4; ++c) { v4u q = w[sl][c]; q.x &= m; q.y &= m; q.z &= m; q.w &= m;
                o[8 * c] += bflo(q.x); o[8 * c + 1] += bfhi(q.x); o[8 * c + 2] += bflo(q.y); o[8 * c + 3] += bfhi(q.y); o[8 * c + 4] += bflo(q.z); o[8 * c + 5] += bfhi(q.z); o[8 * c + 6] += bflo(q.w); o[8 * c + 7] += bfhi(q.w); } }
        const float inv = 1.0f / l; v4u* op = (v4u*)(obuf + (size_t)t * MOBA_W + h * 128 + qd * 32);
#pragma unroll
        for (int c = 0; c < 4; ++c) { const v4u g_ = gq[c]; v4u r_;
            r_.x = pk2(o[8 * c] * inv * silu_f(bflo(g_.x)), o[8 * c + 1] * inv * silu_f(bfhi(g_.x))); r_.y = pk2(o[8 * c + 2] * inv * silu_f(bflo(g_.y)), o[8 * c + 3] * inv * silu_f(bfhi(g_.y)));
            r_.z = pk2(o[8 * c + 4] * inv * silu_f(bflo(g_.z)), o[8 * c + 5] * inv * silu_f(bfhi(g_.z))); r_.w = pk2(o[8 * c + 6] * inv * silu_f(bflo(g_.w)), o[8 * c + 7] * inv * silu_f(bfhi(g_.w))); op[c] = r_; }
    }
}
#ifndef MK_N_LAUNCHES
#define MK_N_LAUNCHES 1
#endif
__device__ __forceinline__ void xcd_skew(int ticks_per_xcd) {
    const unsigned long long t0 = __builtin_amdgcn_s_memrealtime(); const unsigned long long want = (unsigned long long)(((blockIdx.x >> 3) & 31) * ticks_per_xcd);
    while (__builtin_amdgcn_s_memrealtime() - t0 < want) __builtin_amdgcn_s_sleep(2);
}
constexpr int N_PHASES = 25;
struct Args { AllIn I; float* out; unsigned char* ws; int ph_lo, ph_hi; };
#define INP(i) ldin(i)
__global__ void __launch_bounds__(NWAVES * 64, 2) mk_fwd(Args args) {
    extern __shared__ __attribute__((aligned(16))) unsigned char lds[];
    Frame F;
    F.lds = (LAS unsigned char*)lds;
    F.MISC = (volatile LAS unsigned*)(F.lds + MISC_OFF);
    F.tid = threadIdx.x; F.lane = F.tid & 63; F.wave = __builtin_amdgcn_readfirstlane(F.tid >> 6);
    F.G = gridDim.x; F.ws = args.ws;
    F.ctl = (gu32*)(args.ws + WS_CTL);
    for (int u = F.tid; u < (LDS_BYTES - LDSCTL_OFF) / 4; u += NWAVES * 64) ((LAS unsigned*)(F.lds + LDSCTL_OFF))[u] = 0u;
    __syncthreads();
    const int lo = args.ph_lo, hi = args.ph_hi;
    XcdBarrier bar; bar.bar = (unsigned*)(F.ctl + CW_BAR); bar.x = 0; bar.st = nullptr;
    if (hi - lo > 1) bar = xcd_barrier_post((unsigned*)(F.ctl + CW_BAR), F.MISC + 8);
#define IN(k) (lo <= (k) && (k) < hi)
#define SEAM(k) do { if (IN(k) && IN((k) + 1)) xcd_barrier(bar); } while (0)
#define WSP(T, off) ((T*)(args.ws + (off)))
#define ROWSS(l) ((unsigned long long*)(F.ctl + CW_ROWSS) + (l) * M)

    if (IN(0)) { p0_prologue(F, INP(0), WSP(bf16, WS_HB), ROWSS(0)); } SEAM(0);

#define SSD_LAYER(REPV) { constexpr int rep = (REPV); \
        constexpr int pb = rep ? 18 : 1, ib = rep ? 22 : 2, layer = rep ? 3 : 0; \
        if (IN(pb + 0)) { \
            const bf16* Win_t = WSP(const bf16, rep ? WS_W_SSD3_IN : WS_W_SSD0_IN); \
            pg8::Gemm g{WSP(const bf16, WS_HB), Win_t, M, SSD_MAIN, D, D, D, 0}; pg8::StaticOrder S; S.init(M, SSD_MAIN, F.G, (int)blockIdx.x); \
            pg8::EpiRowScale E{WSP(bf16, WS_ACT_A), SSD_MAIN, ROWSS(layer), (LAS float*)(F.lds + 132096)}; \
            pg8::gemm_phase<pg8::EpiRowScale, pg8::StaticOrder, true, true>(F.lds + RING_OFF, g, S, E); \
            __syncthreads(); \
            dt_phase(F, WSP(const bf16, WS_HB), Win_t + (size_t)SSD_MAIN * D, ROWSS(layer), INP(ib + 3), WSP(float, WS_DT)); \
        } \
        SEAM(pb + 0); \
        if (IN(pb + 1)) conv_phase(F, WSP(const bf16, WS_ACT_A), INP(ib + 1), INP(ib + 2), WSP(bf16, WS_XC), WSP(bf16, WS_XT), WSP(bf16, WS_BT), WSP(bf16, WS_BT + 16 * MiB), WSP(bf16, WS_BT + 32 * MiB)); \
        SEAM(pb + 1); \
        if (IN(pb + 2)) ssd_s1_phase(F, WSP(const bf16, WS_XT), WSP(const bf16, WS_BT), WSP(const float, WS_DT), INP(ib + 4), WSP(bf16, WS_STATES), WSP(float, WS_DECAY)); \
        SEAM(pb + 2); \
        if (IN(pb + 3)) ssd_s2_phase(F, WSP(bf16, WS_STATES), WSP(const float, WS_DECAY)); \
        SEAM(pb + 3); \
        if (IN(pb + 4)) ssd_s3_phase(F, WSP(const bf16, WS_XC), WSP(const bf16, WS_XT), WSP(const bf16, WS_BT + 16 * MiB), WSP(const bf16, WS_BT + 32 * MiB), WSP(const bf16, WS_ACT_A), WSP(const float, WS_DT), INP(ib + 4), INP(ib + 5), WSP(float, WS_SSG), WSP(const bf16, WS_STATES), WSP(bf16, WS_ACT_B)); \
        SEAM(pb + 4); \
        if (IN(pb + 6)) { \
            pg8::Gemm g{WSP(const bf16, WS_ACT_B), WSP(const bf16, rep ? WS_W_SSD3_OUT : WS_W_SSD0_OUT), M, D, SSD_DI, SSD_DI, SSD_DI, 0}; pg8::StaticOrder S; S.init(M, D, F.G, (int)blockIdx.x); \
            if constexpr (rep == 0) { pg8::EpiResid<true, true> E{(const float*)nullptr, WSP(const bf16, WS_HB), (float*)nullptr, WSP(bf16, WS_HB), ROWSS(1), WSP(const float, WS_SSG), (LAS float*)(F.lds + 132096)}; \
                pg8::gemm_phase<pg8::EpiResid<true, true>, pg8::StaticOrder, true, true>(F.lds + RING_OFF, g, S, E); } \
            else { pg8::EpiResid<true, true> E{(const float*)nullptr, WSP(const bf16, WS_HB), args.out, (bf16*)nullptr, (unsigned long long*)nullptr, WSP(const float, WS_SSG), (LAS float*)(F.lds + 132096)}; \
                pg8::gemm_phase<pg8::EpiResid<true, true>, pg8::StaticOrder, true, true>(F.lds + RING_OFF, g, S, E); } \
        } \
        SEAM(pb + 6); \
    }
    SSD_LAYER(0)
    {
            if (IN(8)) {
                pg8::Gemm g{WSP(const bf16, WS_HB), WSP(const bf16, WS_W_POOL_IN), M, 16384, D, D, D, 0}; pg8::StaticOrder S; S.init(M, 16384, F.G, (int)blockIdx.x);
                pg8::EpiRowScale E{WSP(bf16, WS_ACT_A), 16384, ROWSS(1), (LAS float*)(F.lds + 132096)};
                pg8::gemm_phase<pg8::EpiRowScale, pg8::StaticOrder, true, true>(F.lds + RING_OFF, g, S, E);
            }
            SEAM(8);
            if (IN(9)) pool_phase(F, WSP(const bf16, WS_ACT_A), WSP(bf16, WS_ACT_B));
            SEAM(9);
            if (IN(10)) {
                pg8::Gemm g{WSP(const bf16, WS_ACT_B), WSP(const bf16, WS_W_POOL_GRP), M, POOL_W, POOL_GD, POOL_W, POOL_GD, POOL_GD / 256}; pg8::StaticOrder S; S.init(M, POOL_W, F.G, (int)blockIdx.x);
                pg8::EpiPoolGrp E{WSP(bf16, WS_ACT_C), WSP(const bf16, WS_ACT_A), INP(13), INP(14)};
                pg8::gemm_phase<pg8::EpiPoolGrp, pg8::StaticOrder, true, true>(F.lds + RING_OFF, g, S, E);
            }
            SEAM(10);
            if (IN(11)) {
                pg8::Gemm g{WSP(const bf16, WS_ACT_C), WSP(const bf16, WS_W_POOL_OUT), M, D, POOL_W, POOL_W, POOL_W, 0}; pg8::StaticOrder S; S.init(M, D, F.G, (int)blockIdx.x);
                pg8::EpiResid<true, false> E{(const float*)nullptr, WSP(const bf16, WS_HB), (float*)nullptr, WSP(bf16, WS_HB), ROWSS(2), (const float*)nullptr, (LAS float*)nullptr};
                pg8::gemm_phase<pg8::EpiResid<true, false>, pg8::StaticOrder, true, true>(F.lds + RING_OFF, g, S, E);
            }
            SEAM(11);
            if (IN(12)) {
                pg8::Gemm g{WSP(const bf16, WS_HB), WSP(const bf16, WS_W_MOBA_IN), M, 16384, D, D, D, 0}; pg8::StaticOrder S; S.init(M, 16384, F.G, (int)blockIdx.x);
                pg8::EpiRowScale E{WSP(bf16, WS_ACT_A), 16384, ROWSS(2), (LAS float*)(F.lds + 132096)};
                pg8::gemm_phase<pg8::EpiRowScale, pg8::StaticOrder, true, true>(F.lds + RING_OFF, g, S, E);
            }
            SEAM(12);
            if (IN(13)) qknorm_phase(F, WSP(bf16, WS_ACT_A), INP(18), INP(19), WSP(bf16, WS_KMEAN), WSP(bf16, WS_XC + 72 * MiB), WSP(bf16, WS_XC));
            SEAM(13);
            if (IN(14)) moba_gate_phase(F, WSP(const bf16, WS_ACT_A), WSP(const bf16, WS_KMEAN), WSP(int, WS_XC + 136 * MiB), WSP(unsigned short, WS_XC + 138 * MiB), WSP(unsigned char, WS_XC + 137 * MiB));
            SEAM(14);
            if (IN(15)) moba_kv_phase(F, WSP(const bf16, WS_ACT_A), WSP(const bf16, WS_XC + 72 * MiB), WSP(const bf16, WS_XC), WSP(const int, WS_XC + 136 * MiB), WSP(const unsigned short, WS_XC + 138 * MiB), INP(18), INP(19), WSP(bf16, WS_ACT_C), WSP(float, WS_XC + 64 * MiB));
            SEAM(15);
            if (IN(16)) moba_combine_phase(F, WSP(const bf16, WS_ACT_A), WSP(const unsigned char, WS_XC + 137 * MiB), WSP(const bf16, WS_ACT_C), WSP(const float, WS_XC + 64 * MiB), WSP(bf16, WS_ACT_B));
            SEAM(16);
            if (IN(17)) {
                pg8::Gemm g{WSP(const bf16, WS_ACT_B), WSP(const bf16, WS_W_MOBA_OUT), M, D, MOBA_W, MOBA_W, MOBA_W, 0}; pg8::StaticOrder S; S.init(M, D, F.G, (int)blockIdx.x);
                pg8::EpiResid<true, false> E{(const float*)nullptr, WSP(const bf16, WS_HB), (float*)nullptr, WSP(bf16, WS_HB), ROWSS(3), (const float*)nullptr, (LAS float*)nullptr};
                pg8::gemm_phase<pg8::EpiResid<true, false>, pg8::StaticOrder, true, true>(F.lds + RING_OFF, g, S, E);
            }
            SEAM(17);
        }
    SSD_LAYER(1)
#undef SSD_LAYER
#undef IN
#undef SEAM
#undef WSP
#undef ROWSS
}

extern "C" void kernel_launch(void* const* d_in, const int* in_sizes, int n_in, void* d_out, int out_size, void* d_ws, size_t ws_size, hipStream_t stream) {
    static int grid = 0;
    if (grid == 0) {
        if (n_in != 30 || in_sizes[0] != M * D || out_size != M * D || ws_size < WS_END) { fprintf(stderr, "kernel_launch: unexpected shapes: n_in %d in0 %d out %d ws %zu (need %zu)\n", n_in, n_in > 0 ? in_sizes[0] : -1, out_size, ws_size, (size_t)WS_END); grid = -1; return; }
        int dev = 0, cus = 0, per_cu = 0;
        if (hipGetDevice(&dev) != hipSuccess || hipDeviceGetAttribute(&cus, hipDeviceAttributeMultiprocessorCount, dev) != hipSuccess) { grid = -1; return; }
        if (hipFuncSetAttribute((const void*)mk_fwd, hipFuncAttributeMaxDynamicSharedMemorySize, LDS_BYTES) != hipSuccess) { fprintf(stderr, "kernel_launch: hipFuncSetAttribute failed\n"); grid = -1; return; }
        if (hipOccupancyMaxActiveBlocksPerMultiprocessor(&per_cu, (const void*)mk_fwd, NWAVES * 64, LDS_BYTES) != hipSuccess || per_cu < 1)
            fprintf(stderr, "kernel_launch: occupancy query reports %d workgroups per CU\n", per_cu);
        (void)hipGetLastError();
        grid = cus;
    }
    if (grid < 0) return;
    if (hipMemsetAsync((char*)d_ws + WS_CTL, 0, CTL_ZERO_BYTES, stream) != hipSuccess) { fprintf(stderr, "kernel_launch: memset failed\n"); return; }
    Args a{};
    for (int i = 0; i < 30; ++i) a.I.in[i] = (const float*)d_in[i];
    a.out = (float*)d_out; a.ws = (unsigned char*)d_ws;
#if MK_N_LAUNCHES == 1
    a.ph_lo = 0; a.ph_hi = N_PHASES;
    hipLaunchKernelGGL(mk_fwd, dim3(grid), dim3(NWAVES * 64), LDS_BYTES, stream, a);
#else
    for (int li = 0; li < N_PHASES; ++li) { a.ph_lo = li; a.ph_hi = li + 1; hipLaunchKernelGGL(mk_fwd, dim3(grid), dim3(NWAVES * 64), LDS_BYTES, stream, a); }
#endif
}
```

```cpp
#include <hip/hip_runtime.h>
#include <cstdio>
#include <cstdint>
#define MK_N_LAUNCHES 1
namespace pg8 {
#define PG8_LAS __attribute__((address_space(3)))
typedef unsigned short bf16_t;
typedef short bf16x8 __attribute__((ext_vector_type(8)));
typedef float f32x4 __attribute__((ext_vector_type(4)));
typedef unsigned u32x4 __attribute__((ext_vector_type(4)));
constexpr int BM = 256, BK = 64, HALF = 128, HTB = HALF * BK * 2  , STAGE_BYTES = 8 * HTB, NXCD = 8, WGM = 4;

__host__ __device__ __forceinline__ int lds_byte(int r, int c) { const int st = (r >> 4) * 2 + (c >> 5), rr = r & 15, cc = c & 31, ob = rr * 64 + cc * 2; return st * 1024 + (ob ^ (((ob >> 9) & 1) << 5)); }
__host__ __device__ __forceinline__ void stage_rc(int b, int& R, int& C) { const int st = b / 1024, sb = b % 1024, swz = sb ^ (((sb >> 9) & 1) << 5); R = (st >> 1) * 16 + swz / 64; C = (st & 1) * 32 + (swz % 64) / 2; }
__host__ __device__ __forceinline__ int perm32(int rho) { const int n = rho >> 4, i = rho & 15; return 8 * (i >> 2) + 4 * n + (i & 3); }

struct Unit { int pm, pn; };
struct Gemm { const bf16_t* A; const bf16_t* Bt; int M, N, K, lda, ldb, gdiv; };

struct StaticOrder {
    int nM, nN, nwg, G, c;
    __host__ __device__ void init(int M, int N, int G_, int c_) { nM = M / BM; nN = N / BM; nwg = nM * nN; G = G_; c = c_; }
    __host__ __device__ bool next(int i, Unit& u) const {
        const long L = (long)i * G + c; if (L >= nwg) return false;
        int wgid = (int)L; { const int q = nwg / NXCD, r = nwg % NXCD, xcd = wgid % NXCD, off = wgid / NXCD; wgid = (xcd < r ? xcd * (q + 1) : r * (q + 1) + (xcd - r) * q) + off; }
        const int nig = WGM * nN, gid = wgid / nig, fm = gid * WGM, gsz = (nM - fm) < WGM ? (nM - fm) : WGM;
        u.pm = fm + ((wgid % nig) % gsz); u.pn = (wgid % nig) / gsz; return true;
    }
    __device__ __forceinline__ void a_ready(const Unit&) const {}
    __device__ __forceinline__ void done(const Unit&) const {}
};

__device__ __forceinline__ unsigned cvt_pk_bf16(float lo, float hi) { unsigned r; asm volatile("v_cvt_pk_bf16_f32 %0, %1, %2" : "=v"(r) : "v"(lo), "v"(hi)); return r; }

template <class Epi, class Sched, bool ALIGN_EPI = false, bool SP2 = false>
__device__ __forceinline__ void gemm_phase(PG8_LAS unsigned char* lds, const Gemm g, const Sched& S, const Epi& E) {
    const int tid = threadIdx.x, wid = __builtin_amdgcn_readfirstlane(tid >> 6), lane = tid & 63, wr = wid >> 2, wc = wid & 3, fr = lane & 15, fq = lane >> 4;
    const int K = g.K, nt = K / BK;
    unsigned voffA[2], voffB[2];
#pragma unroll
    for (int i = 0; i < 2; ++i) { int R, C; stage_rc(tid * 16 + i * 8192, R, C); const int Rb = Epi::PERM ? ((R & ~31) + perm32(R & 31)) : R;
        voffA[i] = (unsigned)(R * g.lda + C) * 2u; voffB[i] = (unsigned)(Rb * g.ldb + C) * 2u; }
    const size_t kstep = (size_t)(BK * 2);
    const size_t hstepA = (size_t)HALF * g.lda * 2, hstepB = (size_t)HALF * g.ldb * 2;
    const size_t tstepA = 2 * hstepA, tstepB = 2 * hstepB;
    const unsigned ldsw = (unsigned)wid * 1024u;
    const int aoff = lds_byte(wr * 64 + fr, fq * 8), boff = lds_byte(wc * 32 + fr, fq * 8);
#define PG8_SA(b, h) (((b) * 2 + (h)) * HTB)
#define PG8_SB(b, h) ((4 + (b) * 2 + (h)) * HTB)
#define PG8_STAGE(bufoff, gbase, voff) do { _Pragma("unroll") for (int _i = 0; _i < 2; ++_i) \
        __builtin_amdgcn_global_load_lds((const unsigned*)((const char*)(gbase) + (voff)[_i]), (PG8_LAS unsigned*)(lds + (bufoff) + ldsw + _i * 8192), 16, 0, 0); } while (0)
#define PG8_LDA(dst, b, h) do { _Pragma("unroll") for (int m = 0; m < 4; ++m) _Pragma("unroll") for (int k = 0; k < 2; ++k) dst[m][k] = *(const PG8_LAS bf16x8*)(lds + PG8_SA(b, h) + aoff + m * 2048 + k * 1024); } while (0)
#define PG8_LDB(dst, b, h) do { _Pragma("unroll") for (int n = 0; n < 2; ++n) _Pragma("unroll") for (int k = 0; k < 2; ++k) dst[n][k] = *(const PG8_LAS bf16x8*)(lds + PG8_SB(b, h) + boff + n * 2048 + k * 1024); } while (0)
#define PG8_MMA(ai, bj, At, Bt) do { __builtin_amdgcn_s_setprio(1); _Pragma("unroll") for (int m = 0; m < 4; ++m) _Pragma("unroll") for (int n = 0; n < 2; ++n) _Pragma("unroll") for (int k = 0; k < 2; ++k) \
        acc[ai][bj][m][n] = __builtin_amdgcn_mfma_f32_16x16x32_bf16(Bt[n][k], At[m][k], acc[ai][bj][m][n], 0, 0, 0); __builtin_amdgcn_s_setprio(0); } while (0)
#define PG8_WAIT_V(n) asm volatile("s_waitcnt vmcnt(" #n ")" ::: "memory")
#define PG8_WAIT_L(n) asm volatile("s_waitcnt lgkmcnt(" #n ")" ::: "memory")
#define PG8_BAR __builtin_amdgcn_s_barrier()
#define PG8_SCHED __builtin_amdgcn_sched_barrier(0)
#define PG8_ABASE(u) ((const char*)g.A + (size_t)(u).pm * tstepA + (g.gdiv ? (size_t)((u).pn / g.gdiv) * (size_t)K * 2 : (size_t)0))
    Unit cur, nxt; int ui = 0;
    if (!S.next(0, cur)) return;
    f32x4 acc[2][2][4][2];
#pragma unroll
    for (int a = 0; a < 2; ++a)
#pragma unroll
        for (int b = 0; b < 2; ++b)
#pragma unroll
            for (int m = 0; m < 4; ++m)
#pragma unroll
                for (int n = 0; n < 2; ++n) acc[a][b][m][n] = (f32x4){0.f, 0.f, 0.f, 0.f};
    bf16x8 At[4][2], B0[2][2], B1[2][2];
    const char* cA = PG8_ABASE(cur); const char* cB = (const char*)g.Bt + (size_t)cur.pn * tstepB;
    S.a_ready(cur);
    E.pre(cur);
    if constexpr (SP2) {
        PG8_STAGE(PG8_SB(0, 0), cB, voffB); PG8_STAGE(PG8_SB(0, 1), cB + hstepB, voffB); PG8_STAGE(PG8_SA(0, 0), cA, voffA); PG8_STAGE(PG8_SA(0, 1), cA + hstepA, voffA);
        if (wr == 1) PG8_BAR;
        PG8_WAIT_V(2); PG8_BAR;
        PG8_STAGE(PG8_SB(1, 0), cB + kstep, voffB); PG8_STAGE(PG8_SA(1, 0), cA + kstep, voffA); PG8_STAGE(PG8_SB(1, 1), cB + hstepB + kstep, voffB);
        PG8_WAIT_V(6); PG8_BAR;
    } else {
        PG8_STAGE(PG8_SB(0, 0), cB, voffB); PG8_STAGE(PG8_SA(0, 0), cA, voffA); PG8_STAGE(PG8_SB(0, 1), cB + hstepB, voffB); PG8_STAGE(PG8_SA(0, 1), cA + hstepA, voffA);
        if (wr == 1) PG8_BAR;
        PG8_WAIT_V(4); PG8_BAR;
        PG8_STAGE(PG8_SB(1, 0), cB + kstep, voffB); PG8_STAGE(PG8_SA(1, 0), cA + kstep, voffA); PG8_STAGE(PG8_SB(1, 1), cB + hstepB + kstep, voffB);
        PG8_WAIT_V(6); PG8_BAR;
    }
    for (;;) {
        const bool has_next = S.next(ui + 1, nxt);
        const char* nA = has_next ? PG8_ABASE(nxt) : cA; const char* nB = has_next ? (const char*)g.Bt + (size_t)nxt.pn * tstepB : cB;
        for (int t = 0; t < nt; t += 2) {
            const bool last = (t == nt - 2);
            if constexpr (Epi::KHOOK) {
                if (t == 2) E.fill(cur);
                if (t > 0 && (t & 15) == 0) E.khook(acc, (t >> 4) - 1, wr, fr);
            }
            const char* a1 = cA + (size_t)(t + 1) * kstep;
            const char* a2 = last ? nA : cA + (size_t)(t + 2) * kstep; const char* b2 = last ? nB : cB + (size_t)(t + 2) * kstep;
            const char* a3 = a2 + kstep; const char* b3 = b2 + kstep;
            if (last && has_next) S.a_ready(nxt);
            if constexpr (SP2) {
            PG8_LDB(B0, 0, 0); PG8_LDB(B1, 0, 1); PG8_SCHED; PG8_LDA(At, 0, 0); PG8_STAGE(PG8_SA(1, 1), a1 + hstepA, voffA);
            PG8_WAIT_V(8); PG8_WAIT_L(0); PG8_BAR; PG8_MMA(0, 0, At, B0); PG8_MMA(0, 1, At, B1); PG8_BAR; PG8_SCHED;
            PG8_LDA(At, 0, 1); PG8_STAGE(PG8_SB(0, 0), b2, voffB); PG8_STAGE(PG8_SB(0, 1), b2 + hstepB, voffB); PG8_STAGE(PG8_SA(0, 0), a2, voffA);
            PG8_WAIT_V(8); PG8_WAIT_L(0); PG8_BAR; PG8_MMA(1, 0, At, B0); PG8_MMA(1, 1, At, B1); PG8_BAR; PG8_SCHED;
            PG8_LDB(B0, 1, 0); PG8_LDB(B1, 1, 1); PG8_SCHED; PG8_LDA(At, 1, 0); PG8_STAGE(PG8_SA(0, 1), a2 + hstepA, voffA);
            PG8_WAIT_V(8); PG8_WAIT_L(0); PG8_BAR; PG8_MMA(0, 0, At, B0); PG8_MMA(0, 1, At, B1); PG8_BAR; PG8_SCHED;
            PG8_LDA(At, 1, 1); PG8_STAGE(PG8_SB(1, 0), b3, voffB); PG8_STAGE(PG8_SB(1, 1), b3 + hstepB, voffB); PG8_STAGE(PG8_SA(1, 0), a3, voffA);
            PG8_WAIT_V(8); PG8_WAIT_L(0); PG8_BAR; PG8_MMA(1, 0, At, B0); PG8_MMA(1, 1, At, B1); PG8_BAR; PG8_SCHED;
            } else {
            PG8_LDB(B0, 0, 0); PG8_SCHED; PG8_LDA(At, 0, 0); PG8_STAGE(PG8_SA(1, 1), a1 + hstepA, voffA);
            PG8_WAIT_L(8); PG8_BAR; PG8_WAIT_L(0); PG8_MMA(0, 0, At, B0); PG8_BAR; PG8_SCHED;
            PG8_LDB(B1, 0, 1); PG8_STAGE(PG8_SB(0, 0), b2, voffB);
            PG8_BAR; PG8_WAIT_L(0); PG8_MMA(0, 1, At, B1); PG8_BAR;
            PG8_LDA(At, 0, 1); PG8_STAGE(PG8_SA(0, 0), a2, voffA);
            PG8_BAR; PG8_WAIT_L(0); PG8_MMA(1, 0, At, B0); PG8_BAR; PG8_SCHED;
            PG8_STAGE(PG8_SB(0, 1), b2 + hstepB, voffB);
            PG8_WAIT_V(6); PG8_BAR; PG8_MMA(1, 1, At, B1); PG8_BAR;
            PG8_LDB(B0, 1, 0); PG8_SCHED; PG8_LDA(At, 1, 0); PG8_STAGE(PG8_SA(0, 1), a2 + hstepA, voffA);
            PG8_WAIT_L(8); PG8_BAR; PG8_WAIT_L(0); PG8_MMA(0, 0, At, B0); PG8_BAR; PG8_SCHED;
            PG8_LDB(B1, 1, 1); PG8_STAGE(PG8_SB(1, 0), b3, voffB);
            PG8_BAR; PG8_WAIT_L(0); PG8_MMA(0, 1, At, B1); PG8_BAR;
            PG8_LDA(At, 1, 1); PG8_STAGE(PG8_SA(1, 0), a3, voffA);
            PG8_BAR; PG8_WAIT_L(0); PG8_MMA(1, 0, At, B0); PG8_BAR; PG8_SCHED;
            PG8_STAGE(PG8_SB(1, 1), b3 + hstepB, voffB);
            PG8_WAIT_V(6); PG8_BAR; PG8_MMA(1, 1, At, B1); PG8_BAR;
            }
        }
        if constexpr (ALIGN_EPI) { if (wr == 0) PG8_BAR; }
        E(acc, cur, wr, wc, fr, fq, ui & 1, has_next, nxt); S.done(cur);
        if (!has_next) break;
#pragma unroll
        for (int a = 0; a < 2; ++a)
#pragma unroll
            for (int b = 0; b < 2; ++b)
#pragma unroll
                for (int m = 0; m < 4; ++m)
#pragma unroll
                    for (int n = 0; n < 2; ++n) acc[a][b][m][n] = (f32x4){0.f, 0.f, 0.f, 0.f};
        cur = nxt; cA = nA; cB = nB; ++ui;
        if constexpr (ALIGN_EPI) { if (wr == 1) PG8_BAR; }
    }
    PG8_WAIT_V(0);
    if constexpr (!ALIGN_EPI) { if (wr == 0) PG8_BAR; }
    PG8_BAR;
#undef PG8_ABASE
#undef PG8_SA
#undef PG8_SB
#undef PG8_STAGE
#undef PG8_LDA
#undef PG8_LDB
#undef PG8_MMA
#undef PG8_WAIT_V
#undef PG8_WAIT_L
#undef PG8_BAR
#undef PG8_SCHED
}
}
constexpr int NWAVES = 8;
constexpr int M = 8192, D = 4096;
constexpr float RMS_EPS = 1e-6f;
constexpr int SSD_DI = 8192, SSD_NH = 128, SSD_HD = 64, SSD_NG = 8, SSD_DS = 128, SSD_CONV = 10240, SSD_IN = 18560, SSD_MAIN = 18432;
constexpr int POOL_W = 8192, POOL_GD = 2048;
constexpr int MOBA_H = 32, MOBA_DH = 128, MOBA_BLK = 256, MOBA_NB = 32, MOBA_W = 4096;

constexpr size_t MiB = 1u << 20;
constexpr size_t WS_CTL = 0, CTL_ZERO_BYTES = 1 * MiB;
constexpr size_t WS_W_SSD0_IN = 1 * MiB;
constexpr size_t WS_W_SSD0_OUT = WS_W_SSD0_IN + 145 * MiB;
constexpr size_t WS_W_POOL_IN = WS_W_SSD0_OUT + 64 * MiB;
constexpr size_t WS_W_POOL_GRP = WS_W_POOL_IN + 128 * MiB;
constexpr size_t WS_W_POOL_OUT = WS_W_POOL_GRP + 32 * MiB;
constexpr size_t WS_W_MOBA_IN = WS_W_POOL_OUT + 64 * MiB;
constexpr size_t WS_W_MOBA_OUT = WS_W_MOBA_IN + 128 * MiB;
constexpr size_t WS_W_SSD3_IN = WS_W_MOBA_OUT + 32 * MiB;
constexpr size_t WS_W_SSD3_OUT = WS_W_SSD3_IN + 145 * MiB;
constexpr size_t WS_ACT_A = WS_W_SSD3_OUT + 64 * MiB;
constexpr size_t WS_ACT_B = WS_ACT_A + 288 * MiB;
constexpr size_t WS_ACT_C = WS_ACT_B + 128 * MiB;
constexpr size_t WS_STATES = WS_ACT_C, WS_XT = WS_ACT_C + 128 * MiB;
constexpr size_t WS_XC = WS_ACT_C + 256 * MiB;
constexpr size_t WS_HB = WS_XC + 160 * MiB;
constexpr size_t WS_DT = WS_HB + 64 * MiB;
constexpr size_t WS_KMEAN = WS_DT + 4 * MiB;
constexpr size_t WS_DECAY = WS_KMEAN + 512 * 1024;
constexpr size_t WS_SSG = WS_DECAY + 64 * 1024;
constexpr size_t WS_END = WS_KMEAN + 1 * MiB;
constexpr size_t WS_BT = WS_XC;
constexpr int CW_TMO = 0, CW_CODE = 1;
constexpr int CW_BAR = 4096;
constexpr int CW_ROWSS = 16384;
static_assert((CW_ROWSS + 8 * M) * 4 <= (int)CTL_ZERO_BYTES, "CTL words inside the memset region");

constexpr int RING_OFF = 0, RING_BYTES = 131072;
constexpr int LDSCTL_OFF = RING_BYTES, MISC_OFF = LDSCTL_OFF + 320;
constexpr int LDS_BYTES = 147456;
static_assert(MISC_OFF + 128 <= LDS_BYTES, "LDS map");

#define GAS __attribute__((address_space(1)))
#define LAS __attribute__((address_space(3)))
typedef unsigned short bf16;
typedef unsigned v4u __attribute__((ext_vector_type(4)));
typedef unsigned v2u __attribute__((ext_vector_type(2)));
typedef float f32x4 __attribute__((ext_vector_type(4)));
typedef float f32x16 __attribute__((ext_vector_type(16)));
typedef short bf16x8 __attribute__((ext_vector_type(8)));
typedef GAS unsigned gu32;
#define RLX_AGENT __ATOMIC_RELAXED, __HIP_MEMORY_SCOPE_AGENT
#define LDS_WAIT() asm volatile("s_waitcnt lgkmcnt(0)" ::: "memory")
#define VM_WAIT() asm volatile("s_waitcnt vmcnt(0)" ::: "memory")
__device__ __forceinline__ unsigned f2bf(float f) { unsigned u = __builtin_bit_cast(unsigned, f); return (u + 0x7fffu + ((u >> 16) & 1u)) >> 16; }
typedef float f32x2_t_ __attribute__((ext_vector_type(2)));
typedef __bf16 bf16x2_t_ __attribute__((ext_vector_type(2)));
__device__ __forceinline__ unsigned pk2(float lo, float hi) { const f32x2_t_ v = {lo, hi}; return __builtin_bit_cast(unsigned, __builtin_convertvector(v, bf16x2_t_)); }
__device__ __forceinline__ float bflo(unsigned w) { return __builtin_bit_cast(float, w << 16); }
__device__ __forceinline__ float bfhi(unsigned w) { return __builtin_bit_cast(float, w & 0xffff0000u); }
__device__ __forceinline__ float bf1(bf16 b) { return __builtin_bit_cast(float, ((unsigned)b) << 16); }
__device__ __forceinline__ float silu_f(float x) { return x * __builtin_amdgcn_rcpf(1.f + __expf(-x)); }
template <int CTRL> __device__ __forceinline__ float dpp_mov(float v) { return __builtin_bit_cast(float, __builtin_amdgcn_update_dpp(0, __builtin_bit_cast(int, v), CTRL, 0xf, 0xf, true)); }
__device__ __forceinline__ float wave_sum(float v) {
    v += dpp_mov<0xB1>(v); v += dpp_mov<0x4E>(v); v += dpp_mov<0x141>(v); v += dpp_mov<0x140>(v);
    { const unsigned u = __builtin_bit_cast(unsigned, v); const auto s = __builtin_amdgcn_permlane16_swap(u, u, false, false); v = __builtin_bit_cast(float, (unsigned)s[0]) + __builtin_bit_cast(float, (unsigned)s[1]); }
    { const unsigned u = __builtin_bit_cast(unsigned, v); const auto s = __builtin_amdgcn_permlane32_swap(u, u, false, false); v = __builtin_bit_cast(float, (unsigned)s[0]) + __builtin_bit_cast(float, (unsigned)s[1]); }
    return v;
}
__device__ __forceinline__ float wave_max(float v) {
#pragma unroll
    for (int o = 1; o < 64; o <<= 1) v = fmaxf(v, __shfl_xor(v, o));
    return v;
}
__device__ __forceinline__ f32x16 zero16() { f32x16 z;
#pragma unroll
    for (int j = 0; j < 16; ++j) z[j] = 0.f;
    asm volatile("" : "+v"(z)); return z; }
#define XB_TMO      128
#define XB_XCNT(j)  (256  + 64 * (j))
#define XB_XSUB(j)  (1280 + 64 * (j))
#define XB_XGEN(j)  (2304 + 64 * (j))
#define XB_TOP      3328
#define XB_TOPGEN   3392
#define XCD_BAR_WORDS 3456
#define XB_SPIN_CAP (1u << 18)

__device__ __forceinline__ unsigned xb_ld(unsigned* p)              { return __hip_atomic_load(p, __ATOMIC_RELAXED, __HIP_MEMORY_SCOPE_AGENT); }
__device__ __forceinline__ unsigned xb_add(unsigned* p, unsigned v) { return __hip_atomic_fetch_add(p, v, __ATOMIC_RELAXED, __HIP_MEMORY_SCOPE_AGENT); }
__device__ __forceinline__ unsigned xb_xcc_id() { return (unsigned)__builtin_amdgcn_s_getreg((3 << 11) | 20) & 0xFu; }
#define XB_SPIN(cond, bar) do { unsigned _sp = 0; while (cond) { __builtin_amdgcn_s_sleep(1); \
    if ((++_sp & 255u) == 0u) { if (xb_ld(&(bar)[XB_TMO])) break; if (_sp > XB_SPIN_CAP) { atomicAdd(&(bar)[XB_TMO], 1u); break; } } } } while (0)

struct XcdBarrier {
    unsigned* bar; unsigned x;
    volatile LAS unsigned* st;
};

__device__ __forceinline__ XcdBarrier xcd_barrier_post(unsigned* bar, volatile LAS unsigned* st) {
    XcdBarrier b; b.bar = bar; b.x = xb_xcc_id(); b.st = st;
    if (threadIdx.x == 0) (void)xb_add(&bar[XB_XCNT(b.x)], 1u);
    return b;
}
__device__ __forceinline__ void xcd_barrier_complete(unsigned* bar, unsigned x, unsigned& nloc, unsigned& nx) {
    const unsigned G = gridDim.x * gridDim.y * gridDim.z;
    unsigned sum, cnt, mine, sp = 0u;
    for (;;) {
        sum = 0u; cnt = 0u; mine = 0u;
#pragma unroll
        for (unsigned j = 0; j < 16; ++j) { const unsigned c = xb_ld(&bar[XB_XCNT(j)]); sum += c; cnt += (c > 0u) ? 1u : 0u; mine = (j == x) ? c : mine; }
        if (sum == G) break;
        __builtin_amdgcn_s_sleep(1);
        if ((++sp & 255u) == 0u) { if (xb_ld(&bar[XB_TMO])) break; if (sp > XB_SPIN_CAP) { atomicAdd(&bar[XB_TMO], 1u); break; } }
    }
    nloc = mine > 0u ? mine : 1u; nx = cnt > 0u ? cnt : 1u;
}

__device__ __forceinline__ void xcd_barrier(const XcdBarrier& b) {
    asm volatile("s_waitcnt vmcnt(0)" ::: "memory");
    __syncthreads();
    if (threadIdx.x == 0) {
        unsigned* bar = b.bar;
        __builtin_amdgcn_s_waitcnt(0);
        unsigned nloc = b.st[0], nx = b.st[1];
        if (nloc == 0u) { xcd_barrier_complete(bar, b.x, nloc, nx); b.st[0] = nloc; b.st[1] = nx; }
        const unsigned old = xb_add(&bar[XB_XSUB(b.x)], 1u);
        const unsigned gen = old / nloc;
        if (old + 1u == (gen + 1u) * nloc) {
            __builtin_amdgcn_fence(__ATOMIC_RELEASE, "agent");
            asm volatile("s_waitcnt vmcnt(0)" ::: "memory");
            const unsigned og = xb_add(&bar[XB_TOP], 1u);
            const unsigned tg = og / nx;
            if (og + 1u == (tg + 1u) * nx) xb_add(&bar[XB_TOPGEN], 1u);
            else XB_SPIN(xb_ld(&bar[XB_TOPGEN]) == tg, bar);
            __builtin_amdgcn_fence(__ATOMIC_ACQUIRE, "agent");
            xb_add(&bar[XB_XGEN(b.x)], 1u);
            asm volatile("s_waitcnt vmcnt(0)" ::: "memory");
        } else {
            XB_SPIN(xb_ld(&bar[XB_XGEN(b.x)]) == gen, bar);
            __builtin_amdgcn_fence(__ATOMIC_ACQUIRE, "agent");
            asm volatile("s_waitcnt vmcnt(0)" ::: "memory");
        }
    }
    __syncthreads();
}
struct Frame {
    LAS unsigned char* lds;
    volatile LAS unsigned* MISC;
    gu32* ctl;
    int tid, lane, wave;
    int G;
    unsigned char* ws;
};

namespace pg8 {
struct EpiRowScale {
    static constexpr bool PERM = true, KHOOK = false;
    bf16_t* O; int ldc; const unsigned long long* rowss;
    PG8_LAS float* tab;
    static __device__ __forceinline__ float rstd_of(unsigned long long ss) { return rsqrtf((float)ss * (1.0f / (4096.0f * 16777216.0f)) + 1e-6f); }
    __device__ __forceinline__ void pre(const Unit& u) const { if (threadIdx.x < 256) tab[threadIdx.x] = rstd_of(rowss[u.pm * BM + threadIdx.x]); }
    __device__ __forceinline__ void operator()(const f32x4 (&acc)[2][2][4][2], const Unit& u, int wr, int wc, int fr, int fq, int slot, bool has_next, const Unit& nxt) const {
        const int row0 = u.pm * BM + wr * 64 + fr, col0 = u.pn * BM + wc * 32 + 8 * fq;
        const bool fill = has_next && threadIdx.x < 256;
        unsigned long long ssn = 0; if (fill) ssn = rowss[nxt.pm * BM + threadIdx.x];
        float rsv[8];
#pragma unroll
        for (int i = 0; i < 8; ++i) rsv[i] = tab[slot * 256 + wr * 64 + fr + (i >> 2) * HALF + (i & 3) * 16];
#pragma unroll
        for (int ai = 0; ai < 2; ++ai)
#pragma unroll
            for (int m = 0; m < 4; ++m) { const int row = row0 + ai * HALF + m * 16; const float rs = rsv[ai * 4 + m];
                bf16_t* rowp = O + (size_t)row * ldc + col0;
#pragma unroll
                for (int bj = 0; bj < 2; ++bj) { const f32x4 v0 = acc[ai][bj][m][0] * rs, v1 = acc[ai][bj][m][1] * rs;
                    u32x4 w; w.x = cvt_pk_bf16(v0[0], v0[1]); w.y = cvt_pk_bf16(v0[2], v0[3]); w.z = cvt_pk_bf16(v1[0], v1[1]); w.w = cvt_pk_bf16(v1[2], v1[3]);
                    *(u32x4*)(rowp + bj * HALF) = w; } }
        if (fill) tab[(slot ^ 1) * 256 + threadIdx.x] = rstd_of(ssn);
    }
};
template <bool RESB, bool KH>
struct EpiResid {
    static constexpr bool PERM = true, KHOOK = KH;
    const float* res; const bf16_t* resb; float* out; bf16_t* hb; unsigned long long* rowss_next;
    const float* ssg; PG8_LAS float* tab;
    __device__ __forceinline__ void pre(const Unit&) const {}
    __device__ __forceinline__ void fill(const Unit& u) const {
        if (threadIdx.x < 256) {
            unsigned voff = (unsigned)(u.pm * BM + (int)threadIdx.x) * 4u; float s0, s1, s2, s3, s4, s5, s6, s7;
            asm volatile("global_load_dword %0, %8, %9\n\tv_add_u32 %8, 0x8000, %8\n\tglobal_load_dword %1, %8, %9\n\tv_add_u32 %8, 0x8000, %8\n\t"
                         "global_load_dword %2, %8, %9\n\tv_add_u32 %8, 0x8000, %8\n\tglobal_load_dword %3, %8, %9\n\tv_add_u32 %8, 0x8000, %8\n\t"
                         "global_load_dword %4, %8, %9\n\tv_add_u32 %8, 0x8000, %8\n\tglobal_load_dword %5, %8, %9\n\tv_add_u32 %8, 0x8000, %8\n\t"
                         "global_load_dword %6, %8, %9\n\tv_add_u32 %8, 0x8000, %8\n\tglobal_load_dword %7, %8, %9\n\ts_waitcnt vmcnt(0)"
                         : "=&v"(s0), "=&v"(s1), "=&v"(s2), "=&v"(s3), "=&v"(s4), "=&v"(s5), "=&v"(s6), "=&v"(s7), "+v"(voff) : "s"(ssg) : "memory");
            const float r0 = rsqrtf(s0 * (1.0f / 1024.0f) + 1e-6f), r1 = rsqrtf(s1 * (1.0f / 1024.0f) + 1e-6f), r2 = rsqrtf(s2 * (1.0f / 1024.0f) + 1e-6f), r3 = rsqrtf(s3 * (1.0f / 1024.0f) + 1e-6f);
            const float r4 = rsqrtf(s4 * (1.0f / 1024.0f) + 1e-6f), r5 = rsqrtf(s5 * (1.0f / 1024.0f) + 1e-6f), r6 = rsqrtf(s6 * (1.0f / 1024.0f) + 1e-6f), r7 = rsqrtf(s7 * (1.0f / 1024.0f) + 1e-6f);
            PG8_LAS float* tp = tab + threadIdx.x;
            tp[0] = r0 * __builtin_amdgcn_rcpf(r1); tp[256] = r1 * __builtin_amdgcn_rcpf(r2); tp[512] = r2 * __builtin_amdgcn_rcpf(r3); tp[768] = r3 * __builtin_amdgcn_rcpf(r4);
            tp[1024] = r4 * __builtin_amdgcn_rcpf(r5); tp[1280] = r5 * __builtin_amdgcn_rcpf(r6); tp[1536] = r6 * __builtin_amdgcn_rcpf(r7); tp[1792] = r7; }
    }
    __device__ __forceinline__ void khook(f32x4 (&acc)[2][2][4][2], int b, int wr, int fr) const {
#pragma unroll
        for (int ai = 0; ai < 2; ++ai)
#pragma unroll
            for (int m = 0; m < 4; ++m) { const float q = tab[b * 256 + wr * 64 + fr + ai * HALF + m * 16];
#pragma unroll
                for (int bj = 0; bj < 2; ++bj) { acc[ai][bj][m][0] *= q; acc[ai][bj][m][1] *= q; } }
    }
    __device__ __forceinline__ void operator()(const f32x4 (&acc_)[2][2][4][2], const Unit& u, int wr, int wc, int fr, int fq, int, bool, const Unit&) const {
        const int row0 = u.pm * BM + wr * 64 + fr, col0 = u.pn * BM + wc * 32 + 8 * fq;
        f32x4 acc[2][2][4][2];
#pragma unroll
        for (int ai = 0; ai < 2; ++ai)
#pragma unroll
            for (int m = 0; m < 4; ++m) { float q = 1.0f; if constexpr (KH) q = tab[7 * 256 + wr * 64 + fr + ai * HALF + m * 16];
#pragma unroll
                for (int bj = 0; bj < 2; ++bj) { acc[ai][bj][m][0] = KH ? acc_[ai][bj][m][0] * q : acc_[ai][bj][m][0]; acc[ai][bj][m][1] = KH ? acc_[ai][bj][m][1] * q : acc_[ai][bj][m][1]; } }
        if constexpr (RESB) {
            u32x4 R[2][4];
#define EPR_LOADB(b) { _Pragma("unroll") for (int q_ = 0; q_ < 4; ++q_) { const int rowl_ = row0 + ((b) >> 1) * HALF + (((b) & 1) * 2 + (q_ >> 1)) * 16; \
                R[(b) & 1][q_] = *(const u32x4*)(resb + (size_t)rowl_ * 4096 + col0 + (q_ & 1) * HALF); } }
            EPR_LOADB(0)
#pragma unroll
            for (int b = 0; b < 4; ++b) {
                if (b == 0) EPR_LOADB(1) else if (b == 1) EPR_LOADB(2) else if (b == 2) EPR_LOADB(3)
#pragma unroll
                for (int rl = 0; rl < 2; ++rl) { const int ai = b >> 1, m = (b & 1) * 2 + rl, row = row0 + ai * HALF + m * 16; const size_t off = (size_t)row * 4096 + col0; float ss = 0.f;
#pragma unroll
                    for (int bj = 0; bj < 2; ++bj) { const u32x4 rq = R[b & 1][rl * 2 + bj];
                        f32x4 o0, o1;
                        o0[0] = __builtin_bit_cast(float, rq.x << 16) + acc[ai][bj][m][0][0]; o0[1] = __builtin_bit_cast(float, rq.x & 0xffff0000u) + acc[ai][bj][m][0][1];
                        o0[2] = __builtin_bit_cast(float, rq.y << 16) + acc[ai][bj][m][0][2]; o0[3] = __builtin_bit_cast(float, rq.y & 0xffff0000u) + acc[ai][bj][m][0][3];
                        o1[0] = __builtin_bit_cast(float, rq.z << 16) + acc[ai][bj][m][1][0]; o1[1] = __builtin_bit_cast(float, rq.z & 0xffff0000u) + acc[ai][bj][m][1][1];
                        o1[2] = __builtin_bit_cast(float, rq.w << 16) + acc[ai][bj][m][1][2]; o1[3] = __builtin_bit_cast(float, rq.w & 0xffff0000u) + acc[ai][bj][m][1][3];
                        if (out) { *(f32x4*)(out + off + bj * HALF) = o0; *(f32x4*)(out + off + bj * HALF + 4) = o1; }
                        ss += (o0[0] * o0[0] + o0[1] * o0[1]) + (o0[2] * o0[2] + o0[3] * o0[3]) + (o1[0] * o1[0] + o1[1] * o1[1]) + (o1[2] * o1[2] + o1[3] * o1[3]);
                        if (hb) { u32x4 w; w.x = cvt_pk_bf16(o0[0], o0[1]); w.y = cvt_pk_bf16(o0[2], o0[3]); w.z = cvt_pk_bf16(o1[0], o1[1]); w.w = cvt_pk_bf16(o1[2], o1[3]);
                            *(u32x4*)(hb + off + bj * HALF) = w; } }
                    if (rowss_next) { ss += __shfl_xor(ss, 16); ss += __shfl_xor(ss, 32); if (fq == 0) atomicAdd(rowss_next + row, (unsigned long long)__float2ll_rn(ss * 16777216.0f)); } }
            }
#undef EPR_LOADB
        } else {
            f32x4 R[2][8];
#define EPR_LOAD(b) { _Pragma("unroll") for (int q_ = 0; q_ < 8; ++q_) { const int rowl_ = row0 + ((b) >> 1) * HALF + (((b) & 1) * 2 + (q_ >> 2)) * 16; \
                R[(b) & 1][q_] = *(const f32x4*)(res + (size_t)rowl_ * 4096 + col0 + ((q_ >> 1) & 1) * HALF + (q_ & 1) * 4); } }
            EPR_LOAD(0)
#pragma unroll
            for (int b = 0; b < 4; ++b) {
                if (b == 0) EPR_LOAD(1) else if (b == 1) EPR_LOAD(2) else if (b == 2) EPR_LOAD(3)
#pragma unroll
                for (int rl = 0; rl < 2; ++rl) { const int ai = b >> 1, m = (b & 1) * 2 + rl, row = row0 + ai * HALF + m * 16; const size_t off = (size_t)row * 4096 + col0; float ss = 0.f;
#pragma unroll
                    for (int bj = 0; bj < 2; ++bj) {
                        const f32x4 o0 = R[b & 1][rl * 4 + bj * 2] + acc[ai][bj][m][0], o1 = R[b & 1][rl * 4 + bj * 2 + 1] + acc[ai][bj][m][1];
                        if (out) { *(f32x4*)(out + off + bj * HALF) = o0; *(f32x4*)(out + off + bj * HALF + 4) = o1; }
                        ss += (o0[0] * o0[0] + o0[1] * o0[1]) + (o0[2] * o0[2] + o0[3] * o0[3]) + (o1[0] * o1[0] + o1[1] * o1[1]) + (o1[2] * o1[2] + o1[3] * o1[3]);
                        if (hb) { u32x4 w; w.x = cvt_pk_bf16(o0[0], o0[1]); w.y = cvt_pk_bf16(o0[2], o0[3]); w.z = cvt_pk_bf16(o1[0], o1[1]); w.w = cvt_pk_bf16(o1[2], o1[3]);
                            *(u32x4*)(hb + off + bj * HALF) = w; } }
                    if (rowss_next) { ss += __shfl_xor(ss, 16); ss += __shfl_xor(ss, 32); if (fq == 0) atomicAdd(rowss_next + row, (unsigned long long)__float2ll_rn(ss * 16777216.0f)); } }
            }
#undef EPR_LOAD
        }
    }
};
struct EpiPoolGrp {
    static constexpr bool PERM = true, KHOOK = false;
    bf16_t* O; const bf16_t* vz; const float* bg; const float* sc;
    __device__ __forceinline__ void pre(const Unit&) const {}
    __device__ __forceinline__ void operator()(const f32x4 (&acc)[2][2][4][2], const Unit& u, int wr, int wc, int fr, int fq, int, bool, const Unit&) const {
        const int row0 = u.pm * BM + wr * 64 + fr, col0 = u.pn * BM + wc * 32 + 8 * fq;
        f32x4 bv[2][2], sv[2][2];
#pragma unroll
        for (int bj = 0; bj < 2; ++bj)
#pragma unroll
            for (int n = 0; n < 2; ++n) { bv[bj][n] = *(const f32x4*)(bg + col0 + bj * HALF + 4 * n); sv[bj][n] = *(const f32x4*)(sc + col0 + bj * HALF + 4 * n); }
        u32x4 zz[8], wv[8];
#define EPG_LOAD(ai_) { _Pragma("unroll") for (int q_ = 0; q_ < 8; ++q_) zz[q_] = *(const u32x4*)(vz + (size_t)(row0 + (ai_) * HALF + (q_ >> 1) * 16) * 16384 + 8192 + col0 + (q_ & 1) * HALF); }
#define EPG_CALC(ai_) { _Pragma("unroll") for (int q_ = 0; q_ < 8; ++q_) { const int m_ = q_ >> 1, bj_ = q_ & 1; const u32x4 zq = zz[q_]; \
            const f32x4 v0 = (acc[ai_][bj_][m_][0] + bv[bj_][0]) * sv[bj_][0], v1 = (acc[ai_][bj_][m_][1] + bv[bj_][1]) * sv[bj_][1]; \
            float z[8]; z[0] = __builtin_bit_cast(float, zq.x << 16); z[1] = __builtin_bit_cast(float, zq.x & 0xffff0000u); z[2] = __builtin_bit_cast(float, zq.y << 16); z[3] = __builtin_bit_cast(float, zq.y & 0xffff0000u); \
            z[4] = __builtin_bit_cast(float, zq.z << 16); z[5] = __builtin_bit_cast(float, zq.z & 0xffff0000u); z[6] = __builtin_bit_cast(float, zq.w << 16); z[7] = __builtin_bit_cast(float, zq.w & 0xffff0000u); \
            float o[8]; \
            _Pragma("unroll") for (int j = 0; j < 4; ++j) { o[j] = v0[j] * (z[j] * __builtin_amdgcn_rcpf(1.f + __expf(-z[j]))); o[4 + j] = v1[j] * (z[4 + j] * __builtin_amdgcn_rcpf(1.f + __expf(-z[4 + j]))); } \
            wv[q_].x = cvt_pk_bf16(o[0], o[1]); wv[q_].y = cvt_pk_bf16(o[2], o[3]); wv[q_].z = cvt_pk_bf16(o[4], o[5]); wv[q_].w = cvt_pk_bf16(o[6], o[7]); } }
#define EPG_STORE(ai_) { _Pragma("unroll") for (int q_ = 0; q_ < 8; ++q_) *(u32x4*)(O + (size_t)(row0 + (ai_) * HALF + (q_ >> 1) * 16) * 8192 + col0 + (q_ & 1) * HALF) = wv[q_]; }
        EPG_LOAD(0) EPG_CALC(0) EPG_LOAD(1) EPG_STORE(0) EPG_CALC(1) EPG_STORE(1)
#undef EPG_LOAD
#undef EPG_CALC
#undef EPG_STORE
    }
};
}

__device__ __forceinline__ void p0_transpose_item(const float* W, int K, int N, bf16* WT, const float* gain, LAS float* scr, int item, int lane) {
    const int nblk = N / 32, kb = item / nblk, nb = item % nblk, k0 = 64 * kb, n0 = 32 * nb;
    const int kr = lane >> 3, nc = (lane & 7) * 4;
    f32x4 v[8];
#pragma unroll
    for (int i = 0; i < 8; ++i) v[i] = __builtin_nontemporal_load((const f32x4*)(W + (size_t)(k0 + 8 * i + kr) * N + n0 + nc));
#pragma unroll
    for (int i = 0; i < 8; ++i) { const float g = gain ? gain[k0 + 8 * i + kr] : 1.0f; *(LAS f32x4*)(scr + (8 * i + kr) * 36 + nc) = v[i] * g; }
    LDS_WAIT(); asm volatile("" ::: "memory");
    const int c = lane & 7;
#pragma unroll
    for (int j = 0; j < 4; ++j) { const int n = (lane >> 3) + 8 * j; const LAS float* s = scr + (8 * c) * 36 + n;
        v4u o; o.x = pk2(s[0 * 36], s[1 * 36]); o.y = pk2(s[2 * 36], s[3 * 36]); o.z = pk2(s[4 * 36], s[5 * 36]); o.w = pk2(s[6 * 36], s[7 * 36]);
        *(GAS v4u*)(WT + (size_t)(n0 + n) * K + k0 + 8 * c) = o; }
    LDS_WAIT(); asm volatile("" ::: "memory");
}
struct AllIn { const float* in[30]; };
__device__ __forceinline__ const float* ldin(int i) { int off = i * 8; asm volatile("" : "+s"(off));
    const char __attribute__((address_space(4)))* kp = (const char __attribute__((address_space(4)))*)__builtin_amdgcn_kernarg_segment_ptr();
    return *(const float* const __attribute__((address_space(4)))*)(kp + off); }
__device__ __forceinline__ void p0_prologue(Frame& F, const float* x, bf16* hb, unsigned long long* rowss0) {
    LAS float* scr = (LAS float*)(F.lds + RING_OFF + F.wave * 16384);
    const int gw = blockIdx.x * NWAVES + F.wave, NGW = F.G * NWAVES;
    unsigned char* ws = F.ws;
    constexpr int I_SIN = (D / 64) * (SSD_IN / 32), I_SOUT = (SSD_DI / 64) * (D / 32), I_PIN = (D / 64) * (16384 / 32), I_PG = (2048 / 64) * (2048 / 32), I_POUT = I_SOUT, I_MIN = I_PIN, I_MOUT = (D / 64) * (D / 32);
    constexpr int NITEMS = 2 * I_SIN + 2 * I_SOUT + I_PIN + 4 * I_PG + I_POUT + I_MIN + I_MOUT;
    for (int it = gw; it < NITEMS; it += NGW) {
        int r = it;
        if (r < I_SIN) { p0_transpose_item(ldin(2), D, SSD_IN, (bf16*)(ws + WS_W_SSD0_IN), ldin(1), scr, r, F.lane); continue; } r -= I_SIN;
        if (r < I_SOUT) { p0_transpose_item(ldin(9), SSD_DI, D, (bf16*)(ws + WS_W_SSD0_OUT), ldin(8), scr, r, F.lane); continue; } r -= I_SOUT;
        if (r < I_PIN) { p0_transpose_item(ldin(11), D, 16384, (bf16*)(ws + WS_W_POOL_IN), ldin(10), scr, r, F.lane); continue; } r -= I_PIN;
        if (r < 4 * I_PG) { const int g = r / I_PG; p0_transpose_item(ldin(12) + (size_t)g * 2048 * 2048, 2048, 2048, (bf16*)(ws + WS_W_POOL_GRP) + (size_t)g * 2048 * 2048, nullptr, scr, r % I_PG, F.lane); continue; } r -= 4 * I_PG;
        if (r < I_POUT) { p0_transpose_item(ldin(15), POOL_W, D, (bf16*)(ws + WS_W_POOL_OUT), nullptr, scr, r, F.lane); continue; } r -= I_POUT;
        if (r < I_MIN) { p0_transpose_item(ldin(17), D, 16384, (bf16*)(ws + WS_W_MOBA_IN), ldin(16), scr, r, F.lane); continue; } r -= I_MIN;
        if (r < I_MOUT) { p0_transpose_item(ldin(20), D, D, (bf16*)(ws + WS_W_MOBA_OUT), nullptr, scr, r, F.lane); continue; } r -= I_MOUT;
        if (r < I_SIN) { p0_transpose_item(ldin(22), D, SSD_IN, (bf16*)(ws + WS_W_SSD3_IN), ldin(21), scr, r, F.lane); continue; } r -= I_SIN;
        p0_transpose_item(ldin(29), SSD_DI, D, (bf16*)(ws + WS_W_SSD3_OUT), ldin(28), scr, r, F.lane);
    }
    for (int m = gw; m < M; m += NGW) {
        const GAS f32x4* xr = (const GAS f32x4*)(x + (size_t)m * D) + F.lane; GAS v2u* o8 = (GAS v2u*)(hb + (size_t)m * D) + F.lane; float s = 0.f;
#pragma unroll 4
        for (int j = 0; j < 16; ++j) { const f32x4 v = xr[64 * j]; s += (v.x * v.x + v.y * v.y) + (v.z * v.z + v.w * v.w); v2u w; w.x = pk2(v.x, v.y); w.y = pk2(v.z, v.w); o8[64 * j] = w; }
        s = wave_sum(s); if (F.lane == 0) rowss0[m] = (unsigned long long)__float2ll_rn(s * 16777216.0f);
    }
}

__device__ __forceinline__ void dt_phase(Frame& F, const bf16* A, const bf16* Wdt, const unsigned long long* rowss, const float* dt_bias, float* dt_out) {
    const int lane = F.lane, r = lane & 31, hh = lane >> 5;
    LAS float* P = (LAS float*)(F.lds + RING_OFF);
    for (int u = blockIdx.x; u < M / 32; u += F.G) {
        const bf16* ap = A + (size_t)(u * 32 + r) * D + F.wave * 512 + hh * 8;
        const bf16* bp = Wdt + (size_t)r * D + F.wave * 512 + hh * 8;
        f32x16 acc[4];
#pragma unroll
        for (int nb = 0; nb < 4; ++nb) acc[nb] = zero16();
#pragma unroll 4
        for (int ks = 0; ks < 32; ++ks) {
            const bf16x8 a = *(const bf16x8*)(ap + ks * 16);
#pragma unroll
            for (int nb = 0; nb < 4; ++nb) { const bf16x8 b = *(const bf16x8*)(bp + (size_t)nb * 32 * D + ks * 16); acc[nb] = __builtin_amdgcn_mfma_f32_32x32x16_bf16(a, b, acc[nb], 0, 0, 0); }
        }
#pragma unroll
        for (int nb = 0; nb < 4; ++nb)
#pragma unroll
            for (int j = 0; j < 16; ++j) { const int row = (j & 3) + 8 * (j >> 2) + 4 * hh; P[F.wave * 4096 + row * 128 + nb * 32 + r] = acc[nb][j]; }
        __syncthreads();
#pragma unroll
        for (int j = 0; j < 8; ++j) { const int idx = F.tid + 512 * j; float s = 0.f;
#pragma unroll
            for (int w = 0; w < 8; ++w) s += P[w * 4096 + idx];
            const int row = u * 32 + (idx >> 7), col = idx & 127;
            const float v = s * rsqrtf((float)rowss[row] * (1.0f / (4096.0f * 16777216.0f)) + RMS_EPS) + dt_bias[col];
            dt_out[(size_t)row * 128 + col] = fmaxf(v, 0.f) + log1pf(__expf(-fabsf(v))); }
        __syncthreads();
    }
}
__device__ __forceinline__ int pi32(int r) { return (r & ~0xC) | ((r & 4) << 1) | ((r & 8) >> 1); }
__device__ __forceinline__ void conv_phase(Frame& F, const bf16* zx, const float* cw, const float* cb, bf16* xc, bf16* xtile, bf16* btT, bf16* btok, bf16* ctok) {
    constexpr int NCG = SSD_CONV / 8, RUN = 16, NIT = (M / RUN) * NCG;
    LAS unsigned char* STG = F.lds + RING_OFF + F.wave * 8192;
    for (int it = blockIdx.x * 512 + F.tid; it < NIT; it += F.G * 512) {
        const int cg = it % NCG, tr = it / NCG, c0 = cg * 8, t0 = tr * RUN;
        v4u rows[RUN + 3];
#pragma unroll
        for (int i = 0; i < RUN + 3; ++i) { const int t = t0 - 3 + i; if (t >= 0) rows[i] = *(const v4u*)(zx + (size_t)t * SSD_MAIN + SSD_DI + c0); else { rows[i].x = 0u; rows[i].y = 0u; rows[i].z = 0u; rows[i].w = 0u; } }
        float w[4][8], b[8];
#pragma unroll
        for (int k = 0; k < 4; ++k) { const f32x4 a = *(const f32x4*)(cw + k * SSD_CONV + c0), bq = *(const f32x4*)(cw + k * SSD_CONV + c0 + 4);
#pragma unroll
            for (int j = 0; j < 4; ++j) { w[k][j] = a[j]; w[k][4 + j] = bq[j]; } }
        { const f32x4 a = *(const f32x4*)(cb + c0), bq = *(const f32x4*)(cb + c0 + 4);
#pragma unroll
          for (int j = 0; j < 4; ++j) { b[j] = a[j]; b[4 + j] = bq[j]; } }
        const int kind = c0 < SSD_DI ? 0 : (c0 < SSD_DI + 1024 ? 1 : 2);
        const int chunk = t0 >> 7, tl0 = t0 & 127;
        unsigned char* ptok; unsigned char* pch;
        if (kind == 0) { const int h = c0 >> 6, pt = (c0 >> 5) & 1, r0 = c0 & 31;
            ptok = (unsigned char*)(xc + (size_t)t0 * SSD_DI + c0);
            pch = (unsigned char*)(xtile + ((((size_t)chunk * 128 + h) * 2 + pt) * 8 + (tl0 >> 4)) * 512 + (size_t)r0 * 8); }
        else { const int n0 = (c0 - SSD_DI) & 127, g = ((c0 - SSD_DI) >> 7) & 7, ksN = n0 >> 4, h2N = (n0 >> 3) & 1, nt = n0 >> 5;
            ptok = (unsigned char*)((kind == 1 ? btok : ctok) + ((((size_t)chunk * 8 + g) * 4 + (tl0 >> 5)) * 8 + ksN) * 512 + (size_t)((tl0 & 16) + 32 * h2N) * 8);
            pch = (unsigned char*)(btT + ((((size_t)chunk * 8 + g) * 4 + nt) * 8 + (tl0 >> 4)) * 512 + (size_t)((n0 & 16) | ((n0 & 8) >> 1)) * 8); }
#pragma unroll
        for (int tb = 0; tb < RUN; tb += 8) {
            unsigned yp[8][4];
#pragma unroll
            for (int i = 0; i < 8; ++i) {
                float y[8];
#pragma unroll
                for (int j = 0; j < 8; ++j) { float a = b[j];
#pragma unroll
                    for (int k = 0; k < 4; ++k) { const v4u q = rows[tb + i + k]; const unsigned wd = (j >> 1) == 0 ? q.x : (j >> 1) == 1 ? q.y : (j >> 1) == 2 ? q.z : q.w; a += w[k][j] * ((j & 1) ? bfhi(wd) : bflo(wd)); }
                    y[j] = silu_f(a); }
                v4u o; o.x = pk2(y[0], y[1]); o.y = pk2(y[2], y[3]); o.z = pk2(y[4], y[5]); o.w = pk2(y[6], y[7]);
                const int ti = tb + i, pti = (ti & 3) | ((ti & 4) << 1) | ((ti & 8) >> 1);
                if (kind == 1) *(v4u*)(ptok + pti * 16) = o;
                else if (kind == 2) *(v4u*)(ptok + ti * 16) = o;
#pragma unroll
                for (int j = 0; j < 8; ++j) { const unsigned hb_ = f2bf(y[j]); if (i & 1) yp[j][i >> 1] |= hb_ << 16; else yp[j][i >> 1] = hb_; }
            }
            if (kind == 0) {
#pragma unroll
                for (int j = 0; j < 8; ++j) { v4u o; o.x = yp[j][0]; o.y = yp[j][1]; o.z = yp[j][2]; o.w = yp[j][3]; *(LAS v4u*)(STG + (F.lane * 8 + j) * 16) = o; }
                LDS_WAIT(); asm volatile("" ::: "memory");
                bf16* xbase = xtile + (((size_t)chunk * 256 + (c0 >> 5) - ((F.lane * 8) >> 5)) * 8 + (tl0 >> 4)) * 512 + (size_t)((tb >> 3) * 32) * 8;
#pragma unroll
                for (int s_ = 0; s_ < 8; ++s_) { const int hpl = 2 * s_ + (F.lane >> 5), slot = F.lane & 31;
                    const v4u o = *(const LAS v4u*)(STG + (hpl * 32 + slot) * 16);
                    *(v4u*)(xbase + (size_t)hpl * 8 * 512 + slot * 8) = o; }
                LDS_WAIT(); asm volatile("" ::: "memory");
            } else if (kind == 1) {
#pragma unroll
                for (int j = 0; j < 8; ++j) { v4u o; o.x = yp[j][0]; o.y = yp[j][1]; o.z = yp[j][2]; o.w = yp[j][3];
                    *(v4u*)(pch + (((j & 4) << 1) | (j & 3)) * 16 + (tb >> 3) * 512) = o; } }
        }
    }
}
__device__ __forceinline__ void ssd_s1_phase(Frame& F, const bf16* xtile, const bf16* btT, const float* dt, const float* a_log, bf16* states, float* decay) {
    const int lane = F.lane, h2 = lane >> 5;
    LAS float* w1 = (LAS float*)(F.lds + RING_OFF) + F.wave * 256;
    LAS unsigned char* BL = F.lds + RING_OFF + 16384;
    for (int u = blockIdx.x; u < 64 * SSD_NG; u += F.G) {
        const int c = u >> 3, g = u & 7, t0 = c * 128;
        float dec_out[2];
#pragma unroll
        for (int hh = 0; hh < 2; ++hh) { const int h = g * 16 + F.wave * 2 + hh; const float A = -__expf(a_log[h]);
            const float d0 = dt[(size_t)(t0 + 2 * lane) * 128 + h], d1 = dt[(size_t)(t0 + 2 * lane + 1) * 128 + h];
            const float a0 = d0 * A, a1 = d1 * A; float s = a0 + a1;
#pragma unroll
            for (int o = 1; o < 64; o <<= 1) { const float v = __shfl_up(s, o); if (lane >= o) s += v; }
            const float cs1 = s, cs0 = s - a1; const float cend = __shfl(s, 63);
            w1[hh * 128 + 2 * lane] = d0 * __expf(cend - cs0); w1[hh * 128 + 2 * lane + 1] = d1 * __expf(cend - cs1);
            dec_out[hh] = __expf(cend); }
        if (lane == 0) { decay[(c * 8 + g) * 32 + F.wave * 2] = dec_out[0]; decay[(c * 8 + g) * 32 + F.wave * 2 + 1] = dec_out[1]; }
        __syncthreads();
        { const bf16* bp = btT + ((((size_t)c * 8 + g) * 4) * 8) * 512 + (size_t)lane * 8; v4u bq[4];
#pragma unroll
          for (int i = 0; i < 4; ++i) bq[i] = *(const v4u*)(bp + (size_t)(F.wave * 4 + i) * 512);
#pragma unroll
          for (int i = 0; i < 4; ++i) *(LAS v4u*)(BL + (F.wave * 4 + i) * 1024 + lane * 16) = bq[i]; }
        __syncthreads();
        bf16x8 Xn[8];
        { const bf16* xp = xtile + ((((size_t)c * 128 + g * 16 + F.wave * 2) * 2) * 8) * 512 + (size_t)lane * 8;
#pragma unroll
          for (int ks = 0; ks < 8; ++ks) Xn[ks] = *(const bf16x8*)(xp + ks * 512); }
#pragma nounroll
        for (int item = 0; item < 4; ++item) { const int hh = item >> 1, pt = item & 1, h = g * 16 + F.wave * 2 + hh;
            bf16x8 Xf[8];
#pragma unroll
            for (int ks = 0; ks < 8; ++ks) { const v4u aq = __builtin_bit_cast(v4u, Xn[ks]);
                const f32x4 wa = *(const LAS f32x4*)(w1 + hh * 128 + ks * 16 + h2 * 8), wb = *(const LAS f32x4*)(w1 + hh * 128 + ks * 16 + h2 * 8 + 4);
                v4u as; as.x = pk2(bflo(aq.x) * wa.x, bfhi(aq.x) * wa.y); as.y = pk2(bflo(aq.y) * wa.z, bfhi(aq.y) * wa.w); as.z = pk2(bflo(aq.z) * wb.x, bfhi(aq.z) * wb.y); as.w = pk2(bflo(aq.w) * wb.z, bfhi(aq.w) * wb.w);
                Xf[ks] = __builtin_bit_cast(bf16x8, as); }
            if (item < 3) { const int hn = g * 16 + F.wave * 2 + ((item + 1) >> 1), ptn = (item + 1) & 1; const bf16* xp = xtile + ((((size_t)c * 128 + hn) * 2 + ptn) * 8) * 512 + (size_t)lane * 8;
#pragma unroll
                for (int ks = 0; ks < 8; ++ks) Xn[ks] = *(const bf16x8*)(xp + ks * 512); }
            bf16* sp = states + ((((size_t)c * 128 + h) * 2 + pt) * 8) * 512 + (size_t)lane * 8;
#pragma unroll
            for (int nt = 0; nt < 4; ++nt) { bf16x8 Bf[8];
#pragma unroll
                for (int ks = 0; ks < 8; ++ks) Bf[ks] = *(const LAS bf16x8*)(BL + (nt * 8 + ks) * 1024 + lane * 16);
                f32x16 acc = zero16();
#pragma unroll
                for (int ks = 0; ks < 8; ++ks) acc = __builtin_amdgcn_mfma_f32_32x32x16_bf16(Bf[ks], Xf[ks], acc, 0, 0, 0);
#pragma unroll
                for (int kk = 0; kk < 2; ++kk) { v4u o; o.x = pk2(acc[8 * kk], acc[8 * kk + 1]); o.y = pk2(acc[8 * kk + 2], acc[8 * kk + 3]); o.z = pk2(acc[8 * kk + 4], acc[8 * kk + 5]); o.w = pk2(acc[8 * kk + 6], acc[8 * kk + 7]);
                    *(v4u*)(sp + (size_t)(2 * nt + kk) * 512) = o; } }
        }
    }
}
__device__ __forceinline__ void ssd_s2_phase(Frame& F, bf16* states, const float* decay) {
    for (int it = blockIdx.x * 512 + F.tid; it < SSD_NH * 64 * 16; it += F.G * 512) {
        const int h = it >> 10; float H[8];
#pragma unroll
        for (int j = 0; j < 8; ++j) H[j] = 0.f;
        v4u* sp = (v4u*)(states + (size_t)it * 8);
#pragma unroll 8
        for (int c = 0; c < 64; ++c) { const v4u q = sp[(size_t)c * (128 * 64 * 16)]; const float dec = decay[(c * 8 + (h >> 4)) * 32 + (h & 15)];
            v4u o; o.x = pk2(H[0], H[1]); o.y = pk2(H[2], H[3]); o.z = pk2(H[4], H[5]); o.w = pk2(H[6], H[7]);
            sp[(size_t)c * (128 * 64 * 16)] = o;
            H[0] = H[0] * dec + bflo(q.x); H[1] = H[1] * dec + bfhi(q.x); H[2] = H[2] * dec + bflo(q.y); H[3] = H[3] * dec + bfhi(q.y);
            H[4] = H[4] * dec + bflo(q.z); H[5] = H[5] * dec + bfhi(q.z); H[6] = H[6] * dec + bflo(q.w); H[7] = H[7] * dec + bfhi(q.w); }
    }
}
__device__ __forceinline__ void ssd_s3_phase(Frame& F, const bf16* xc, const bf16* xtile, const bf16* btok, const bf16* ctok, const bf16* zx, const float* dt, const float* a_log, const float* dsk, float* ssg, const bf16* states, bf16* ybuf) {
    const int lane = F.lane, r = lane & 31, h2 = lane >> 5, li = F.wave >> 1, hhalf = F.wave & 1;
    LAS float* cst = (LAS float*)(F.lds + RING_OFF);
    LAS float* dtt = cst + 2048;
    LAS float* ssw = dtt + 2048;
    LAS float* TT = (LAS float*)(F.lds + RING_OFF + 20480) + F.wave * (32 * 36);
    const int el = lane >> 1, eh = lane & 1;
    for (int u = blockIdx.x; u < 64 * SSD_NG; u += F.G) {
        const int c = u >> 3, g = u & 7, t0 = c * 128;
#pragma unroll
        for (int hh = 0; hh < 2; ++hh) { const int hl = F.wave * 2 + hh, h = g * 16 + hl; const float A = -__expf(a_log[h]);
            const float d0 = dt[(size_t)(t0 + 2 * lane) * 128 + h], d1 = dt[(size_t)(t0 + 2 * lane + 1) * 128 + h];
            const float a1 = d1 * A; float s = d0 * A + a1;
#pragma unroll
            for (int o = 1; o < 64; o <<= 1) { const float v = __shfl_up(s, o); if (lane >= o) s += v; }
            cst[hl * 128 + 2 * lane] = s - a1; cst[hl * 128 + 2 * lane + 1] = s; dtt[hl * 128 + 2 * lane] = d0; dtt[hl * 128 + 2 * lane + 1] = d1; }
        __syncthreads();
        const bf16* cp = ctok + ((((size_t)c * 8 + g) * 4 + li) * 8) * 512 + (size_t)lane * 8;
        f32x16 CBt[4];
        { bf16x8 Cf[8];
#pragma unroll
          for (int ks = 0; ks < 8; ++ks) Cf[ks] = *(const bf16x8*)(cp + ks * 512);
#pragma unroll
          for (int si = 0; si < 4; ++si) {
            if (si <= li) { CBt[si] = zero16(); const bf16* bp = btok + ((((size_t)c * 8 + g) * 4 + si) * 8) * 512 + (size_t)lane * 8; bf16x8 Bf[8];
#pragma unroll
                for (int ks = 0; ks < 8; ++ks) Bf[ks] = *(const bf16x8*)(bp + ks * 512);
#pragma unroll
                for (int ks = 0; ks < 8; ++ks) CBt[si] = __builtin_amdgcn_mfma_f32_32x32x16_bf16(Bf[ks], Cf[ks], CBt[si], 0, 0, 0); }
          } }
        float ssq = 0.f;
        LAS unsigned char* HX = F.lds + RING_OFF + 57344 + hhalf * 32768;
        bf16x8 st[4];
        { const int h = g * 16 + hhalf * 8; const bf16* hp = states + ((((size_t)c * 128 + h) * 2) * 8 + li * 4) * 512 + (size_t)lane * 8;
#pragma unroll
          for (int f = 0; f < 4; ++f) st[f] = *(const bf16x8*)(hp + f * 512); }
#pragma nounroll
        for (int hq = 0; hq < 8; ++hq) {
            const int hl = hhalf * 8 + hq, h = g * 16 + hl;
            const float csl = cst[hl * 128 + 32 * li + r], Dh = dsk[h];
            __syncthreads();
            bf16x8 Cf[8];
            { const bf16* xp = xtile + ((((size_t)c * 128 + h) * 2) * 8 + li * 4) * 512 + (size_t)lane * 8; bf16x8 sx[4];
#pragma unroll
              for (int f = 0; f < 4; ++f) sx[f] = *(const bf16x8*)(xp + f * 512);
#pragma unroll
              for (int ks = 0; ks < 8; ++ks) Cf[ks] = *(const bf16x8*)(cp + ks * 512);
#pragma unroll
              for (int f = 0; f < 4; ++f) { *(LAS bf16x8*)(HX + (li * 4 + f) * 1024 + lane * 16) = st[f]; *(LAS bf16x8*)(HX + 16384 + (li * 4 + f) * 1024 + lane * 16) = sx[f]; } }
            { const int hn = g * 16 + hhalf * 8 + (hq < 7 ? hq + 1 : hq);
              const bf16* hp = states + ((((size_t)c * 128 + hn) * 2) * 8 + li * 4) * 512 + (size_t)lane * 8;
#pragma unroll
              for (int f = 0; f < 4; ++f) st[f] = *(const bf16x8*)(hp + f * 512); }
            __syncthreads();
            f32x16 acc[2];
#pragma unroll
            for (int pt = 0; pt < 2; ++pt) {
                acc[pt] = zero16();
#pragma unroll
                for (int ks = 0; ks < 8; ++ks) { const bf16x8 hf = *(const LAS bf16x8*)(HX + (pt * 8 + ks) * 1024 + lane * 16); acc[pt] = __builtin_amdgcn_mfma_f32_32x32x16_bf16(Cf[ks], hf, acc[pt], 0, 0, 0); }
            }
            v4u zq[2][2];
            asm volatile("" ::: "memory");
            { const size_t t = (size_t)(t0 + 32 * li + el); const int ch = h * 64 + eh * 16; zq[0][0] = *(const v4u*)(zx + t * SSD_MAIN + ch); zq[0][1] = *(const v4u*)(zx + t * SSD_MAIN + ch + 8); }
#pragma unroll
            for (int j = 0; j < 16; ++j) { const float e = __expf(cst[hl * 128 + 32 * li + (j & 3) + 8 * (j >> 2) + 4 * h2]); acc[0][j] *= e; acc[1][j] *= e; }
#pragma unroll
            for (int si = 0; si < 4; ++si) {
                if (si <= li) {
#pragma unroll
                    for (int kk = 0; kk < 2; ++kk) {
                        const int sl = 16 * kk + 8 * h2, s0 = 32 * si + sl;
                        const f32x4 ca = *(const LAS f32x4*)(cst + hl * 128 + s0), cb = *(const LAS f32x4*)(cst + hl * 128 + s0 + 4);
                        const f32x4 da = *(const LAS f32x4*)(dtt + hl * 128 + s0), db = *(const LAS f32x4*)(dtt + hl * 128 + s0 + 4);
                        float gv[8];
#pragma unroll
                        for (int jj = 0; jj < 8; ++jj) { const float cs_s = jj < 4 ? ca[jj & 3] : cb[jj & 3], dt_s = jj < 4 ? da[jj & 3] : db[jj & 3];
                            float v = CBt[si][8 * kk + jj] * __expf(fminf(csl - cs_s, 0.f)) * dt_s;
                            if (si == li && sl + jj > r) v = 0.f;
                            if (si == li && sl + jj == r) v += Dh;
                            gv[jj] = v; }
                        v4u gq; gq.x = pk2(gv[0], gv[1]); gq.y = pk2(gv[2], gv[3]); gq.z = pk2(gv[4], gv[5]); gq.w = pk2(gv[6], gv[7]);
                        const bf16x8 Gf = __builtin_bit_cast(bf16x8, gq);
#pragma unroll
                        for (int pt = 0; pt < 2; ++pt) { const bf16x8 xf = *(const LAS bf16x8*)(HX + 16384 + (pt * 8 + 2 * si + kk) * 1024 + lane * 16);
                            acc[pt] = __builtin_amdgcn_mfma_f32_32x32x16_bf16(Gf, xf, acc[pt], 0, 0, 0); }
                    }
                }
            }
#pragma unroll
            for (int pt = 0; pt < 2; ++pt) {
#pragma unroll
                for (int j = 0; j < 16; ++j) TT[((j & 3) + 8 * (j >> 2) + 4 * h2) * 36 + r] = acc[pt][j];
                LDS_WAIT(); asm volatile("" ::: "memory");
                const size_t t = (size_t)(t0 + 32 * li + el); const int ch = h * 64 + pt * 32 + eh * 16;
                if (pt == 0) { zq[1][0] = *(const v4u*)(zx + t * SSD_MAIN + ch + 32); zq[1][1] = *(const v4u*)(zx + t * SSD_MAIN + ch + 40); }
                const v4u z0 = zq[pt][0], z1 = zq[pt][1];
                const f32x4 a0 = *(const LAS f32x4*)(TT + el * 36 + eh * 16), a1 = *(const LAS f32x4*)(TT + el * 36 + eh * 16 + 4), a2 = *(const LAS f32x4*)(TT + el * 36 + eh * 16 + 8), a3 = *(const LAS f32x4*)(TT + el * 36 + eh * 16 + 12);
                float yv[16];
#define S3_Y(i, av, xw, zw, hi) { const float zs_ = (hi) ? bfhi(zw) : bflo(zw); const float y_ = (av) * silu_f(zs_); yv[i] = y_; ssq += y_ * y_; }
                S3_Y(0, a0.x, 0, z0.x, 0) S3_Y(1, a0.y, 0, z0.x, 1) S3_Y(2, a0.z, 0, z0.y, 0) S3_Y(3, a0.w, 0, z0.y, 1)
                S3_Y(4, a1.x, 0, z0.z, 0) S3_Y(5, a1.y, 0, z0.z, 1) S3_Y(6, a1.z, 0, z0.w, 0) S3_Y(7, a1.w, 0, z0.w, 1)
                S3_Y(8, a2.x, 0, z1.x, 0) S3_Y(9, a2.y, 0, z1.x, 1) S3_Y(10, a2.z, 0, z1.y, 0) S3_Y(11, a2.w, 0, z1.y, 1)
                S3_Y(12, a3.x, 0, z1.z, 0) S3_Y(13, a3.y, 0, z1.z, 1) S3_Y(14, a3.z, 0, z1.w, 0) S3_Y(15, a3.w, 0, z1.w, 1)
#undef S3_Y
                v4u o0, o1; o0.x = pk2(yv[0], yv[1]); o0.y = pk2(yv[2], yv[3]); o0.z = pk2(yv[4], yv[5]); o0.w = pk2(yv[6], yv[7]); o1.x = pk2(yv[8], yv[9]); o1.y = pk2(yv[10], yv[11]); o1.z = pk2(yv[12], yv[13]); o1.w = pk2(yv[14], yv[15]);
                *(v4u*)(ybuf + t * SSD_DI + ch) = o0; *(v4u*)(ybuf + t * SSD_DI + ch + 8) = o1;
                LDS_WAIT(); asm volatile("" ::: "memory");
            }
        }
        ssq += __shfl_xor(ssq, 1);
        if (eh == 0) ssw[hhalf * 128 + 32 * li + el] = ssq;
        __syncthreads();
        if (F.tid < 128) ssg[(size_t)g * M + t0 + F.tid] = ssw[F.tid] + ssw[128 + F.tid];
        __syncthreads();
    }
}
__device__ __forceinline__ void ssd_norm_phase(Frame& F, bf16* ybuf, const float* ssg, const float* norm_w) {
    const int gt = blockIdx.x * 512 + F.tid, chunk = gt & 1023, ch0 = chunk * 8, g = ch0 >> 10;
    const f32x4 wa = *(const f32x4*)(norm_w + ch0), wb = *(const f32x4*)(norm_w + ch0 + 4);
    const int tstep = (F.G * 512) >> 10;
    for (int t = gt >> 10; t < M; t += 4 * tstep) {
        v4u q[4]; float rs[4];
#pragma unroll
        for (int i = 0; i < 4; ++i) { const int ti = t + i * tstep; if (ti < M) { q[i] = *(const v4u*)(ybuf + (size_t)ti * SSD_DI + ch0); rs[i] = ssg[(size_t)g * M + ti]; } }
#pragma unroll
        for (int i = 0; i < 4; ++i) { const int ti = t + i * tstep; if (ti < M) { const float r_ = rsqrtf(rs[i] * (1.0f / 1024.0f) + RMS_EPS); v4u o;
            o.x = pk2(bflo(q[i].x) * r_ * wa.x, bfhi(q[i].x) * r_ * wa.y); o.y = pk2(bflo(q[i].y) * r_ * wa.z, bfhi(q[i].y) * r_ * wa.w);
            o.z = pk2(bflo(q[i].z) * r_ * wb.x, bfhi(q[i].z) * r_ * wb.y); o.w = pk2(bflo(q[i].w) * r_ * wb.z, bfhi(q[i].w) * r_ * wb.w);
            *(v4u*)(ybuf + (size_t)ti * SSD_DI + ch0) = o; } }
    }
}
template <int W> __device__ __forceinline__ void pool_item(const bf16* vz, bf16* dbuf, int c0, int t0) {
    constexpr int RUN = W == 16 ? 8 : 16, NR = RUN + W - 1;
    v4u rows[NR];
#pragma unroll
    for (int i = 0; i < NR; ++i) { const int t = t0 - (W - 1) + i; if (t >= 0) rows[i] = *(const v4u*)(vz + (size_t)t * 16384 + c0); else { rows[i].x = 0u; rows[i].y = 0u; rows[i].z = 0u; rows[i].w = 0u; } }
    float S[8];
#pragma unroll
    for (int j = 0; j < 8; ++j) S[j] = 0.f;
#define POOL_ACC(q, sgn) do { S[0] += sgn bflo((q).x); S[1] += sgn bfhi((q).x); S[2] += sgn bflo((q).y); S[3] += sgn bfhi((q).y); S[4] += sgn bflo((q).z); S[5] += sgn bfhi((q).z); S[6] += sgn bflo((q).w); S[7] += sgn bfhi((q).w); } while (0)
#pragma unroll
    for (int i = 0; i < W - 1; ++i) POOL_ACC(rows[i], +);
#pragma unroll
    for (int i = 0; i < RUN; ++i) { const int t = t0 + i; const v4u q = rows[W - 1 + i]; POOL_ACC(q, +);
        const float inv = __builtin_amdgcn_rcpf((float)(t + 1 < W ? t + 1 : W));
        v4u o; o.x = pk2(S[0] * inv - bflo(q.x), S[1] * inv - bfhi(q.x)); o.y = pk2(S[2] * inv - bflo(q.y), S[3] * inv - bfhi(q.y)); o.z = pk2(S[4] * inv - bflo(q.z), S[5] * inv - bfhi(q.z)); o.w = pk2(S[6] * inv - bflo(q.w), S[7] * inv - bfhi(q.w));
        *(v4u*)(dbuf + (size_t)t * POOL_W + c0) = o;
        POOL_ACC(rows[i], -); }
#undef POOL_ACC
}
template <int W> __device__ __forceinline__ void pool_group(Frame& F, const bf16* vz, bf16* dbuf, int gsel) {
    constexpr int NCG = POOL_GD / 8, RUN = W == 16 ? 8 : 16, NIT = (M / RUN) * NCG;
    for (int it = blockIdx.x * 512 + F.tid; it < NIT; it += F.G * 512) pool_item<W>(vz, dbuf, gsel * POOL_GD + (it % NCG) * 8, (it / NCG) * RUN);
}
__device__ __forceinline__ void pool_phase(Frame& F, const bf16* vz, bf16* dbuf) {
    pool_group<2>(F, vz, dbuf, 0); asm volatile("" ::: "memory");
    pool_group<4>(F, vz, dbuf, 1); asm volatile("" ::: "memory");
    pool_group<8>(F, vz, dbuf, 2); asm volatile("" ::: "memory");
    pool_group<16>(F, vz, dbuf, 3);
}

typedef short s16x4 __attribute__((ext_vector_type(4)));
__device__ __forceinline__ void qknorm_phase(Frame& F, bf16* qkvg, const float* qw, const float* kw, bf16* kmb, bf16* ktile, bf16* vtile) {
    LAS float* red = (LAS float*)(F.lds + 132096);
    LAS unsigned char* KL = F.lds + RING_OFF + F.wave * 16384;
    LAS unsigned char* VL = KL + 8192;
    const int lane = F.lane, r = lane & 31, h2 = lane >> 5;
    const int pr = (r & ~0xC) | ((r & 4) << 1) | ((r & 8) >> 1);
    const float qw0 = qw[2 * lane], qw1 = qw[2 * lane + 1], kw0 = kw[2 * lane], kw1 = kw[2 * lane + 1];
    for (int it = blockIdx.x; it < MOBA_NB * MOBA_H; it += F.G) {
        const int n = it / MOBA_H, h = it % MOBA_H; float ks0 = 0.f, ks1 = 0.f; const int tb = n * 256 + F.wave * 32;
#pragma unroll 8
        for (int i = 0; i < 32; ++i) { const int t = tb + i;
            unsigned* qp = (unsigned*)(qkvg + (size_t)t * 16384 + h * 128) + lane;
            const unsigned qv = *qp, kv = *((const unsigned*)(qkvg + (size_t)t * 16384 + 4096 + h * 128) + lane), vv = *((const unsigned*)(qkvg + (size_t)t * 16384 + 8192 + h * 128) + lane);
            const float q0 = bflo(qv), q1 = bfhi(qv), k0 = bflo(kv), k1 = bfhi(kv);
            const float qs = wave_sum(q0 * q0 + q1 * q1), ks = wave_sum(k0 * k0 + k1 * k1);
            const float qr = rsqrtf(qs * (1.0f / 128.0f) + RMS_EPS), kr = rsqrtf(ks * (1.0f / 128.0f) + RMS_EPS);
            const unsigned qo = pk2(q0 * qr * qw0, q1 * qr * qw1), ko = pk2(k0 * kr * kw0, k1 * kr * kw1);
            *qp = qo; ks0 += bflo(ko); ks1 += bfhi(ko);
            *(LAS unsigned*)(KL + i * 256 + lane * 4) = ko; *(LAS unsigned*)(VL + i * 256 + lane * 4) = vv; }
        red[F.wave * 128 + 2 * lane] = ks0; red[F.wave * 128 + 2 * lane + 1] = ks1;
        LDS_WAIT(); asm volatile("" ::: "memory");
        { const size_t tbase = ((((size_t)h * MOBA_NB + n) * 8 + F.wave) * 8) * 512 + (size_t)lane * 8;
#pragma unroll
          for (int ks = 0; ks < 8; ++ks) *(v4u*)(ktile + tbase + (size_t)ks * 512) = *(const LAS v4u*)(KL + pr * 256 + (16 * ks + 8 * h2) * 2);
          const int qq = (lane & 15) >> 2, pp = lane & 3, b16 = (lane >> 4) & 1;
#pragma unroll
          for (int kk = 0; kk < 2; ++kk)
#pragma unroll
              for (int dt = 0; dt < 4; ++dt) {
                  const LAS unsigned char* a0 = VL + (16 * kk + 8 * h2 + qq) * 256 + (dt * 32 + 16 * b16 + 4 * pp) * 2;
                  const s16x4 lo = __builtin_amdgcn_ds_read_tr16_b64_v4i16((LAS s16x4*)a0), hi = __builtin_amdgcn_ds_read_tr16_b64_v4i16((LAS s16x4*)(a0 + 4 * 256));
                  bf16x8 f; f[0] = lo[0]; f[1] = lo[1]; f[2] = lo[2]; f[3] = lo[3]; f[4] = hi[0]; f[5] = hi[1]; f[6] = hi[2]; f[7] = hi[3];
                  *(bf16x8*)(vtile + tbase + (size_t)(kk * 4 + dt) * 512) = f; } }
        __syncthreads();
        if (F.tid < 128) { float s = 0.f;
#pragma unroll
            for (int w = 0; w < 8; ++w) s += red[w * 128 + F.tid];
            kmb[((size_t)h * MOBA_NB + n) * 128 + F.tid] = (bf16)f2bf(s * (1.0f / 256.0f)); }
        __syncthreads();
    }
}

__device__ __forceinline__ void moba_gate_phase(Frame& F, const bf16* qkvg, const bf16* kmb, int* cntg, unsigned short* listg, unsigned char* selvg) {
    const int lane = F.lane, r = lane & 31, h2 = lane >> 5;
    LAS unsigned short* LIST = (LAS unsigned short*)(F.lds + RING_OFF);
    LAS int* CNTW = (LAS int*)(F.lds + RING_OFF + 16384);
    LAS int* TOT = (LAS int*)(F.lds + RING_OFF + 17408);
    for (int u = blockIdx.x; u < MOBA_H * MOBA_NB; u += F.G) {
        const int h = u >> 5, j = u & 31;
        int s0 = -1, s1 = -1, s2 = -1;
        { const bf16* qp = qkvg + (size_t)(j * 256 + F.wave * 32 + r) * 16384 + h * 128 + h2 * 8; const bf16* kp = kmb + ((size_t)h * MOBA_NB + r) * 128 + h2 * 8;
          f32x16 gs = zero16();
#pragma unroll
          for (int ks = 0; ks < 8; ++ks) { const bf16x8 a = *(const bf16x8*)(kp + ks * 16), b = *(const bf16x8*)(qp + ks * 16); gs = __builtin_amdgcn_mfma_f32_32x32x16_bf16(a, b, gs, 0, 0, 0); }
          float v0 = -INFINITY, v1 = -INFINITY, v2 = -INFINITY;
#pragma unroll
          for (int n = 0; n < 32; ++n) { const int ri = (n & 3) + 4 * (n >> 3); const float own = gs[ri], oth = __shfl_xor(own, 32);
              float s = (((n >> 2) & 1) == h2) ? own : oth; if (n >= j) s = -INFINITY;
              if (s > v0) { v2 = v1; s2 = s1; v1 = v0; s1 = s0; v0 = s; s0 = n; } else if (s > v1) { v2 = v1; s2 = s1; v1 = s; s1 = n; } else if (s > v2) { v2 = s; s2 = n; } }
        }
        if (h2 == 0) selvg[(size_t)(j * 256 + F.wave * 32 + r) * MOBA_H + h] = (unsigned char)((s0 >= 0 ? 1 : 0) | (s1 >= 0 ? 2 : 0) | (s2 >= 0 ? 4 : 0));
#pragma unroll 4
        for (int n = 0; n < 32; ++n) { const unsigned long long b = __ballot(h2 == 0 && (s0 == n || s1 == n || s2 == n)); if (lane == 0) CNTW[F.wave * 32 + n] = __popcll(b); }
        __syncthreads();
        int basev = 0, totv = 0;
        if (lane < 32) {
#pragma unroll
            for (int w = 0; w < 8; ++w) { const int cval = CNTW[w * 32 + lane]; if (w < F.wave) basev += cval; totv += cval; } }
#pragma unroll 4
        for (int n = 0; n < 32; ++n) { const bool mine = h2 == 0 && (s0 == n || s1 == n || s2 == n); const unsigned long long b = __ballot(mine);
            const int base = __builtin_amdgcn_readlane(basev, n);
            if (mine) { const int pos = base + __popcll(b & ((1ull << lane) - 1ull)); const int slot = (s0 == n) ? 0 : (s1 == n) ? 1 : 2; LIST[n * 256 + pos] = (unsigned short)((F.wave * 32 + r) | (slot << 8)); } }
        if (F.wave == 0 && lane < 32) { TOT[lane] = totv; cntg[((size_t)h * 32 + lane) * 32 + j] = totv; }
        __syncthreads();
        for (int i = F.tid; i < 32 * 256; i += 512) { const int n = i >> 8, pos = i & 255; if (pos < TOT[n]) listg[(((size_t)h * 32 + n) * 32 + j) * 256 + pos] = LIST[i]; }
        __syncthreads();
    }
}
__device__ __forceinline__ void moba_kv_phase(Frame& F, const bf16* qkvg, const bf16* ktile, const bf16* vtile, const int* cntg, const unsigned short* listg, const float* qw, const float* kw, bf16* part, float* lpart) {
    const int lane = F.lane, r = lane & 31, h2 = lane >> 5;
    LAS unsigned char* KV = F.lds + RING_OFF;
    LAS int* CHO = (LAS int*)(F.lds + 132096);
    LAS int* PJ = (LAS int*)(F.lds + 136320);
    float c2;
    { float mq = fmaxf(fabsf(qw[2 * lane]), fabsf(qw[2 * lane + 1])), mk = fmaxf(fabsf(kw[2 * lane]), fabsf(kw[2 * lane + 1])); mq = wave_max(mq); mk = wave_max(mk);
      c2 = (11.3137085f * mq * mk * 1.03f + 0.1f) * 1.44269504f; }
    const float c1 = 0.08838834764831845f * 1.44269504f;
    for (int i = F.tid; i < 1024; i += 512) { const int n = i & 31; int E = 0; const int* cp = cntg + (size_t)i * 32;
        for (int j = n + 1; j < 32; ++j) E += cp[j];
        CHO[i] = (8 + ((E + 31) >> 5) + 7) >> 3; }
    __syncthreads();
    if (F.wave == 0) { int loc[16]; int s = 0;
#pragma unroll
        for (int k = 0; k < 16; ++k) { loc[k] = CHO[lane * 16 + k]; s += loc[k]; }
        int inc = s;
#pragma unroll
        for (int o = 1; o < 64; o <<= 1) { const int v = __shfl_up(inc, o); if (lane >= o) inc += v; }
        int run = inc - s;
#pragma unroll
        for (int k = 0; k < 16; ++k) { CHO[lane * 16 + k] = run; run += loc[k]; }
        if (lane == 63) CHO[1024] = inc; }
    __syncthreads();
    const int NC = CHO[1024];
    const int cbeg = (int)(((long)blockIdx.x * NC) / F.G), cend = (int)(((long)(blockIdx.x + 1) * NC) / F.G);
    int cur_hn = -1;
    for (int cid = cbeg; cid < cend; ++cid) {
        int lo = 0, hi = 1023;
        while (lo < hi) { const int mid = (lo + hi + 1) >> 1; if (CHO[mid] <= cid) lo = mid; else hi = mid - 1; }
        const int h = lo >> 5, n = lo & 31, c = cid - CHO[lo];
        const bool reload = lo != cur_hn; cur_hn = lo;
        if (reload) {
            __syncthreads();
            if (F.wave == 0) { int v = (lane < 32 && lane > n) ? cntg[((size_t)h * 32 + n) * 32 + lane] : 0; int inc = v;
#pragma unroll
                for (int o = 1; o < 32; o <<= 1) { const int w = __shfl_up(inc, o); if (lane >= o) inc += w; }
                if (lane < 32) PJ[lane] = inc - v; if (lane == 31) PJ[32] = inc; }
            const v4u* ks = (const v4u*)(ktile + (((size_t)h * MOBA_NB + n) * 64) * 512); const v4u* vs = (const v4u*)(vtile + (((size_t)h * MOBA_NB + n) * 64) * 512);
            v4u kb[8], vb[8];
#pragma unroll
            for (int k = 0; k < 8; ++k) { kb[k] = ks[F.tid + 512 * k]; vb[k] = vs[F.tid + 512 * k]; }
#pragma unroll
            for (int k = 0; k < 8; ++k) { *(LAS v4u*)(KV + (F.tid + 512 * k) * 16) = kb[k]; *(LAS v4u*)(KV + 65536 + (F.tid + 512 * k) * 16) = vb[k]; }
            __syncthreads();
        }
        const int E = PJ[32], T = 8 + ((E + 31) >> 5), ti = c * 8 + F.wave;
        int q = 0, slot = 3, tq = 0, nkt = 0; bool valid = false, own = false;
        if (ti < 8) { own = true; q = ti * 32 + r; tq = n * 256 + q; nkt = ti + 1; valid = true; }
        else if (ti < T) { int e = (ti - 8) * 32 + r; valid = e < E; if (!valid) e = (ti - 8) * 32; int jj = n + 1;
            for (int j2 = n + 2; j2 < 32; ++j2) if (PJ[j2] <= e) jj = j2;
            const int ent = listg[(((size_t)h * 32 + n) * 32 + jj) * 256 + (e - PJ[jj])]; q = ent & 255; slot = ent >> 8; tq = jj * 256 + q; nkt = 8; }
        if (nkt > 0) {
            f32x16 O[4]; float lsum = 0.f;
#pragma unroll
            for (int dt = 0; dt < 4; ++dt) O[dt] = zero16();
            bf16x8 Qf[8];
            { const bf16* qp = qkvg + (size_t)tq * 16384 + h * 128 + h2 * 8;
#pragma unroll
              for (int ks = 0; ks < 8; ++ks) Qf[ks] = *(const bf16x8*)(qp + ks * 16); }
#pragma nounroll
            for (int kt = 0; kt < nkt; ++kt) {
                f32x16 S = zero16();
#pragma unroll
                for (int ks = 0; ks < 8; ++ks) { const bf16x8 kf = *(const LAS bf16x8*)(KV + ((kt * 8 + ks) * 64 + lane) * 16); S = __builtin_amdgcn_mfma_f32_32x32x16_bf16(kf, Qf[ks], S, 0, 0, 0); }
                const bool diag = own && (kt == nkt - 1);
                float p[16];
#pragma unroll
                for (int i = 0; i < 16; ++i) { float pv = __builtin_amdgcn_exp2f(S[i] * c1 - c2); if (diag && (kt * 32 + 16 * (i >> 3) + 8 * h2 + (i & 7)) > q) pv = 0.f; p[i] = pv; lsum += pv; }
#pragma unroll
                for (int kk = 0; kk < 2; ++kk) { v4u pq; pq.x = pk2(p[8 * kk], p[8 * kk + 1]); pq.y = pk2(p[8 * kk + 2], p[8 * kk + 3]); pq.z = pk2(p[8 * kk + 4], p[8 * kk + 5]); pq.w = pk2(p[8 * kk + 6], p[8 * kk + 7]);
                    const bf16x8 Pf = __builtin_bit_cast(bf16x8, pq);
#pragma unroll
                    for (int dt = 0; dt < 4; ++dt) { const bf16x8 vf = *(const LAS bf16x8*)(KV + 65536 + ((kt * 8 + kk * 4 + dt) * 64 + lane) * 16); O[dt] = __builtin_amdgcn_mfma_f32_32x32x16_bf16(vf, Pf, O[dt], 0, 0, 0); } }
            }
            lsum += __shfl_xor(lsum, 32);
            {
                const size_t dst = ((size_t)tq * MOBA_H + h) * 4 + slot; if (valid && h2 == 0) lpart[dst] = lsum;
                bf16* pr_ = part + dst * 128 + 8 * h2;
#pragma unroll
                for (int dt = 0; dt < 4; ++dt)
#pragma unroll
                    for (int rp = 0; rp < 2; ++rp) {
                        const unsigned x0 = pk2(O[dt][8 * rp], O[dt][8 * rp + 1]), x1 = pk2(O[dt][8 * rp + 2], O[dt][8 * rp + 3]), y0 = pk2(O[dt][8 * rp + 4], O[dt][8 * rp + 5]), y1 = pk2(O[dt][8 * rp + 6], O[dt][8 * rp + 7]);
                        const auto s0 = __builtin_amdgcn_permlane32_swap(x0, y0, false, false), s1 = __builtin_amdgcn_permlane32_swap(x1, y1, false, false);
                        v4u w; w.x = s0[0]; w.y = s1[0]; w.z = s0[1]; w.w = s1[1];
                        if (valid) *(v4u*)(pr_ + dt * 32 + 16 * rp) = w; } }
        }
    }
}
__device__ __forceinline__ void moba_combine_phase(Frame& F, const bf16* qkvg, const unsigned char* selvg, const bf16* part, const float* lpart, bf16* obuf) {
    for (int it = blockIdx.x * 512 + F.tid; it < M * MOBA_H * 4; it += F.G * 512) {
        const int qd = it & 3, th = it >> 2, h = th & 31, t = th >> 5; const unsigned vm = selvg[th] | 8u;
        v4u w[4][4]; float lv[4];
#pragma unroll
        for (int sl = 0; sl < 4; ++sl) { const bool v = (vm >> sl) & 1u; const size_t rd = (size_t)th * 4 + (v ? sl : 3); lv[sl] = lpart[rd]; const v4u* pp = (const v4u*)(part + rd * 128 + qd * 32);
#pragma unroll
            for (int c = 0; c < 4; ++c) w[sl][c] = pp[c]; }
        const v4u* gp = (const v4u*)(qkvg + (size_t)t * 16384 + 12288 + h * 128 + qd * 32); v4u gq[4];
#pragma unroll
        for (int c = 0; c < 4; ++c) gq[c] = gp[c];
        float o[32]; float l = 0.f;
#pragma unroll
        for (int i = 0; i < 32; ++i) o[i] = 0.f;
#pragma unroll
        for (int sl = 0; sl < 4; ++sl) { const bool v = (vm >> sl) & 1u; const unsigned m = v ? 0xffffffffu : 0u; l += v ? lv[sl] : 0.f;
#pragma unroll
            for (int c = 0; c < 4; ++c) { v4u q = w[sl][c]; q.x &= m; q.y &= m; q.z &= m; q.w &= m;
                o[8 * c] += bflo(q.x); o[8 * c + 1] += bfhi(q.x); o[8 * c + 2] += bflo(q.y); o[8 * c + 3] += bfhi(q.y); o[8 * c + 4] += bflo(q.z); o[8 * c + 5] += bfhi(q.z); o[8 * c + 6] += bflo(q.w); o[8 * c + 7] += bfhi(q.w); } }
        const float inv = 1.0f / l; v4u* op = (v4u*)(obuf + (size_t)t * MOBA_W + h * 128 + qd * 32);
#pragma unroll
        for (int c = 0; c < 4; ++c) { const v4u g_ = gq[c]; v4u r_;
            r_.x = pk2(o[8 * c] * inv * silu_f(bflo(g_.x)), o[8 * c + 1] * inv * silu_f(bfhi(g_.x))); r_.y = pk2(o[8 * c + 2] * inv * silu_f(bflo(g_.y)), o[8 * c + 3] * inv * silu_f(bfhi(g_.y)));
            r_.z = pk2(o[8 * c + 4] * inv * silu_f(bflo(g_.z)), o[8 * c + 5] * inv * silu_f(bfhi(g_.z))); r_.w = pk2(o[8 * c + 6] * inv * silu_f(bflo(g_.w)), o[8 * c + 7] * inv * silu_f(bfhi(g_.w))); op[c] = r_; }
    }
}
#ifndef MK_N_LAUNCHES
#define MK_N_LAUNCHES 1
#endif
__device__ __forceinline__ void xcd_skew(int ticks_per_xcd) {
    const unsigned long long t0 = __builtin_amdgcn_s_memrealtime(); const unsigned long long want = (unsigned long long)(((blockIdx.x >> 3) & 31) * ticks_per_xcd);
    while (__builtin_amdgcn_s_memrealtime() - t0 < want) __builtin_amdgcn_s_sleep(2);
}
constexpr int N_PHASES = 25;
struct Args { AllIn I; float* out; unsigned char* ws; int ph_lo, ph_hi; };
#define INP(i) ldin(i)
__global__ void __launch_bounds__(NWAVES * 64, 2) mk_fwd(Args args) {
    extern __shared__ __attribute__((aligned(16))) unsigned char lds[];
    Frame F;
    F.lds = (LAS unsigned char*)lds;
    F.MISC = (volatile LAS unsigned*)(F.lds + MISC_OFF);
    F.tid = threadIdx.x; F.lane = F.tid & 63; F.wave = __builtin_amdgcn_readfirstlane(F.tid >> 6);
    F.G = gridDim.x; F.ws = args.ws;
    F.ctl = (gu32*)(args.ws + WS_CTL);
    for (int u = F.tid; u < (LDS_BYTES - LDSCTL_OFF) / 4; u += NWAVES * 64) ((LAS unsigned*)(F.lds + LDSCTL_OFF))[u] = 0u;
    __syncthreads();
    const int lo = args.ph_lo, hi = args.ph_hi;
    XcdBarrier bar; bar.bar = (unsigned*)(F.ctl + CW_BAR); bar.x = 0; bar.st = nullptr;
    if (hi - lo > 1) bar = xcd_barrier_post((unsigned*)(F.ctl + CW_BAR), F.MISC + 8);
#define IN(k) (lo <= (k) && (k) < hi)
#define SEAM(k) do { if (IN(k) && IN((k) + 1)) xcd_barrier(bar); } while (0)
#define WSP(T, off) ((T*)(args.ws + (off)))
#define ROWSS(l) ((unsigned long long*)(F.ctl + CW_ROWSS) + (l) * M)

    if (IN(0)) { p0_prologue(F, INP(0), WSP(bf16, WS_HB), ROWSS(0)); } SEAM(0);

#define SSD_LAYER(REPV) { constexpr int rep = (REPV); \
        constexpr int pb = rep ? 18 : 1, ib = rep ? 22 : 2, layer = rep ? 3 : 0; \
        if (IN(pb + 0)) { \
            const bf16* Win_t = WSP(const bf16, rep ? WS_W_SSD3_IN : WS_W_SSD0_IN); \
            pg8::Gemm g{WSP(const bf16, WS_HB), Win_t, M, SSD_MAIN, D, D, D, 0}; pg8::StaticOrder S; S.init(M, SSD_MAIN, F.G, (int)blockIdx.x); \
            pg8::EpiRowScale E{WSP(bf16, WS_ACT_A), SSD_MAIN, ROWSS(layer), (LAS float*)(F.lds + 132096)}; \
            pg8::gemm_phase<pg8::EpiRowScale, pg8::StaticOrder, true, true>(F.lds + RING_OFF, g, S, E); \
            __syncthreads(); \
            dt_phase(F, WSP(const bf16, WS_HB), Win_t + (size_t)SSD_MAIN * D, ROWSS(layer), INP(ib + 3), WSP(float, WS_DT)); \
        } \
        SEAM(pb + 0); \
        if (IN(pb + 1)) conv_phase(F, WSP(const bf16, WS_ACT_A), INP(ib + 1), INP(ib + 2), WSP(bf16, WS_XC), WSP(bf16, WS_XT), WSP(bf16, WS_BT), WSP(bf16, WS_BT + 16 * MiB), WSP(bf16, WS_BT + 32 * MiB)); \
        SEAM(pb + 1); \
        if (IN(pb + 2)) ssd_s1_phase(F, WSP(const bf16, WS_XT), WSP(const bf16, WS_BT), WSP(const float, WS_DT), INP(ib + 4), WSP(bf16, WS_STATES), WSP(float, WS_DECAY)); \
        SEAM(pb + 2); \
        if (IN(pb + 3)) ssd_s2_phase(F, WSP(bf16, WS_STATES), WSP(const float, WS_DECAY)); \
        SEAM(pb + 3); \
        if (IN(pb + 4)) ssd_s3_phase(F, WSP(const bf16, WS_XC), WSP(const bf16, WS_XT), WSP(const bf16, WS_BT + 16 * MiB), WSP(const bf16, WS_BT + 32 * MiB), WSP(const bf16, WS_ACT_A), WSP(const float, WS_DT), INP(ib + 4), INP(ib + 5), WSP(float, WS_SSG), WSP(const bf16, WS_STATES), WSP(bf16, WS_ACT_B)); \
        SEAM(pb + 4); \
        if (IN(pb + 6)) { \
            pg8::Gemm g{WSP(const bf16, WS_ACT_B), WSP(const bf16, rep ? WS_W_SSD3_OUT : WS_W_SSD0_OUT), M, D, SSD_DI, SSD_DI, SSD_DI, 0}; pg8::StaticOrder S; S.init(M, D, F.G, (int)blockIdx.x); \
            if constexpr (rep == 0) { pg8::EpiResid<true, true> E{(const float*)nullptr, WSP(const bf16, WS_HB), (float*)nullptr, WSP(bf16, WS_HB), ROWSS(1), WSP(const float, WS_SSG), (LAS float*)(F.lds + 132096)}; \
                pg8::gemm_phase<pg8::EpiResid<true, true>, pg8::StaticOrder, true, true>(F.lds + RING_OFF, g, S, E); } \
            else { pg8::EpiResid<true, true> E{(const float*)nullptr, WSP(const bf16, WS_HB), args.out, (bf16*)nullptr, (unsigned long long*)nullptr, WSP(const float, WS_SSG), (LAS float*)(F.lds + 132096)}; \
                pg8::gemm_phase<pg8::EpiResid<true, true>, pg8::StaticOrder, true, true>(F.lds + RING_OFF, g, S, E); } \
        } \
        SEAM(pb + 6); \
    }
    SSD_LAYER(0)
    {
            if (IN(8)) {
                pg8::Gemm g{WSP(const bf16, WS_HB), WSP(const bf16, WS_W_POOL_IN), M, 16384, D, D, D, 0}; pg8::StaticOrder S; S.init(M, 16384, F.G, (int)blockIdx.x);
                pg8::EpiRowScale E{WSP(bf16, WS_ACT_A), 16384, ROWSS(1), (LAS float*)(F.lds + 132096)};
                pg8::gemm_phase<pg8::EpiRowScale, pg8::StaticOrder, true, true>(F.lds + RING_OFF, g, S, E);
            }
            SEAM(8);
            if (IN(9)) pool_phase(F, WSP(const bf16, WS_ACT_A), WSP(bf16, WS_ACT_B));
            SEAM(9);
            if (IN(10)) {
                pg8::Gemm g{WSP(const bf16, WS_ACT_B), WSP(const bf16, WS_W_POOL_GRP), M, POOL_W, POOL_GD, POOL_W, POOL_GD, POOL_GD / 256}; pg8::StaticOrder S; S.init(M, POOL_W, F.G, (int)blockIdx.x);
                pg8::EpiPoolGrp E{WSP(bf16, WS_ACT_C), WSP(const bf16, WS_ACT_A), INP(13), INP(14)};
                pg8::gemm_phase<pg8::EpiPoolGrp, pg8::StaticOrder, true, true>(F.lds + RING_OFF, g, S, E);
            }
            SEAM(10);
            if (IN(11)) {
                pg8::Gemm g{WSP(const bf16, WS_ACT_C), WSP(const bf16, WS_W_POOL_OUT), M, D, POOL_W, POOL_W, POOL_W, 0}; pg8::StaticOrder S; S.init(M, D, F.G, (int)blockIdx.x);
                pg8::EpiResid<true, false> E{(const float*)nullptr, WSP(const bf16, WS_HB), (float*)nullptr, WSP(bf16, WS_HB), ROWSS(2), (const float*)nullptr, (LAS float*)nullptr};
                pg8::gemm_phase<pg8::EpiResid<true, false>, pg8::StaticOrder, true, true>(F.lds + RING_OFF, g, S, E);
            }
            SEAM(11);
            if (IN(12)) {
                pg8::Gemm g{WSP(const bf16, WS_HB), WSP(const bf16, WS_W_MOBA_IN), M, 16384, D, D, D, 0}; pg8::StaticOrder S; S.init(M, 16384, F.G, (int)blockIdx.x);
                pg8::EpiRowScale E{WSP(bf16, WS_ACT_A), 16384, ROWSS(2), (LAS float*)(F.lds + 132096)};
                pg8::gemm_phase<pg8::EpiRowScale, pg8::StaticOrder, true, true>(F.lds + RING_OFF, g, S, E);
            }
            SEAM(12);
            if (IN(13)) qknorm_phase(F, WSP(bf16, WS_ACT_A), INP(18), INP(19), WSP(bf16, WS_KMEAN), WSP(bf16, WS_XC + 72 * MiB), WSP(bf16, WS_XC));
            SEAM(13);
            if (IN(14)) moba_gate_phase(F, WSP(const bf16, WS_ACT_A), WSP(const bf16, WS_KMEAN), WSP(int, WS_XC + 136 * MiB), WSP(unsigned short, WS_XC + 138 * MiB), WSP(unsigned char, WS_XC + 137 * MiB));
            SEAM(14);
            if (IN(15)) moba_kv_phase(F, WSP(const bf16, WS_ACT_A), WSP(const bf16, WS_XC + 72 * MiB), WSP(const bf16, WS_XC), WSP(const int, WS_XC + 136 * MiB), WSP(const unsigned short, WS_XC + 138 * MiB), INP(18), INP(19), WSP(bf16, WS_ACT_C), WSP(float, WS_XC + 64 * MiB));
            SEAM(15);
            if (IN(16)) moba_combine_phase(F, WSP(const bf16, WS_ACT_A), WSP(const unsigned char, WS_XC + 137 * MiB), WSP(const bf16, WS_ACT_C), WSP(const float, WS_XC + 64 * MiB), WSP(bf16, WS_ACT_B));
            SEAM(16);
            if (IN(17)) {
                pg8::Gemm g{WSP(const bf16, WS_ACT_B), WSP(const bf16, WS_W_MOBA_OUT), M, D, MOBA_W, MOBA_W, MOBA_W, 0}; pg8::StaticOrder S; S.init(M, D, F.G, (int)blockIdx.x);
                pg8::EpiResid<true, false> E{(const float*)nullptr, WSP(const bf16, WS_HB), (float*)nullptr, WSP(bf16, WS_HB), ROWSS(3), (const float*)nullptr, (LAS float*)nullptr};
                pg8::gemm_phase<pg8::EpiResid<true, false>, pg8::StaticOrder, true, true>(F.lds + RING_OFF, g, S, E);
            }
            SEAM(17);
        }
    SSD_LAYER(1)
#undef SSD_LAYER
#undef IN
#undef SEAM
#undef WSP
#undef ROWSS
}

extern "C" void kernel_launch(void* const* d_in, const int* in_sizes, int n_in, void* d_out, int out_size, void* d_ws, size_t ws_size, hipStream_t stream) {
    static int grid = 0;
    if (grid == 0) {
        if (n_in != 30 || in_sizes[0] != M * D || out_size != M * D || ws_size < WS_END) { fprintf(stderr, "kernel_launch: unexpected shapes: n_in %d in0 %d out %d ws %zu (need %zu)\n", n_in, n_in > 0 ? in_sizes[0] : -1, out_size, ws_size, (size_t)WS_END); grid = -1; return; }
        int dev = 0, cus = 0, per_cu = 0;
        if (hipGetDevice(&dev) != hipSuccess || hipDeviceGetAttribute(&cus, hipDeviceAttributeMultiprocessorCount, dev) != hipSuccess) { grid = -1; return; }
        if (hipFuncSetAttribute((const void*)mk_fwd, hipFuncAttributeMaxDynamicSharedMemorySize, LDS_BYTES) != hipSuccess) { fprintf(stderr, "kernel_launch: hipFuncSetAttribute failed\n"); grid = -1; return; }
        if (hipOccupancyMaxActiveBlocksPerMultiprocessor(&per_cu, (const void*)mk_fwd, NWAVES * 64, LDS_BYTES) != hipSuccess || per_cu < 1)
            fprintf(stderr, "kernel_launch: occupancy query reports %d workgroups per CU\n", per_cu);
        (void)hipGetLastError();
        grid = cus;
    }
    if (grid < 0) return;
    if (hipMemsetAsync((char*)d_ws + WS_CTL, 0, CTL_ZERO_BYTES, stream) != hipSuccess) { fprintf(stderr, "kernel_launch: memset failed\n"); return; }
    Args a{};
    for (int i = 0; i < 30; ++i) a.I.in[i] = (const float*)d_in[i];
    a.out = (float*)d_out; a.ws = (unsigned char*)d_ws;
#if MK_N_LAUNCHES == 1
    a.ph_lo = 0; a.ph_hi = N_PHASES;
    hipLaunchKernelGGL(mk_fwd, dim3(grid), dim3(NWAVES * 64), LDS_BYTES, stream, a);
#else
    for (int li = 0; li < N_PHASES; ++li) { a.ph_lo = li; a.ph_hi = li + 1; hipLaunchKernelGGL(mk_fwd, dim3(grid), dim3(NWAVES * 64), LDS_BYTES, stream, a); }
#endif
}
```
